# Optimizing an MI355X kernel written in HIP

```python
import math
import jax
import jax.numpy as jnp
from jax import lax
import numpy as np

D_MODEL = 2048
BATCH = 4
SEQ = 4096
DEPTH = 4

GRID_W = 64
CTX_LEN = 256
N_MIXERS = 4
HEAD_DIM = 128
Q_BLOCK = 128
ROPE_THETA = 10000.0
EPS = 1e-6
NEG_INF = -1e30
FFN_HIDDEN = -(-8 * D_MODEL // (3 * 256)) * 256

SWA_Q_HEADS = D_MODEL // HEAD_DIM
SWA_KV_HEADS = SWA_Q_HEADS // 4
SWA_WINDOW = 128
DIFF_HEADS = D_MODEL // (2 * HEAD_DIM)
MLA_HEADS = D_MODEL // HEAD_DIM
MLA_Q_RANK = D_MODEL // 4
MLA_KV_RANK = 512
MLA_NOPE_DIM = 128
MLA_ROPE_DIM = 64
MLA_V_DIM = 128
NA_HEADS = D_MODEL // HEAD_DIM
NA_WIN_ROWS = 8
NA_WIN_COLS = 16
NA_QCOLS = 16
NA_KCOLS = NA_QCOLS + NA_WIN_COLS

kernel_name = 'hybrid_interleaved_diffusion_block'


def rmsnorm(x, g):
    xf = x.astype(jnp.float32)
    y = xf * lax.rsqrt(jnp.mean(xf * xf, axis=-1, keepdims=True) + EPS)
    return (y * g.astype(jnp.float32)).astype(x.dtype)


def adaln(cond, w, b):
    return jnp.split(jax.nn.silu(cond) @ w + b, 6, axis=-1)


def axial_angles(n_tokens, rot_dim):
    n = rot_dim // 4
    t = jnp.arange(n_tokens)
    row = (t // GRID_W).astype(jnp.float32)
    col = (t % GRID_W).astype(jnp.float32)
    inv = ROPE_THETA ** (-jnp.arange(n, dtype=jnp.float32) / n)
    return row[:, None] * inv, col[:, None] * inv


def _rotate(x, ang):
    n = ang.shape[-1]
    shape = (ang.shape[0],) + (1,) * (x.ndim - 3) + (n,)
    cos = jnp.cos(ang).reshape(shape).astype(x.dtype)
    sin = jnp.sin(ang).reshape(shape).astype(x.dtype)
    x1, x2 = x[..., :n], x[..., n:]
    return jnp.concatenate([x1 * cos - x2 * sin, x1 * sin + x2 * cos], axis=-1)


def axial_rope(x, ang):
    ang_r, ang_c = ang
    h = x.shape[-1] // 2
    return jnp.concatenate([_rotate(x[..., :h], ang_r), _rotate(x[..., h:], ang_c)], axis=-1)


def sweep_query_blocks(fn, qs):
    b, s = qs[0].shape[:2]
    nb = s // Q_BLOCK
    blocks = tuple(jnp.moveaxis(q.reshape(b, nb, Q_BLOCK, *q.shape[2:]), 1, 0) for q in qs)
    o = jnp.moveaxis(lax.map(fn, blocks), 0, 1)
    return o.reshape(b, s, *o.shape[3:])


def swiglu(u, w_gu, w_down):
    g, up = jnp.split(u @ w_gu, 2, axis=-1)
    return (jax.nn.silu(g) * up) @ w_down


def swa_mixer(ul, uc, wqkv, wo, sink, ang, need_ctx):
    hq, hk, dh = SWA_Q_HEADS, SWA_KV_HEADS, HEAD_DIM
    g = hq // hk
    scale = dh ** -0.5

    def proj(u):
        b, n, _ = u.shape
        q, k, v = jnp.split(u @ wqkv, [hq * dh, (hq + hk) * dh], axis=-1)
        return q.reshape(b, n, hk, g, dh) * scale, k.reshape(b, n, hk, dh), v.reshape(b, n, hk, dh)

    ql, kl, vl = proj(ul)
    qc, kc, vc = proj(uc)
    ql = axial_rope(ql, ang)
    kl = axial_rope(kl, ang)
    b, s = ul.shape[:2]
    nb, qb_len = s // Q_BLOCK, Q_BLOCK
    sink_hg = sink.astype(jnp.float32).reshape(hk, g)

    qb = ql.reshape(b, nb, qb_len, hk, g, dh)

    def band(t):
        tp = jnp.pad(t, ((0, 0), (qb_len, qb_len), (0, 0), (0, 0))).reshape(b, nb + 2, qb_len, hk, dh)
        return jnp.concatenate([tp[:, :-2], tp[:, 1:-1], tp[:, 2:]], axis=2)

    kb, vb = band(kl), band(vl)
    qpos = jnp.arange(qb_len)
    kpos = jnp.arange(3 * qb_len) - qb_len
    in_win = jnp.abs(kpos[None, :] - qpos[:, None]) <= SWA_WINDOW
    kabs = jnp.arange(nb)[:, None] * qb_len + kpos[None, :]
    in_seq = (kabs >= 0) & (kabs < s)
    mask = in_win[None] & in_seq[:, None, :]
    s_band = jnp.einsum('bnqhgd,bnkhd->bnhgqk', qb, kb).astype(jnp.float32)
    s_band = jnp.where(mask[None, :, None, None], s_band, NEG_INF)
    s_ctx = jnp.einsum('bnqhgd,bchd->bnhgqc', qb, kc).astype(jnp.float32)
    sink_col = jnp.broadcast_to(sink_hg[:, :, None, None], (b, nb, hk, g, qb_len, 1))
    p = jax.nn.softmax(jnp.concatenate([s_band, s_ctx, sink_col], axis=-1), axis=-1).astype(vl.dtype)
    nband = 3 * qb_len
    o = (jnp.einsum('bnhgqk,bnkhd->bnqhgd', p[..., :nband], vb)
         + jnp.einsum('bnhgqc,bchd->bnqhgd', p[..., nband:-1], vc))
    yl = o.reshape(b, s, hq * dh) @ wo

    yc = None
    if need_ctx:
        nc = uc.shape[1]
        s_cc = jnp.einsum('bqhgd,bkhd->bhgqk', qc, kc).astype(jnp.float32)
        sink_c = jnp.broadcast_to(sink_hg[:, :, None, None], (b, hk, g, nc, 1))
        pc = jax.nn.softmax(jnp.concatenate([s_cc, sink_c], axis=-1), axis=-1).astype(vc.dtype)
        oc = jnp.einsum('bhgqk,bkhd->bqhgd', pc[..., :-1], vc)
        yc = oc.reshape(b, nc, hq * dh) @ wo
    return yl, yc


def diff_mixer(ul, uc, wqkv, wo, lam_vecs, subln, lam_init, ang, need_ctx):
    h, dh = DIFF_HEADS, HEAD_DIM
    scale = dh ** -0.5

    def proj(u):
        b, n, _ = u.shape
        q, k, v = jnp.split(u @ wqkv, 3, axis=-1)
        return q.reshape(b, n, h, 2, dh) * scale, k.reshape(b, n, h, 2, dh), v.reshape(b, n, h, 2 * dh)

    ql, kl, vl = proj(ul)
    qc, kc, vc = proj(uc)
    ql = axial_rope(ql, ang)
    kl = axial_rope(kl, ang)
    lv = lam_vecs.astype(jnp.float32)
    lam = jnp.exp(jnp.sum(lv[0] * lv[1])) - jnp.exp(jnp.sum(lv[2] * lv[3])) + lam_init

    def attend(q, k, v):
        sc = jnp.einsum('bqhcd,bkhcd->bhcqk', q, k).astype(jnp.float32)
        p = jax.nn.softmax(sc, axis=-1)
        a = (p[:, :, 0] - lam * p[:, :, 1]).astype(v.dtype)
        return jnp.einsum('bhqk,bkhe->bqhe', a, v)

    def finish(o):
        o = rmsnorm(o, subln) * (1.0 - lam_init)
        return o.reshape(o.shape[0], o.shape[1], h * 2 * dh) @ wo

    k_all = jnp.concatenate([kc, kl], axis=1)
    v_all = jnp.concatenate([vc, vl], axis=1)
    yl = finish(sweep_query_blocks(lambda qs: attend(qs[0], k_all, v_all), (ql,)))
    yc = finish(attend(qc, kc, vc)) if need_ctx else None
    return yl, yc


def mla_mixer(ul, uc, wdown, q_norm, kv_norm, wuq, wukv, wo, ang, need_ctx):
    h, dn, dr, dv = MLA_HEADS, MLA_NOPE_DIM, MLA_ROPE_DIM, MLA_V_DIM
    scale = (dn + dr) ** -0.5

    def proj(u):
        b, n, _ = u.shape
        cq, ckv, kpe = jnp.split(u @ wdown, [MLA_Q_RANK, MLA_Q_RANK + MLA_KV_RANK], axis=-1)
        q = (rmsnorm(cq, q_norm) @ wuq).reshape(b, n, h, dn + dr) * scale
        kv = (rmsnorm(ckv, kv_norm) @ wukv).reshape(b, n, h, dn + dv)
        return q[..., :dn], q[..., dn:], kv[..., :dn], kpe, kv[..., dn:]

    qn_l, qp_l, kn_l, kp_l, v_l = proj(ul)
    qn_c, qp_c, kn_c, kp_c, v_c = proj(uc)
    qp_l = axial_rope(qp_l, ang)
    kp_l = axial_rope(kp_l, ang)

    def attend(qn, qp, kn, kp, v):
        sc = (jnp.einsum('bqhd,bkhd->bhqk', qn, kn)
              + jnp.einsum('bqhr,bkr->bhqk', qp, kp)).astype(jnp.float32)
        p = jax.nn.softmax(sc, axis=-1).astype(v.dtype)
        return jnp.einsum('bhqk,bkhd->bqhd', p, v)

    kn_all = jnp.concatenate([kn_c, kn_l], axis=1)
    kp_all = jnp.concatenate([kp_c, kp_l], axis=1)
    v_all = jnp.concatenate([v_c, v_l], axis=1)
    b, s = ul.shape[:2]
    ol = sweep_query_blocks(lambda qs: attend(qs[0], qs[1], kn_all, kp_all, v_all), (qn_l, qp_l))
    yl = ol.reshape(b, s, h * dv) @ wo
    yc = None
    if need_ctx:
        oc = attend(qn_c, qp_c, kn_c, kp_c, v_c)
        yc = oc.reshape(b, uc.shape[1], h * dv) @ wo
    return yl, yc


def na_mixer(ul, uc, wqkv, wo, rpb, need_ctx):
    h, dh = NA_HEADS, HEAD_DIM
    scale = dh ** -0.5

    def proj(u):
        b, n, _ = u.shape
        q, k, v = jnp.split(u @ wqkv, 3, axis=-1)
        return q.reshape(b, n, h, dh) * scale, k.reshape(b, n, h, dh), v.reshape(b, n, h, dh)

    ql, kl, vl = proj(ul)
    qc, kc, vc = proj(uc)
    b, s = ul.shape[:2]
    rows = s // GRID_W
    wr = min(NA_WIN_ROWS, rows)
    ncb = GRID_W // NA_QCOLS
    starts = [min(max(j * NA_QCOLS - NA_WIN_COLS // 2, 0), GRID_W - NA_KCOLS) for j in range(ncb)]
    qcol = np.arange(GRID_W).reshape(ncb, NA_QCOLS)
    c0 = np.clip(qcol - NA_WIN_COLS // 2, 0, GRID_W - NA_WIN_COLS)
    kcol = np.array(starts)[:, None] + np.arange(NA_KCOLS)[None, :]
    col_ok = (kcol[:, None, :] >= c0[:, :, None]) & (kcol[:, None, :] < c0[:, :, None] + NA_WIN_COLS)
    col_idx = np.clip(kcol[:, None, :] - qcol[:, :, None] + NA_WIN_COLS - 1, 0, 2 * NA_WIN_COLS - 2)
    nk = wr * NA_KCOLS
    mask = np.broadcast_to(col_ok[:, :, None, :], (ncb, NA_QCOLS, wr, NA_KCOLS)).reshape(ncb, NA_QCOLS, nk)
    kg = kl.reshape(b, rows, GRID_W, h, dh)
    vg = vl.reshape(b, rows, GRID_W, h, dh)
    rpb32 = rpb.astype(jnp.float32)

    def row_fn(args):
        r, qr = args
        r0 = jnp.clip(r - wr // 2, 0, rows - wr)

        def gather(t):
            tr = lax.dynamic_slice_in_dim(t, r0, wr, axis=1)
            tb = jnp.stack([tr[:, :, st:st + NA_KCOLS] for st in starts], axis=1)
            return tb.reshape(b, ncb, nk, h, dh)

        kb, vb = gather(kg), gather(vg)
        qb = qr.reshape(b, ncb, NA_QCOLS, h, dh)
        row_off = r0 + jnp.arange(wr) - r + NA_WIN_ROWS - 1
        bias = rpb32[:, row_off][:, :, col_idx]
        bias = bias.transpose(0, 2, 3, 1, 4).reshape(h, ncb, NA_QCOLS, nk)
        s_nb = jnp.einsum('bjqhd,bjkhd->bhjqk', qb, kb).astype(jnp.float32) + bias
        s_nb = jnp.where(mask, s_nb, NEG_INF)
        s_cx = jnp.einsum('bjqhd,bchd->bhjqc', qb, kc).astype(jnp.float32)
        p = jax.nn.softmax(jnp.concatenate([s_nb, s_cx], axis=-1), axis=-1).astype(vb.dtype)
        o = (jnp.einsum('bhjqk,bjkhd->bjqhd', p[..., :nk], vb)
             + jnp.einsum('bhjqc,bchd->bjqhd', p[..., nk:], vc))
        return o.reshape(b, GRID_W, h, dh)

    q_rows = jnp.moveaxis(ql.reshape(b, rows, GRID_W, h, dh), 1, 0)
    o = lax.map(row_fn, (jnp.arange(rows), q_rows))
    yl = jnp.moveaxis(o, 0, 1).reshape(b, s, h * dh) @ wo
    yc = None
    if need_ctx:
        sc = jnp.einsum('bqhd,bkhd->bhqk', qc, kc).astype(jnp.float32)
        pc = jax.nn.softmax(sc, axis=-1).astype(vc.dtype)
        yc = jnp.einsum('bhqk,bkhd->bqhd', pc, vc).reshape(b, uc.shape[1], h * dh) @ wo
    return yl, yc


def diff_lambda_init(layer):
    return 0.8 - 0.6 * math.exp(-0.3 * layer)


def setup_inputs(seed: int = 0) -> dict:
    key = jax.random.key(seed)
    ks = iter(jax.random.split(key, 32))

    def nrm(shape, std):
        return jax.random.normal(next(ks), shape, jnp.float32) * std

    def gain(shape):
        return 1.0 + nrm(shape, 0.01)

    d, f = D_MODEL, FFN_HIDDEN
    na, nb, nc, nd = [len(range(m, DEPTH, N_MIXERS)) for m in range(N_MIXERS)]
    swa_cols = (SWA_Q_HEADS + 2 * SWA_KV_HEADS) * HEAD_DIM
    swa_o = SWA_Q_HEADS * HEAD_DIM
    diff_o = DIFF_HEADS * 2 * HEAD_DIM
    mla_down = MLA_Q_RANK + MLA_KV_RANK + MLA_ROPE_DIM
    mla_o = MLA_HEADS * MLA_V_DIM
    na_o = NA_HEADS * HEAD_DIM
    return {
        'x': nrm((BATCH, SEQ, d), 1.0),
        'c': nrm((BATCH, d), 1.0),
        'ctx': nrm((BATCH, CTX_LEN, d), 1.0),
        'c_ctx': nrm((d,), 1.0),
        'mod_w': nrm((DEPTH, d, 6 * d), d ** -0.5),
        'mod_b': nrm((DEPTH, 6 * d), 0.01),
        'norm_g': gain((DEPTH, 4, d)),
        'ffn_w_gu': nrm((DEPTH, d, 2 * f), d ** -0.5),
        'ffn_w_down': nrm((DEPTH, f, d), f ** -0.5),
        'swa_wqkv': nrm((na, d, swa_cols), d ** -0.5),
        'swa_wo': nrm((na, swa_o, d), swa_o ** -0.5),
        'swa_sink': nrm((na, SWA_Q_HEADS), 0.5),
        'diff_wqkv': nrm((nb, d, 3 * diff_o), d ** -0.5),
        'diff_wo': nrm((nb, diff_o, d), diff_o ** -0.5),
        'diff_lambda': nrm((nb, 4, HEAD_DIM), 0.1),
        'diff_subln': gain((nb, 2 * HEAD_DIM)),
        'mla_wdown': nrm((nc, d, mla_down), d ** -0.5),
        'mla_q_norm': gain((nc, MLA_Q_RANK)),
        'mla_kv_norm': gain((nc, MLA_KV_RANK)),
        'mla_wuq': nrm((nc, MLA_Q_RANK, MLA_HEADS * (MLA_NOPE_DIM + MLA_ROPE_DIM)), MLA_Q_RANK ** -0.5),
        'mla_wukv': nrm((nc, MLA_KV_RANK, MLA_HEADS * (MLA_NOPE_DIM + MLA_V_DIM)), MLA_KV_RANK ** -0.5),
        'mla_wo': nrm((nc, mla_o, d), mla_o ** -0.5),
        'na_wqkv': nrm((nd, d, 3 * na_o), d ** -0.5),
        'na_wo': nrm((nd, na_o, d), na_o ** -0.5),
        'na_rpb': nrm((nd, NA_HEADS, 2 * NA_WIN_ROWS - 1, 2 * NA_WIN_COLS - 1), 0.1),
    }


def reference(x, c, ctx, c_ctx, mod_w, mod_b, norm_g, ffn_w_gu, ffn_w_down,
              swa_wqkv, swa_wo, swa_sink,
              diff_wqkv, diff_wo, diff_lambda, diff_subln,
              mla_wdown, mla_q_norm, mla_kv_norm, mla_wuq, mla_wukv, mla_wo,
              na_wqkv, na_wo, na_rpb):
    s = x.shape[1]
    ang_head = axial_angles(s, HEAD_DIM)
    ang_mla = axial_angles(s, MLA_ROPE_DIM)
    hl, hc = x, ctx
    for i in range(DEPTH):
        kind, j = i % N_MIXERS, i // N_MIXERS
        need_ctx = i < DEPTH - 1
        ml = [m[:, None, :] for m in adaln(c, mod_w[i], mod_b[i])]
        mc = adaln(c_ctx, mod_w[i], mod_b[i])
        g_pre_mix, g_post_mix, g_pre_ffn, g_post_ffn = norm_g[i]

        ul = rmsnorm(hl, g_pre_mix) * (1.0 + ml[1]) + ml[0]
        uc = rmsnorm(hc, g_pre_mix) * (1.0 + mc[1]) + mc[0]
        if kind == 0:
            yl, yc = swa_mixer(ul, uc, swa_wqkv[j], swa_wo[j], swa_sink[j], ang_head, need_ctx)
        elif kind == 1:
            yl, yc = diff_mixer(ul, uc, diff_wqkv[j], diff_wo[j], diff_lambda[j], diff_subln[j],
                                diff_lambda_init(i), ang_head, need_ctx)
        elif kind == 2:
            yl, yc = mla_mixer(ul, uc, mla_wdown[j], mla_q_norm[j], mla_kv_norm[j], mla_wuq[j],
                               mla_wukv[j], mla_wo[j], ang_mla, need_ctx)
        else:
            yl, yc = na_mixer(ul, uc, na_wqkv[j], na_wo[j], na_rpb[j], need_ctx)

        hl = hl + ml[2] * rmsnorm(yl, g_post_mix)
        fl = swiglu(rmsnorm(hl, g_pre_ffn) * (1.0 + ml[4]) + ml[3], ffn_w_gu[i], ffn_w_down[i])
        hl = hl + ml[5] * rmsnorm(fl, g_post_ffn)
        if need_ctx:
            hc = hc + mc[2] * rmsnorm(yc, g_post_mix)
            fc = swiglu(rmsnorm(hc, g_pre_ffn) * (1.0 + mc[4]) + mc[3], ffn_w_gu[i], ffn_w_down[i])
            hc = hc + mc[5] * rmsnorm(fc, g_post_ffn)
    return hl
```

```cpp
#include <hip/hip_runtime.h>
#include <cstdio>
#include <cstdint>

#define GAS __attribute__((address_space(1)))
#define LAS __attribute__((address_space(3)))
typedef unsigned short bf16;
typedef unsigned v4u __attribute__((ext_vector_type(4)));
typedef float f32x4 __attribute__((ext_vector_type(4)));
typedef float f32x2 __attribute__((ext_vector_type(2)));
typedef float f32x16 __attribute__((ext_vector_type(16)));
typedef short bf16x8 __attribute__((ext_vector_type(8)));
typedef short s16x4 __attribute__((ext_vector_type(4)));
typedef GAS unsigned gu32;

constexpr int DM = 2048, NBATCH = 4, SEQ = 4096, CTXL = 256, TPB = SEQ + CTXL  ;
constexpr int MROWS = NBATCH * TPB  , FF = 5632, NLAYER = 4, MODW = 6 * DM  ;
constexpr float EPS = 1e-6f;
constexpr float LOG2E = 1.4426950408889634f;

__device__ __forceinline__ unsigned cvt_pk_bf16(float lo, float hi) { unsigned r; asm volatile("v_cvt_pk_bf16_f32 %0, %1, %2" : "=v"(r) : "v"(lo), "v"(hi)); return r; }
__device__ __forceinline__ float bf2f(unsigned short h) { return __builtin_bit_cast(float, (unsigned)h << 16); }

namespace pg8 {
typedef unsigned short bf16_t;
constexpr int BM = 256, BK = 64, HALF = 128, HTB = HALF * BK * 2, STAGE_BYTES = 8 * HTB, NXCD = 8, WGM = 8;
__host__ __device__ __forceinline__ int lds_byte(int r, int c) { const int st = (r >> 4) * 2 + (c >> 5), rr = r & 15, cc = c & 31, ob = rr * 64 + cc * 2; return st * 1024 + (ob ^ (((ob >> 9) & 1) << 5)); }
__host__ __device__ __forceinline__ void stage_rc(int b, int& R, int& C) { const int st = b / 1024, sb = b % 1024, swz = sb ^ (((sb >> 9) & 1) << 5); R = (st >> 1) * 16 + swz / 64; C = (st & 1) * 32 + (swz % 64) / 2; }
__host__ __device__ __forceinline__ int perm32(int rho) { const int n = rho >> 4, i = rho & 15; return 8 * (i >> 2) + 4 * n + (i & 3); }

struct Unit { int pm, pn, ks, koff, nt; };
struct Gemm { const bf16_t* A; const bf16_t* Bt; int M, N, K, lda; };

struct StaticOrder {
    int nM, nN, nwg, G, c, ntK;
    __host__ __device__ void init(int M, int N, int K, int G_, int c_) { nM = M / BM; nN = N / BM; nwg = nM * nN; G = G_; c = c_; ntK = K / BK; }
    __host__ __device__ bool next(int i, Unit& u) const {
        const long L = (long)i * G + c; if (L >= nwg) return false;
        u.ks = -1; u.koff = 0; u.nt = ntK;
        int wgid = (int)L; { const int q = nwg / NXCD, r = nwg % NXCD, xcd = wgid % NXCD, off = wgid / NXCD; wgid = (xcd < r ? xcd * (q + 1) : r * (q + 1) + (xcd - r) * q) + off; }
        const int nig = WGM * nN, gid = wgid / nig, fm = gid * WGM, gsz = (nM - fm) < WGM ? (nM - fm) : WGM;
        u.pm = fm + ((wgid % nig) % gsz); u.pn = (wgid % nig) / gsz; return true;
    }
};
struct LatentOrder : StaticOrder {
    __host__ __device__ bool next(int i, Unit& u) const { if (!StaticOrder::next(i, u)) return false; u.pm = u.pm + (u.pm >> 4) + 1; return true; }
};
struct CtxSplitOrder : LatentOrder {
    int S, ntS;
    __host__ __device__ bool next(int i, Unit& u) const {
        if (LatentOrder::next(i, u)) return true;
        const long s = (long)i * G + c - nwg; if (s < 0 || s >= (long)4 * nN * S) return false;
        const int ks = (int)(s % S), t = (int)(s / S); u.pn = t % nN; u.pm = (t / nN) * 17; u.ks = ks; u.koff = ks * ntS * BK * 2; u.nt = ntS; return true;
    }
};

__device__ __forceinline__ void rope2(f32x4& v, const f32x4 t) {
    const float a0 = v[0] * t[0] - v[1] * t[1], a1 = v[0] * t[1] + v[1] * t[0], a2 = v[2] * t[2] - v[3] * t[3], a3 = v[2] * t[3] + v[3] * t[2];
    v = (f32x4){a0, a1, a2, a3};
}
__device__ __forceinline__ v4u pack8(const f32x4 v0, const f32x4 v1) { v4u w; w.x = cvt_pk_bf16(v0[0], v0[1]); w.y = cvt_pk_bf16(v0[2], v0[3]); w.z = cvt_pk_bf16(v1[0], v1[1]); w.w = cvt_pk_bf16(v1[2], v1[3]); return w; }
struct EpiF32 {
    static constexpr bool PERM = true;
    bf16_t* O; int ldc; float* YP;
    __device__ __forceinline__ void operator()(const f32x4 (&acc)[2][2][4][2], const Unit& u, int wr, int wc, int fr, int fq) const {
        const int col0 = u.pn * BM + wc * 32 + 8 * fq;
        if (u.ks >= 0) { const int row0 = u.ks * 1024 + (u.pm / 17) * BM + wr * 64 + fr;
#pragma unroll
            for (int ai = 0; ai < 2; ++ai)
#pragma unroll
                for (int m = 0; m < 4; ++m) { GAS float* rowp = (GAS float*)YP + (size_t)(row0 + ai * HALF + m * 16) * ldc + col0;
#pragma unroll
                    for (int bj = 0; bj < 2; ++bj)
#pragma unroll
                        for (int n = 0; n < 2; ++n) *(GAS f32x4*)(rowp + bj * HALF + n * 4) = acc[ai][bj][m][n]; }
        } else { const int row0 = u.pm * BM + wr * 64 + fr;
#pragma unroll
            for (int ai = 0; ai < 2; ++ai)
#pragma unroll
                for (int m = 0; m < 4; ++m) { GAS bf16_t* rowp = (GAS bf16_t*)O + (size_t)(row0 + ai * HALF + m * 16) * ldc + col0;
#pragma unroll
                    for (int bj = 0; bj < 2; ++bj) *(GAS v4u*)(rowp + bj * HALF) = pack8(acc[ai][bj][m][0], acc[ai][bj][m][1]); }
        }
    }
};
struct EpiQKV {
    static constexpr bool PERM = true;
    bf16_t* O; int ldc, nq, nrope; float qscale; const float* tab;
    bf16_t* KH; bf16_t* VH; int nk, gv;
    __device__ __forceinline__ void operator()(const f32x4 (&acc)[2][2][4][2], const Unit& u, int wr, int wc, int fr, int fq) const {
        const int row0 = u.pm * BM + wr * 64 + fr, col0 = u.pn * BM + wc * 32 + 8 * fq;
        const float sc = (u.pn < nq) ? qscale : 1.f;
        const int pb = u.pm % 17; const bool rope = (u.pn < nrope) && (pb != 0);
        const GAS f32x4* T = (const GAS f32x4*)tab;
        const bool hm = (KH != nullptr) && (u.pn >= nq);
#pragma unroll
        for (int ai = 0; ai < 2; ++ai)
#pragma unroll
            for (int m = 0; m < 4; ++m) { const int row = row0 + ai * HALF + m * 16;
                const int pos = (wc < 2) ? (4 * (pb - 1) + 2 * ai + wr) : (16 * m + fr);
#pragma unroll
                for (int bj = 0; bj < 2; ++bj) { f32x4 v0 = acc[ai][bj][m][0] * sc, v1 = acc[ai][bj][m][1] * sc;
                    if (rope) { const int k0 = 8 * (wc & 1) + 2 * fq; rope2(v0, T[pos * 16 + k0]); rope2(v1, T[pos * 16 + k0 + 1]); }
                    GAS bf16_t* dst;
                    if (!hm) dst = (GAS bf16_t*)O + (size_t)row * ldc + col0 + bj * HALF;
                    else { const int ci = (u.pn - nq) * 2 + bj, cc = wc * 32 + 8 * fq;
                        if (ci < nk) dst = (GAS bf16_t*)KH + ((size_t)ci * MROWS + row) * 128 + cc;
                        else { const int cv = ci - nk, hd = cv / gv, part = cv - hd * gv; dst = (GAS bf16_t*)VH + ((size_t)hd * MROWS + row) * (128 * gv) + part * 128 + cc; } }
                    *(GAS v4u*)dst = pack8(v0, v1); } }
    }
};
struct EpiSwiGLU {
    static constexpr bool PERM = true;
    bf16_t* O; int ldc;
    __device__ __forceinline__ void operator()(const f32x4 (&acc)[2][2][4][2], const Unit& u, int wr, int wc, int fr, int fq) const {
        const int row0 = u.pm * BM + wr * 64 + fr, col0 = u.pn * HALF + wc * 32 + 8 * fq;
#pragma unroll
        for (int ai = 0; ai < 2; ++ai)
#pragma unroll
            for (int m = 0; m < 4; ++m) { GAS bf16_t* rowp = (GAS bf16_t*)O + (size_t)(row0 + ai * HALF + m * 16) * ldc + col0;
                f32x4 o[2];
#pragma unroll
                for (int n = 0; n < 2; ++n) { const f32x4 g = acc[ai][0][m][n], up = acc[ai][1][m][n];
#pragma unroll
                    for (int e = 0; e < 4; ++e) { const float s = __builtin_amdgcn_rcpf(1.f + __builtin_amdgcn_exp2f(-g[e] * LOG2E)); o[n][e] = g[e] * s * up[e]; } }
                *(GAS v4u*)rowp = pack8(o[0], o[1]); }
    }
};
struct EpiMlaDown {
    static constexpr bool PERM = true;
    bf16_t* C; bf16_t* KPE; float* SSQ; const float* tab64;
    __device__ __forceinline__ void operator()(const f32x4 (&acc)[2][2][4][2], const Unit& u, int wr, int wc, int fr, int fq) const {
        const int row0 = u.pm * BM + wr * 64 + fr; const int pb = u.pm % 17;
        if (u.pn < 4) {
            const int col0 = u.pn * BM + wc * 32 + 8 * fq;
#pragma unroll
            for (int ai = 0; ai < 2; ++ai)
#pragma unroll
                for (int m = 0; m < 4; ++m) { const int row = row0 + ai * HALF + m * 16; GAS bf16_t* rowp = (GAS bf16_t*)C + (size_t)row * 1024 + col0; float ss = 0.f;
#pragma unroll
                    for (int bj = 0; bj < 2; ++bj) { const f32x4 v0 = acc[ai][bj][m][0], v1 = acc[ai][bj][m][1];
                        ss += (v0[0] * v0[0] + v0[1] * v0[1]) + (v0[2] * v0[2] + v0[3] * v0[3]) + (v1[0] * v1[0] + v1[1] * v1[1]) + (v1[2] * v1[2] + v1[3] * v1[3]);
                        *(GAS v4u*)(rowp + bj * HALF) = pack8(v0, v1); }
                    ss += __shfl_xor(ss, 16); ss += __shfl_xor(ss, 32);
                    if (fq == 0) ((GAS float*)SSQ)[(size_t)row * 16 + u.pn * 4 + wc] = ss; }
        } else if (wc < 2) {
            const GAS f32x4* T = (const GAS f32x4*)tab64;
#pragma unroll
            for (int ai = 0; ai < 2; ++ai)
#pragma unroll
                for (int m = 0; m < 4; ++m) { const int row = row0 + ai * HALF + m * 16; f32x4 v0 = acc[ai][0][m][0], v1 = acc[ai][0][m][1];
                    if (pb != 0) { const int pos = (wc == 0) ? (4 * (pb - 1) + 2 * ai + wr) : (16 * m + fr); rope2(v0, T[pos * 8 + 2 * fq]); rope2(v1, T[pos * 8 + 2 * fq + 1]); }
                    *(GAS v4u*)((GAS bf16_t*)KPE + (size_t)row * 64 + wc * 32 + 8 * fq) = pack8(v0, v1); }
        }
    }
};
template <bool ROPE> struct EpiMlaUp {
    static constexpr bool PERM = true;
    bf16_t* O; int ldc; const float* SSQ; int which; float scale; const float* tab64;
    __device__ __forceinline__ void operator()(const f32x4 (&acc)[2][2][4][2], const Unit& u, int wr, int wc, int fr, int fq) const {
        const int row0 = u.pm * BM + wr * 64 + fr, col0 = u.pn * BM + wc * 32 + 8 * fq; const int pb = u.pm % 17;
        const GAS f32x4* T = (const GAS f32x4*)tab64;
#pragma unroll
        for (int ai = 0; ai < 2; ++ai)
#pragma unroll
            for (int m = 0; m < 4; ++m) { const int row = row0 + ai * HALF + m * 16; GAS bf16_t* rowp = (GAS bf16_t*)O + (size_t)row * ldc + col0;
                const GAS f32x4* sp = (const GAS f32x4*)((const GAS float*)SSQ + (size_t)row * 16 + which * 8); const f32x4 s0 = sp[0], s1 = sp[1];
                const float ss = ((s0[0] + s0[1]) + (s0[2] + s0[3])) + ((s1[0] + s1[1]) + (s1[2] + s1[3]));
                const float rs = __builtin_amdgcn_rsqf(ss * (1.f / 512.f) + EPS) * scale;
#pragma unroll
                for (int bj = 0; bj < 2; ++bj) { f32x4 v0 = acc[ai][bj][m][0] * rs, v1 = acc[ai][bj][m][1] * rs;
                    if (ROPE) { const int g = (u.pn * BM + bj * HALF + wc * 32) % 192;
                        if (g >= 128 && pb != 0) { const int pos = (g == 128) ? (4 * (pb - 1) + 2 * ai + wr) : (16 * m + fr); rope2(v0, T[pos * 8 + 2 * fq]); rope2(v1, T[pos * 8 + 2 * fq + 1]); } }
                    *(GAS v4u*)(rowp + bj * HALF) = pack8(v0, v1); } }
    }
};

template <class Epi, class Sched>
__device__ __forceinline__ void gemm_phase(LAS unsigned char* lds, const Gemm g, const Sched& S, const Epi& E) {
    const int tid = threadIdx.x, wid = __builtin_amdgcn_readfirstlane(tid >> 6), lane = tid & 63, wr = wid >> 2, wc = wid & 3, fr = lane & 15, fq = lane >> 4;
    const int K = g.K, lda = g.lda;
    unsigned voffA[2], voffB[2];
#pragma unroll
    for (int i = 0; i < 2; ++i) { int R, C; stage_rc(tid * 16 + i * 8192, R, C); const int Rb = Epi::PERM ? ((R & ~31) + perm32(R & 31)) : R;
        voffA[i] = (unsigned)(R * lda + C) * 2u; voffB[i] = (unsigned)(Rb * K + C) * 2u; }
    const size_t kstep = (size_t)(BK * 2);
    const size_t hsA = (size_t)HALF * lda * 2, hsB = (size_t)HALF * K * 2;
    const size_t tsA = 2 * hsA, tsB = 2 * hsB;
    const unsigned ldsw = (unsigned)wid * 1024u;
    const int aoff = lds_byte(wr * 64 + fr, fq * 8), boff = lds_byte(wc * 32 + fr, fq * 8);
#define PG8_SA(b, h) (((b) * 2 + (h)) * HTB)
#define PG8_SB(b, h) ((4 + (b) * 2 + (h)) * HTB)
#define PG8_STAGE(bufoff, gbase, voff) do { _Pragma("unroll") for (int _i = 0; _i < 2; ++_i) \
        __builtin_amdgcn_global_load_lds((const unsigned*)((const char*)(gbase) + (voff)[_i]), (LAS unsigned*)(lds + (bufoff) + ldsw + _i * 8192), 16, 0, 0); } while (0)
#define PG8_LDA(dst, b, h) do { _Pragma("unroll") for (int m = 0; m < 4; ++m) _Pragma("unroll") for (int k = 0; k < 2; ++k) dst[m][k] = *(const LAS bf16x8*)(lds + PG8_SA(b, h) + aoff + m * 2048 + k * 1024); } while (0)
#define PG8_LDB(dst, b, h) do { _Pragma("unroll") for (int n = 0; n < 2; ++n) _Pragma("unroll") for (int k = 0; k < 2; ++k) dst[n][k] = *(const LAS bf16x8*)(lds + PG8_SB(b, h) + boff + n * 2048 + k * 1024); } while (0)
#define PG8_MMA(ai, bj, At, Bt) do { __builtin_amdgcn_s_setprio(1); _Pragma("unroll") for (int m = 0; m < 4; ++m) _Pragma("unroll") for (int n = 0; n < 2; ++n) _Pragma("unroll") for (int k = 0; k < 2; ++k) \
        acc[ai][bj][m][n] = __builtin_amdgcn_mfma_f32_16x16x32_bf16(Bt[n][k], At[m][k], acc[ai][bj][m][n], 0, 0, 0); __builtin_amdgcn_s_setprio(0); } while (0)
#define PG8_WAIT_V(n) asm volatile("s_waitcnt vmcnt(" #n ")" ::: "memory")
#define PG8_WAIT_L(n) asm volatile("s_waitcnt lgkmcnt(" #n ")" ::: "memory")
#define PG8_BAR __builtin_amdgcn_s_barrier()
#define PG8_SCHED __builtin_amdgcn_sched_barrier(0)
    Unit cur, nxt; int ui = 0;
    if (!S.next(0, cur)) return;
    f32x4 acc[2][2][4][2];
#pragma unroll
    for (int a = 0; a < 2; ++a)
#pragma unroll
        for (int b = 0; b < 2; ++b)
#pragma unroll
            for (int m = 0; m < 4; ++m)
#pragma unroll
                for (int n = 0; n < 2; ++n) acc[a][b][m][n] = (f32x4){0.f, 0.f, 0.f, 0.f};
    bf16x8 At[4][2], B0[2][2], B1[2][2];
    const char* cA = (const char*)g.A + (size_t)cur.pm * tsA + cur.koff; const char* cB = (const char*)g.Bt + (size_t)cur.pn * tsB + cur.koff;
    PG8_STAGE(PG8_SB(0, 0), cB, voffB); PG8_STAGE(PG8_SB(0, 1), cB + hsB, voffB); PG8_STAGE(PG8_SA(0, 0), cA, voffA); PG8_STAGE(PG8_SA(0, 1), cA + hsA, voffA);
    if (wr == 1) PG8_BAR;
    PG8_WAIT_V(2); PG8_BAR;
    PG8_STAGE(PG8_SB(1, 0), cB + kstep, voffB); PG8_STAGE(PG8_SA(1, 0), cA + kstep, voffA); PG8_STAGE(PG8_SB(1, 1), cB + hsB + kstep, voffB);
    PG8_WAIT_V(6); PG8_BAR;
    for (;;) {
        const bool has_next = S.next(ui + 1, nxt);
        const char* nA = has_next ? (const char*)g.A + (size_t)nxt.pm * tsA + nxt.koff : cA; const char* nB = has_next ? (const char*)g.Bt + (size_t)nxt.pn * tsB + nxt.koff : cB;
        const int nt = cur.nt;
        for (int t = 0; t < nt; t += 2) {
            const bool last = (t == nt - 2);
            const char* a1 = cA + (size_t)(t + 1) * kstep;
            const char* a2 = last ? nA : cA + (size_t)(t + 2) * kstep; const char* b2 = last ? nB : cB + (size_t)(t + 2) * kstep;
            const char* a3 = a2 + kstep; const char* b3 = b2 + kstep;
            PG8_LDB(B0, 0, 0); PG8_LDB(B1, 0, 1); PG8_SCHED; PG8_LDA(At, 0, 0); PG8_STAGE(PG8_SA(1, 1), a1 + hsA, voffA);
            PG8_WAIT_V(8); PG8_WAIT_L(0); PG8_BAR; PG8_MMA(0, 0, At, B0); PG8_MMA(0, 1, At, B1); PG8_BAR; PG8_SCHED;
            PG8_LDA(At, 0, 1); PG8_STAGE(PG8_SB(0, 0), b2, voffB); PG8_STAGE(PG8_SB(0, 1), b2 + hsB, voffB); PG8_STAGE(PG8_SA(0, 0), a2, voffA);
            PG8_WAIT_V(8); PG8_WAIT_L(0); PG8_BAR; PG8_MMA(1, 0, At, B0); PG8_MMA(1, 1, At, B1); PG8_BAR; PG8_SCHED;
            PG8_LDB(B0, 1, 0); PG8_LDB(B1, 1, 1); PG8_SCHED; PG8_LDA(At, 1, 0); PG8_STAGE(PG8_SA(0, 1), a2 + hsA, voffA);
            PG8_WAIT_V(8); PG8_WAIT_L(0); PG8_BAR; PG8_MMA(0, 0, At, B0); PG8_MMA(0, 1, At, B1); PG8_BAR; PG8_SCHED;
            PG8_LDA(At, 1, 1); PG8_STAGE(PG8_SB(1, 0), b3, voffB); PG8_STAGE(PG8_SB(1, 1), b3 + hsB, voffB); PG8_STAGE(PG8_SA(1, 0), a3, voffA);
            PG8_WAIT_V(8); PG8_WAIT_L(0); PG8_BAR; PG8_MMA(1, 0, At, B0); PG8_MMA(1, 1, At, B1); PG8_BAR; PG8_SCHED;
        }
        if (wr == 0) PG8_BAR;
        E(acc, cur, wr, wc, fr, fq);
        if (!has_next) break;
#pragma unroll
        for (int a = 0; a < 2; ++a)
#pragma unroll
            for (int b = 0; b < 2; ++b)
#pragma unroll
                for (int m = 0; m < 4; ++m)
#pragma unroll
                    for (int n = 0; n < 2; ++n) acc[a][b][m][n] = (f32x4){0.f, 0.f, 0.f, 0.f};
        cur = nxt; cA = nA; cB = nB; ++ui;
        if (wr == 1) PG8_BAR;
    }
    PG8_WAIT_V(0);
    PG8_BAR;
#undef PG8_SA
#undef PG8_SB
#undef PG8_STAGE
#undef PG8_LDA
#undef PG8_LDB
#undef PG8_MMA
#undef PG8_WAIT_V
#undef PG8_WAIT_L
#undef PG8_BAR
#undef PG8_SCHED
}
}
namespace attn {
constexpr int NW = 8, QBLK = 32, KVBLK = 64;
constexpr int SHM_V = KVBLK * 128 * 2, SHM_K = KVBLK * 128 * 2, SHM_K2 = KVBLK * 64 * 2;
constexpr int L_V = 0, L_K = 2 * SHM_V, L_K2 = L_K + 2 * SHM_K, L_WS = L_K2 + 2 * SHM_K2, L_RPB = L_WS + NW * 64 * 4, L_Q2 = L_RPB + 2048, L_END = L_Q2 + NW * 4096;
constexpr float THR = 8.f;
#define KSWZ(row, colB) ((row) * 256 + ((colB) ^ (((row) & 7) << 4)))
#define K2SWZ(row, colB) ((row) * 128 + ((colB) ^ (((row) & 7) << 4)))
#define SBAR() __builtin_amdgcn_sched_barrier(0)
__device__ __forceinline__ int crow(int r, int hi) { return (r & 3) + 8 * (r >> 2) + 4 * hi; }

struct Desc {
    const bf16* Q; const bf16* K; const bf16* V; const bf16* K2; bf16* O;
    int ldq, ldk, ldv, ldo;
    int row_ctx, row_lat;
    int NT, NTreal;
    float m0, l0;
    int a0, a1;
    const float* rpb;
    int rot;
};

__device__ __forceinline__ void partialSM(f32x16& p0, f32x16& p1, float& m_reg, float& mn, float& alpha) {
  constexpr float C = LOG2E;
  float pmax = p0[0];
#pragma unroll
  for (int r = 1; r < 16; ++r) pmax = fmaxf(pmax, p0[r]);
#pragma unroll
  for (int r = 0; r < 16; ++r) pmax = fmaxf(pmax, p1[r]);
  { auto rr = __builtin_amdgcn_permlane32_swap(__float_as_uint(pmax), __float_as_uint(pmax), false, false);
    pmax = fmaxf(__uint_as_float(rr[0]), __uint_as_float(rr[1])); }
  if (__builtin_expect(__all(pmax - m_reg <= THR), 1)) { mn = m_reg; alpha = 1.f; }
  else { mn = fmaxf(m_reg, pmax); alpha = __builtin_amdgcn_exp2f((m_reg - mn) * C); m_reg = mn; }
  float mnC = -mn * C;
#pragma unroll
  for (int r = 0; r < 16; ++r) p0[r] = fmaf(p0[r], C, mnC);
#pragma unroll
  for (int r = 0; r < 16; ++r) p1[r] = fmaf(p1[r], C, mnC);
#pragma unroll
  for (int r = 0; r < 16; ++r) p0[r] = __builtin_amdgcn_exp2f(p0[r]);
}
__device__ __forceinline__ void finishSM(f32x16& p0, f32x16& p1, float alpha, float& l_reg, bf16x8& pa0, bf16x8& pa1, bf16x8& pa2, bf16x8& pa3) {
#pragma unroll
  for (int r = 0; r < 16; ++r) p1[r] = __builtin_amdgcn_exp2f(p1[r]);
  float ps = 0;
#pragma unroll
  for (int r = 0; r < 16; ++r) ps += p0[r];
#pragma unroll
  for (int r = 0; r < 16; ++r) ps += p1[r];
  { auto rr = __builtin_amdgcn_permlane32_swap(__float_as_uint(ps), __float_as_uint(ps), false, false);
    ps = __uint_as_float(rr[0]) + __uint_as_float(rr[1]); }
  l_reg = l_reg * alpha + ps;
#define PK4(P, BASE, OUT) do { unsigned a0 = cvt_pk_bf16(P[BASE + 0], P[BASE + 1]), a1 = cvt_pk_bf16(P[BASE + 2], P[BASE + 3]);   \
    unsigned b0 = cvt_pk_bf16(P[BASE + 4], P[BASE + 5]), b1 = cvt_pk_bf16(P[BASE + 6], P[BASE + 7]);                              \
    auto r0 = __builtin_amdgcn_permlane32_swap(a0, b0, false, false); auto r1 = __builtin_amdgcn_permlane32_swap(a1, b1, false, false); \
    v4u w = {r0[0], r1[0], r0[1], r1[1]}; OUT = __builtin_bit_cast(bf16x8, w); } while (0)
  PK4(p0, 0, pa0); PK4(p0, 8, pa1); PK4(p1, 0, pa2); PK4(p1, 8, pa3);
#undef PK4
}
template <bool K2, int NQR>
__device__ __forceinline__ void qkt(f32x16& p0, f32x16& p1, const LAS char* Ks, const LAS char* K2s, const bf16x8* qr, const LAS char* q2l, int r32, int hi) {
  p0 = f32x16{}; p1 = f32x16{};
#pragma unroll
  for (int d0 = 0; d0 < 8; ++d0) { int cb = (d0 * 16 + hi * 8) * 2;
    bf16x8 b0 = *(const LAS bf16x8*)(Ks + KSWZ(r32, cb));
    bf16x8 b1 = *(const LAS bf16x8*)(Ks + KSWZ(32 + r32, cb));
    bf16x8 q; if constexpr (true) { if (d0 < NQR) q = qr[d0 < NQR ? d0 : 0]; else q = *(const LAS bf16x8*)(q2l + (d0 - NQR) * 1024); }
    p0 = __builtin_amdgcn_mfma_f32_32x32x16_bf16(b0, q, p0, 0, 0, 0);
    p1 = __builtin_amdgcn_mfma_f32_32x32x16_bf16(b1, q, p1, 0, 0, 0); }
  if constexpr (K2) {
#pragma unroll
    for (int d0 = 0; d0 < 4; ++d0) { int cb = (d0 * 16 + hi * 8) * 2;
      bf16x8 b0 = *(const LAS bf16x8*)(K2s + K2SWZ(r32, cb));
      bf16x8 b1 = *(const LAS bf16x8*)(K2s + K2SWZ(32 + r32, cb));
      const bf16x8 q2 = *(const LAS bf16x8*)(q2l + (8 - NQR + d0) * 1024);
      p0 = __builtin_amdgcn_mfma_f32_32x32x16_bf16(b0, q2, p0, 0, 0, 0);
      p1 = __builtin_amdgcn_mfma_f32_32x32x16_bf16(b1, q2, p1, 0, 0, 0); }
  }
}
__device__ __forceinline__ int v_st(int k, int c) { const int kk = (k & ~0xC) | ((k & 4) << 1) | ((k & 8) >> 1); return ((kk >> 3) * 4 + (c >> 5)) * 512 + ((kk & 7) * 32 + (c & 31)) * 2; }
__device__ __forceinline__ int v_rd_base(int lane) { return ((lane & 3) << 3) | (((lane >> 2) & 3) << 6) | (((lane >> 4) & 1) << 5) | (((lane >> 5) & 1) << 8); }
constexpr int v_rd_off(int d0, int ks, int half) { return d0 * 512 + ks * 4096 + half * 2048; }
template <int OFF> __device__ __forceinline__ s16x4 tr_read(int vb) {
  s16x4 r; asm volatile("ds_read_b64_tr_b16 %0, %1 offset:%2" : "=&v"(r) : "v"(vb), "i"(OFF) : "memory"); return r;
}
template <int D0> __device__ __forceinline__ void pv_one(f32x16& od, int vb, bf16x8 pa0, bf16x8 pa1, bf16x8 pa2, bf16x8 pa3) {
  const s16x4 l0 = tr_read<v_rd_off(D0, 0, 0)>(vb), h0 = tr_read<v_rd_off(D0, 0, 1)>(vb), l1 = tr_read<v_rd_off(D0, 1, 0)>(vb), h1 = tr_read<v_rd_off(D0, 1, 1)>(vb);
  const s16x4 l2 = tr_read<v_rd_off(D0, 2, 0)>(vb), h2 = tr_read<v_rd_off(D0, 2, 1)>(vb), l3 = tr_read<v_rd_off(D0, 3, 0)>(vb), h3 = tr_read<v_rd_off(D0, 3, 1)>(vb);
  asm volatile("s_waitcnt lgkmcnt(0)" ::: "memory"); SBAR();
#define PK(L, H) (bf16x8){L[0], L[1], L[2], L[3], H[0], H[1], H[2], H[3]}
  od = __builtin_amdgcn_mfma_f32_32x32x16_bf16(pa0, PK(l0, h0), od, 0, 0, 0);
  od = __builtin_amdgcn_mfma_f32_32x32x16_bf16(pa1, PK(l1, h1), od, 0, 0, 0);
  od = __builtin_amdgcn_mfma_f32_32x32x16_bf16(pa2, PK(l2, h2), od, 0, 0, 0);
  od = __builtin_amdgcn_mfma_f32_32x32x16_bf16(pa3, PK(l3, h3), od, 0, 0, 0);
#undef PK
}
__device__ __forceinline__ void pv_d0(f32x16* o, int vb, bf16x8 pa0, bf16x8 pa1, bf16x8 pa2, bf16x8 pa3) {
  pv_one<0>(o[0], vb, pa0, pa1, pa2, pa3); pv_one<1>(o[1], vb, pa0, pa1, pa2, pa3); pv_one<2>(o[2], vb, pa0, pa1, pa2, pa3); pv_one<3>(o[3], vb, pa0, pa1, pa2, pa3);
}
__device__ __forceinline__ void qkt_pf(f32x16& p0, f32x16& p1, const LAS char* Ks, const bf16x8* qr, int r32, int hi) {
  bf16x8 kf[16];
#pragma unroll
  for (int d0 = 0; d0 < 8; ++d0) { const int cb = (d0 * 16 + hi * 8) * 2; kf[2 * d0] = *(const LAS bf16x8*)(Ks + KSWZ(r32, cb)); kf[2 * d0 + 1] = *(const LAS bf16x8*)(Ks + KSWZ(32 + r32, cb)); }
  SBAR();
  p0 = f32x16{}; p1 = f32x16{};
#pragma unroll
  for (int d0 = 0; d0 < 8; ++d0) { p0 = __builtin_amdgcn_mfma_f32_32x32x16_bf16(kf[2 * d0], qr[d0], p0, 0, 0, 0); p1 = __builtin_amdgcn_mfma_f32_32x32x16_bf16(kf[2 * d0 + 1], qr[d0], p1, 0, 0, 0); }
}
template <int D0> __device__ __forceinline__ void vfrag(s16x4 (&f)[8], int vb) {
  f[0] = tr_read<v_rd_off(D0, 0, 0)>(vb); f[1] = tr_read<v_rd_off(D0, 0, 1)>(vb); f[2] = tr_read<v_rd_off(D0, 1, 0)>(vb); f[3] = tr_read<v_rd_off(D0, 1, 1)>(vb);
  f[4] = tr_read<v_rd_off(D0, 2, 0)>(vb); f[5] = tr_read<v_rd_off(D0, 2, 1)>(vb); f[6] = tr_read<v_rd_off(D0, 3, 0)>(vb); f[7] = tr_read<v_rd_off(D0, 3, 1)>(vb);
}
__device__ __forceinline__ void pv4(f32x16& od, const s16x4 (&f)[8], bf16x8 pa0, bf16x8 pa1, bf16x8 pa2, bf16x8 pa3) {
#define PK(L, H) (bf16x8){L[0], L[1], L[2], L[3], H[0], H[1], H[2], H[3]}
  od = __builtin_amdgcn_mfma_f32_32x32x16_bf16(pa0, PK(f[0], f[1]), od, 0, 0, 0);
  od = __builtin_amdgcn_mfma_f32_32x32x16_bf16(pa1, PK(f[2], f[3]), od, 0, 0, 0);
  od = __builtin_amdgcn_mfma_f32_32x32x16_bf16(pa2, PK(f[4], f[5]), od, 0, 0, 0);
  od = __builtin_amdgcn_mfma_f32_32x32x16_bf16(pa3, PK(f[6], f[7]), od, 0, 0, 0);
#undef PK
}
__device__ __forceinline__ void pv_pipe(f32x16* o, int vb, bf16x8 pa0, bf16x8 pa1, bf16x8 pa2, bf16x8 pa3) {
  s16x4 fa[8], fb[8];
  vfrag<0>(fa, vb); SBAR();
  vfrag<1>(fb, vb); asm volatile("s_waitcnt lgkmcnt(8)" ::: "memory"); SBAR(); pv4(o[0], fa, pa0, pa1, pa2, pa3); SBAR();
  vfrag<2>(fa, vb); asm volatile("s_waitcnt lgkmcnt(8)" ::: "memory"); SBAR(); pv4(o[1], fb, pa0, pa1, pa2, pa3); SBAR();
  vfrag<3>(fb, vb); asm volatile("s_waitcnt lgkmcnt(8)" ::: "memory"); SBAR(); pv4(o[2], fa, pa0, pa1, pa2, pa3); SBAR();
  asm volatile("s_waitcnt lgkmcnt(0)" ::: "memory"); SBAR(); pv4(o[3], fb, pa0, pa1, pa2, pa3);
}
template <int MODE>
__device__ __forceinline__ void mask_tile(f32x16& p0, f32x16& p1, const Desc& d, int j, int wid, int r32, int hi, const LAS float* rpbL) {
  if constexpr (MODE == 1) {
    if (j >= 4) { const int base = d.a0 + 64 * (j - 4) - (wid * 32 + r32);
#pragma unroll
      for (int r = 0; r < 16; ++r) { const int dd = base + crow(r, hi); if (dd > 128 || dd < -128) p0[r] = -1e30f; if (dd + 32 > 128 || dd + 32 < -128) p1[r] = -1e30f; } }
  } else if constexpr (MODE == 2) {
    if (j >= 4) {
      const int kr = d.a0 + (j - 4), qr_ = d.a1 + (wid >> 1), c = 32 * (wid & 1) + r32;
      int r0 = qr_ - 4; r0 = r0 < 0 ? 0 : (r0 > 56 ? 56 : r0); int c0 = c - 8; c0 = c0 < 0 ? 0 : (c0 > 48 ? 48 : c0);
      asm volatile("" : "+v"(c0));
      const bool rv = (j < d.NTreal) && (kr >= r0) && (kr < r0 + 8);
      if (!rv) {
#pragma unroll
        for (int r = 0; r < 16; ++r) { p0[r] = -1e30f; p1[r] = -1e30f; }
      } else { const LAS float* brow = rpbL + (kr - qr_ + 7) * 31 + (15 - c);
#pragma unroll
        for (int rc = 0; rc < 16; rc += 4) {
#pragma unroll
          for (int r = rc; r < rc + 4; ++r) { const int k0 = crow(r, hi), k1 = k0 + 32; const bool ok0 = (unsigned)(k0 - c0) < 16u, ok1 = (unsigned)(k1 - c0) < 16u;
            const float b0 = brow[ok0 ? k0 : c], b1 = brow[ok1 ? k1 : c];
            p0[r] = ok0 ? p0[r] + b0 : -1e30f; p1[r] = ok1 ? p1[r] + b1 : -1e30f; }
          SBAR(); } }
    }
  }
}

template <int MODE, bool K2, int SDEPTH, int NQR>
__device__ __forceinline__ void unit(const Desc& d, LAS char* lds) {
  static_assert((K2 ? 12 : 8) - NQR <= 4, "at most four Q fragments live in LDS");
  const int tid = threadIdx.x, wid = __builtin_amdgcn_readfirstlane(tid >> 6), lane = tid & 63, r32 = lane & 31, hi = lane >> 5;
  LAS char* V_lds = lds + L_V; LAS char* K_lds = lds + L_K; LAS char* K2_lds = lds + L_K2;
  LAS float* ws = (LAS float*)(lds + L_WS) + wid * 64; LAS float* li_l = ws; LAS float* al_l = ws + 32;
  LAS float* rpbL = (LAS float*)(lds + L_RPB);
  if constexpr (MODE == 2) { if (tid < 465) rpbL[tid] = ((const GAS float*)d.rpb)[tid]; }
  float m_reg = d.m0, l_reg = d.l0; f32x16 o[4] = {}; bf16x8 qr[NQR];
  LAS char* q2l = lds + L_Q2 + wid * 4096 + lane * 16;
  { const GAS bf16* Qw = (const GAS bf16*)d.Q + (long)(wid * QBLK + r32) * d.ldq + hi * 8;
#pragma unroll
    for (int d0 = 0; d0 < NQR; ++d0) qr[d0] = *(const GAS bf16x8*)(Qw + d0 * 16);
#pragma unroll
    for (int d0 = NQR; d0 < (K2 ? 12 : 8); ++d0) *(LAS bf16x8*)(q2l + (d0 - NQR) * 1024) = *(const GAS bf16x8*)(Qw + d0 * 16); }
  const int sr = tid >> 4, sc = (tid & 15) * 8, vst0 = v_st(sr, sc), vst1 = v_st(32 + sr, sc);
  const int vb0 = (int)(unsigned)(uintptr_t)V_lds + v_rd_base(lane);
  const GAS bf16* Kp = (const GAS bf16*)d.K + (long)sr * d.ldk + sc; const GAS bf16* Vp = (const GAS bf16*)d.V + (long)sr * d.ldv + sc;
  const GAS bf16* K2p = K2 ? (const GAS bf16*)d.K2 + (long)(tid >> 3) * 64 + (tid & 7) * 8 : nullptr;
  const int k2st = K2SWZ(tid >> 3, (tid & 7) * 16);
  struct { bf16x8 vs0, vs1, ks0, ks1, k2; } sr_[SDEPTH];
  const int NT = d.NT, NTr = d.NTreal;
#define TROW(j) ((j) < 4 ? d.row_ctx + 64 * (j) : d.row_lat + 64 * (((j) < NTr ? (j) : NTr - 1) - 4))
#define SLOAD(i, j) do { const long kr_ = TROW(j); sr_[i].vs0 = *(const GAS bf16x8*)(Vp + kr_ * d.ldv); sr_[i].vs1 = *(const GAS bf16x8*)(Vp + (kr_ + 32) * d.ldv); \
    sr_[i].ks0 = *(const GAS bf16x8*)(Kp + kr_ * d.ldk); sr_[i].ks1 = *(const GAS bf16x8*)(Kp + (kr_ + 32) * d.ldk); \
    if constexpr (K2) sr_[i].k2 = *(const GAS bf16x8*)(K2p + kr_ * 64); } while (0)
#define SWRITE(b, i) do { *(LAS bf16x8*)(V_lds + (b) * SHM_V + vst0) = sr_[i].vs0; *(LAS bf16x8*)(V_lds + (b) * SHM_V + vst1) = sr_[i].vs1; const int kc = sc * 2; \
    *(LAS bf16x8*)(K_lds + (b) * SHM_K + KSWZ(sr, kc)) = sr_[i].ks0; *(LAS bf16x8*)(K_lds + (b) * SHM_K + KSWZ(32 + sr, kc)) = sr_[i].ks1; \
    if constexpr (K2) *(LAS bf16x8*)(K2_lds + (b) * SHM_K2 + k2st) = sr_[i].k2; } while (0)
#define SWAIT() do { if constexpr (SDEPTH == 2) asm volatile("s_waitcnt vmcnt(4)" ::: "memory"); else asm volatile("s_waitcnt vmcnt(0)" ::: "memory"); } while (0)
#define RESC(a) do { if (__any((a) < 1.f)) { if (hi == 0) al_l[r32] = (a); asm volatile("s_waitcnt lgkmcnt(0)" ::: "memory"); \
    _Pragma("unroll") for (int dd = 0; dd < 4; ++dd) _Pragma("unroll") for (int r = 0; r < 16; ++r) o[dd][r] *= al_l[crow(r, hi)]; } } while (0)
  f32x16 pA0, pA1, pB0, pB1; float mnA, mnB, alA, alB; bf16x8 pa0, pa1, pa2, pa3;
  constexpr int SE = 0, SO = SDEPTH - 1;
  SLOAD(SE, 0); asm volatile("s_waitcnt vmcnt(0)" ::: "memory"); SWRITE(0, SE); __syncthreads();
  qkt<K2, NQR>(pA0, pA1, K_lds, K2_lds, qr, q2l, r32, hi); partialSM(pA0, pA1, m_reg, mnA, alA);
  SLOAD(SO, 1); if constexpr (SDEPTH == 2) { if (2 < NT) SLOAD(SE, 2); }
  SWAIT(); SWRITE(1, SO); __syncthreads();
  for (int j = 1; j + 1 < NT; j += 2) {
    SBAR(); qkt<K2, NQR>(pB0, pB1, K_lds + SHM_K, K2_lds + SHM_K2, qr, q2l, r32, hi);
    finishSM(pA0, pA1, alA, l_reg, pa0, pa1, pa2, pa3); SBAR();
    SLOAD(SO, j + SDEPTH); SBAR();
    pv_d0(o, vb0, pa0, pa1, pa2, pa3); if constexpr (MODE != 0) { SBAR(); mask_tile<MODE>(pB0, pB1, d, j, wid, r32, hi, rpbL); SBAR(); } partialSM(pB0, pB1, m_reg, mnB, alB);
    __syncthreads(); SWAIT(); SWRITE(0, SE);
    RESC(alB); __syncthreads();
    SBAR(); qkt<K2, NQR>(pA0, pA1, K_lds, K2_lds, qr, q2l, r32, hi);
    finishSM(pB0, pB1, alB, l_reg, pa0, pa1, pa2, pa3); SBAR();
    if (SDEPTH == 1 || j + 3 < NT) SLOAD(SE, j + 1 + SDEPTH); SBAR();
    pv_d0(o, vb0 + SHM_V, pa0, pa1, pa2, pa3); if constexpr (MODE != 0) { SBAR(); mask_tile<MODE>(pA0, pA1, d, j + 1, wid, r32, hi, rpbL); SBAR(); } partialSM(pA0, pA1, m_reg, mnA, alA);
    __syncthreads(); SWAIT(); SWRITE(1, SO);
    RESC(alA); __syncthreads();
  }
  SBAR(); qkt<K2, NQR>(pB0, pB1, K_lds + SHM_K, K2_lds + SHM_K2, qr, q2l, r32, hi);
  finishSM(pA0, pA1, alA, l_reg, pa0, pa1, pa2, pa3); SBAR();
  pv_d0(o, vb0, pa0, pa1, pa2, pa3); if constexpr (MODE != 0) { SBAR(); mask_tile<MODE>(pB0, pB1, d, NT - 1, wid, r32, hi, rpbL); SBAR(); } partialSM(pB0, pB1, m_reg, mnB, alB);
  __syncthreads(); RESC(alB);
  finishSM(pB0, pB1, alB, l_reg, pa0, pa1, pa2, pa3); SBAR();
  pv_d0(o, vb0 + SHM_V, pa0, pa1, pa2, pa3);
  if (hi == 0) li_l[r32] = l_reg; asm volatile("s_waitcnt lgkmcnt(0)" ::: "memory");
  float rli[16];
#pragma unroll
  for (int r = 0; r < 16; ++r) rli[r] = __builtin_amdgcn_rcpf(li_l[crow(r, hi)]);
  GAS bf16* Ow = (GAS bf16*)d.O + (long)(wid * QBLK) * d.ldo;
#pragma unroll
  for (int r = 0; r < 16; ++r) { const int orow = crow(r, hi);
#pragma unroll
    for (int d0 = 0; d0 < 4; ++d0) { const float x = o[d0][r] * rli[r]; Ow[(long)orow * d.ldo + d0 * 32 + r32] = (bf16)(cvt_pk_bf16(x, x) & 0xffffu); } }
  __syncthreads();
#undef TROW
#undef SLOAD
#undef SWRITE
#undef SWAIT
#undef RESC
}
constexpr int X_V = 0, X_K = 4 * SHM_V, X_P = X_K + 3 * SHM_K, X_WS = X_P + 4 * 4096, X_END = X_WS + NW * 64 * 4;
__device__ __forceinline__ void unit_split(const Desc& d, LAS char* lds) {
  const int tid = threadIdx.x, wid = __builtin_amdgcn_readfirstlane(tid >> 6), lane = tid & 63, r32 = lane & 31, hi = lane >> 5;
  const bool isS = wid < 4; const int w4 = wid & 3;
  LAS char* V_lds = lds + X_V; LAS char* K_lds = lds + X_K; LAS char* P_l = lds + X_P + w4 * 4096 + lane * 16;
  LAS float* wsS = (LAS float*)(lds + X_WS) + w4 * 64; LAS float* al_l = wsS; LAS float* li_l = wsS + 32;
  volatile LAS unsigned* flag = (volatile LAS unsigned*)((LAS float*)(lds + X_WS) + (w4 + 4) * 64);
  const int NT = d.NT;
#define KOFF(i, L) ((4 * (w4 + 4 * (i)) + ((L) >> 4)) * d.ldk + ((((L) & 15) ^ ((4 * (w4 + 4 * (i)) + ((L) >> 4)) & 7)) * 8))
#define VKK(i, L) (((w4 + 4 * (i)) >> 1) * 8 + (((L) & 31) >> 2))
#define VOFF(i, L) (((VKK(i, L) & ~0xC) | ((VKK(i, L) & 4) << 1) | ((VKK(i, L) & 8) >> 1)) * d.ldv + ((w4 + 4 * (i)) & 1) * 64 + ((L) >> 5) * 32 + ((L) & 3) * 8)
#define TROT(j) (((j) + d.rot) >= NT ? ((j) + d.rot) - NT : ((j) + d.rot))
#define TROW(j) (TROT(j) < 4 ? d.row_ctx + 64 * TROT(j) : d.row_lat + 64 * (TROT(j) - 4))
#define GLDS(src, dst) __builtin_amdgcn_global_load_lds((const unsigned*)(src), (LAS unsigned*)(dst), 16, 0, 0)
#define KDMA(j) do { int L_ = lane; asm volatile("" : "+v"(L_)); const GAS bf16* kp_ = (const GAS bf16*)d.K + (long)TROW(j) * d.ldk; LAS char* kb_ = K_lds + ((j) % 3) * SHM_K + w4 * 1024; \
    GLDS(kp_ + KOFF(0, L_), kb_); GLDS(kp_ + KOFF(1, L_), kb_ + 4096); GLDS(kp_ + KOFF(2, L_), kb_ + 8192); GLDS(kp_ + KOFF(3, L_), kb_ + 12288); } while (0)
#define VDMA(j) do { int L_ = lane; asm volatile("" : "+v"(L_)); const GAS bf16* vp_ = (const GAS bf16*)d.V + (long)TROW(j) * d.ldv; LAS char* vb_ = V_lds + ((j) & 1) * 2 * SHM_V + w4 * 1024; \
    _Pragma("unroll") for (int i_ = 0; i_ < 4; ++i_) { const int v_ = VOFF(i_, L_); GLDS(vp_ + v_, vb_ + i_ * 4096); GLDS(vp_ + 128 + v_, vb_ + SHM_V + i_ * 4096); } } while (0)
#define WAITV(n) asm volatile("s_waitcnt vmcnt(" #n ")" ::: "memory")
#define BAR() asm volatile("s_waitcnt lgkmcnt(0)\n\ts_barrier" ::: "memory")
#define KBUF(j) (K_lds + ((j) % 3) * SHM_K)
#define VOFS(j) (((j) & 1) * 2 * SHM_V)
  if (isS) { KDMA(0); VDMA(0); KDMA(1); } WAITV(4); BAR();
  if (isS) {
    float m_reg = d.m0, l_reg = d.l0; bf16x8 qr[8];
    { const GAS bf16* Qw = (const GAS bf16*)d.Q + (long)(w4 * QBLK + r32) * d.ldq + hi * 8;
#pragma unroll
      for (int d0 = 0; d0 < 8; ++d0) qr[d0] = *(const GAS bf16x8*)(Qw + d0 * 16); }
    f32x16 pA0, pA1, pB0, pB1; float mnA, mnB, alA, alB; bf16x8 pa0, pa1, pa2, pa3;
    qkt_pf(pA0, pA1, KBUF(0), qr, r32, hi); partialSM(pA0, pA1, m_reg, mnA, alA);
    WAITV(0); BAR();
    if (2 < NT) KDMA(2);
#define PUBP() do { *(LAS bf16x8*)(P_l) = pa0; *(LAS bf16x8*)(P_l + 1024) = pa1; *(LAS bf16x8*)(P_l + 2048) = pa2; *(LAS bf16x8*)(P_l + 3072) = pa3; } while (0)
#ifdef PROBE_S
#define PROBE_SVALU() do { float dm_ = 1.0f; _Pragma("unroll") for (int q_ = 0; q_ < 32; ++q_) asm volatile("v_exp_f32 %0, %0" : "+v"(dm_)); asm volatile("" :: "v"(dm_)); } while (0)
#else
#define PROBE_SVALU() do { } while (0)
#endif
#define SSTEP(J, PN0, PN1, MNN, ALN, PO0, PO1, ALO, W0, W1) do { \
      SBAR(); qkt_pf(PN0, PN1, KBUF(J), qr, r32, hi); finishSM(PO0, PO1, ALO, l_reg, pa0, pa1, pa2, pa3); SBAR(); PUBP(); \
      W0; BAR();                                                                         \
      VDMA(J); \
      partialSM(PN0, PN1, m_reg, MNN, ALN); PROBE_SVALU(); { const bool rs_ = __any((ALN) < 1.f); if (rs_ && hi == 0) al_l[r32] = (ALN); if (lane == 0) *flag = rs_ ? 1u : 0u; } \
      W1; BAR();                                                                         \
      if ((J) + 2 < NT) KDMA((J) + 2); \
    } while (0)
    for (int j = 1; j + 4 < NT; j += 2) {
      SSTEP(j, pB0, pB1, mnB, alB, pA0, pA1, alA, WAITV(4), WAITV(8));
      SSTEP(j + 1, pA0, pA1, mnA, alA, pB0, pB1, alB, WAITV(4), WAITV(8));
    }
    SSTEP(NT - 3, pB0, pB1, mnB, alB, pA0, pA1, alA, WAITV(4), WAITV(8));
    SSTEP(NT - 2, pA0, pA1, mnA, alA, pB0, pB1, alB, WAITV(0), WAITV(0));
    SSTEP(NT - 1, pB0, pB1, mnB, alB, pA0, pA1, alA, WAITV(0), WAITV(0));
    finishSM(pB0, pB1, alB, l_reg, pa0, pa1, pa2, pa3); SBAR(); PUBP();
    if (hi == 0) li_l[r32] = l_reg;
    WAITV(0); BAR();
    BAR();
#undef PUBP
#undef SSTEP
  } else {
    f32x16 o[8] = {}; bf16x8 pa0, pa1, pa2, pa3; f32x16 dmy = {};
    const int vb0 = (int)(unsigned)(uintptr_t)V_lds + v_rd_base(lane);
    WAITV(0); BAR();
#define GETP() do { pa0 = *(const LAS bf16x8*)(P_l); pa1 = *(const LAS bf16x8*)(P_l + 1024); pa2 = *(const LAS bf16x8*)(P_l + 2048); pa3 = *(const LAS bf16x8*)(P_l + 3072); } while (0)
#ifdef PROBE_V
#define PROBE_VMFMA() do { _Pragma("unroll") for (int q_ = 0; q_ < 16; ++q_) dmy = __builtin_amdgcn_mfma_f32_32x32x16_bf16(pa0, pa1, dmy, 0, 0, 0); asm volatile("" : "+v"(dmy)); } while (0)
#else
#define PROBE_VMFMA() do { } while (0)
#endif
#define VSTEP(J, W0, W1) do { \
      W0; BAR();                                                                         \
      GETP(); asm volatile("s_waitcnt lgkmcnt(0)" ::: "memory"); pv_pipe(o, vb0 + VOFS((J) - 1), pa0, pa1, pa2, pa3); PROBE_VMFMA(); \
      W1; BAR();                                                                         \
      pv_pipe(o + 4, vb0 + VOFS((J) - 1) + SHM_V, pa0, pa1, pa2, pa3); \
      if (__builtin_amdgcn_readfirstlane(*flag)) { \
        _Pragma("unroll") for (int dd = 0; dd < 8; ++dd) _Pragma("unroll") for (int r = 0; r < 16; ++r) o[dd][r] *= al_l[crow(r, hi)]; } \
    } while (0)
    for (int j = 1; j + 4 < NT; j += 2) { VSTEP(j, , ); VSTEP(j + 1, , ); }
    VSTEP(NT - 3, , );
    VSTEP(NT - 2, , );
    VSTEP(NT - 1, , );
    WAITV(0); BAR();
    GETP(); asm volatile("s_waitcnt lgkmcnt(0)" ::: "memory"); pv_pipe(o, vb0 + VOFS(NT - 1), pa0, pa1, pa2, pa3); pv_pipe(o + 4, vb0 + VOFS(NT - 1) + SHM_V, pa0, pa1, pa2, pa3);
    float rli[16];
#pragma unroll
    for (int r = 0; r < 16; ++r) rli[r] = __builtin_amdgcn_rcpf(li_l[crow(r, hi)]);
    GAS bf16* Ow = (GAS bf16*)d.O + (long)(w4 * QBLK) * d.ldo;
    { LAS bf16* stg = (LAS bf16*)(lds + X_P + w4 * 4096);
#pragma unroll
      for (int g = 0; g < 4; ++g) {
#pragma unroll
        for (int r = 0; r < 16; ++r) { const int orow = crow(r, hi); const float x0 = o[2 * g][r] * rli[r], x1 = o[2 * g + 1][r] * rli[r];
          stg[orow * 64 + r32] = (bf16)(cvt_pk_bf16(x0, x0) & 0xffffu); stg[orow * 64 + 32 + r32] = (bf16)(cvt_pk_bf16(x1, x1) & 0xffffu); }
        asm volatile("s_waitcnt lgkmcnt(0)" ::: "memory");
#pragma unroll
        for (int q = 0; q < 4; ++q) { const int idx = q * 64 + lane, row = idx >> 3, ch = idx & 7; const v4u v = *(const LAS v4u*)(stg + row * 64 + ch * 8);
          *(GAS v4u*)(Ow + (long)row * d.ldo + g * 64 + ch * 8) = v; }
        asm volatile("s_waitcnt lgkmcnt(0)" ::: "memory"); } }
    BAR();
#undef GETP
#undef VSTEP
  }
#undef KOFF
#undef VKK
#undef VOFF
#undef TROW
#undef TROT
#undef GLDS
#undef KDMA
#undef VDMA
#undef WAITV
#undef BAR
#undef KBUF
#undef VOFS
}
}
constexpr int NWAVES = 8;
constexpr size_t MiB = 1u << 20;
constexpr size_t WS_CTL = 0, CTL_ZERO_BYTES = 1 * MiB;
constexpr size_t WS_MODP = 1 * MiB;
constexpr size_t WS_MODS = 9 * MiB;
constexpr size_t WS_TAB = 10 * MiB;
constexpr size_t WS_SSQ = 11 * MiB;
constexpr size_t WS_W = 13 * MiB;
constexpr size_t W_SWA_QKV = WS_W, W_SWA_O = W_SWA_QKV + 12 * MiB, W_DIFF_QKV = W_SWA_O + 8 * MiB, W_DIFF_O = W_DIFF_QKV + 24 * MiB;
constexpr size_t W_MLA_DOWN = W_DIFF_O + 8 * MiB, W_MLA_UQ = W_MLA_DOWN + 5 * MiB, W_MLA_UKV = W_MLA_UQ + 3 * MiB, W_MLA_O = W_MLA_UKV + 4 * MiB;
constexpr size_t W_NA_QKV = W_MLA_O + 8 * MiB, W_NA_O = W_NA_QKV + 24 * MiB, W_GU = W_NA_O + 8 * MiB, W_DOWN = W_GU + 4 * 44 * MiB, W_END = W_DOWN + 4 * 22 * MiB;
constexpr size_t WS_H = W_END;
constexpr size_t WS_U = WS_H + 136 * MiB;
constexpr size_t WS_Y = WS_U + 68 * MiB;
constexpr size_t WS_O = WS_Y + 136 * MiB;
constexpr size_t WS_O12 = WS_O + 68 * MiB;
constexpr size_t WS_R1 = WS_O12 + 136 * MiB;
constexpr size_t R1_MLA_Q = WS_R1, R1_MLA_KV = WS_R1 + 102 * MiB, R1_MLA_C = R1_MLA_KV + 136 * MiB, R1_MLA_KPE = R1_MLA_C + 34 * MiB;
constexpr size_t R1_KH = WS_R1 + 68 * MiB, R1_VH = WS_R1 + 136 * MiB;
constexpr size_t WS_YP = WS_R1 + 276 * MiB;
constexpr size_t WS_END = WS_YP + 64 * MiB;
static_assert(W_END == (13 + 368) * MiB && (size_t)MROWS * 6144 * 2 <= 276 * MiB && (size_t)MROWS * FF * 2 <= 276 * MiB && R1_MLA_KPE + (size_t)MROWS * 64 * 2 <= WS_END, "ws map");
constexpr int CW_BAR = 4096;
constexpr int RING_BYTES = 133120, MISC_OFF = 135168, LDS_BYTES = 147456;
static_assert(attn::L_END <= RING_BYTES && attn::X_END <= RING_BYTES && pg8::STAGE_BYTES <= RING_BYTES && 8 * 16640 <= RING_BYTES && MISC_OFF + 128 <= LDS_BYTES, "LDS map");

#define RLX_AGENT __ATOMIC_RELAXED, __HIP_MEMORY_SCOPE_AGENT
#define LDS_WAIT() asm volatile("s_waitcnt lgkmcnt(0)" ::: "memory")

#define XB_TMO      128
#define XB_XCNT(j)  (256  + 64 * (j))
#define XB_XSUB(j)  (1280 + 64 * (j))
#define XB_XGEN(j)  (2304 + 64 * (j))
#define XB_TOP      3328
#define XB_TOPGEN   3392
#define XCD_BAR_WORDS 3456
#define XB_SPIN_CAP (1u << 18)
__device__ __forceinline__ unsigned xb_ld(unsigned* p)              { return __hip_atomic_load(p, __ATOMIC_RELAXED, __HIP_MEMORY_SCOPE_AGENT); }
__device__ __forceinline__ unsigned xb_add(unsigned* p, unsigned v) { return __hip_atomic_fetch_add(p, v, __ATOMIC_RELAXED, __HIP_MEMORY_SCOPE_AGENT); }
__device__ __forceinline__ unsigned xb_xcc_id() { return (unsigned)__builtin_amdgcn_s_getreg((3 << 11) | 20) & 0xFu; }
#define XB_SPIN(cond, bar) do { unsigned _sp = 0; while (cond) { __builtin_amdgcn_s_sleep(1); \
    if ((++_sp & 255u) == 0u) { if (xb_ld(&(bar)[XB_TMO])) break; if (_sp > XB_SPIN_CAP) { atomicAdd(&(bar)[XB_TMO], 1u); break; } } } } while (0)
struct XcdBarrier { unsigned* bar; unsigned x; volatile LAS unsigned* st; };
__device__ __forceinline__ XcdBarrier xcd_barrier_post(unsigned* bar, volatile LAS unsigned* st) {
    XcdBarrier b; b.bar = bar; b.x = xb_xcc_id(); b.st = st;
    if (threadIdx.x == 0) (void)xb_add(&bar[XB_XCNT(b.x)], 1u);
    return b;
}
__device__ __forceinline__ void xcd_barrier_complete(unsigned* bar, unsigned x, unsigned& nloc, unsigned& nx) {
    const unsigned G = gridDim.x * gridDim.y * gridDim.z;
    unsigned sum, cnt, mine, sp = 0u;
    for (;;) {
        sum = 0u; cnt = 0u; mine = 0u;
#pragma unroll
        for (unsigned j = 0; j < 16; ++j) { const unsigned c = xb_ld(&bar[XB_XCNT(j)]); sum += c; cnt += (c > 0u) ? 1u : 0u; mine = (j == x) ? c : mine; }
        if (sum == G) break;
        __builtin_amdgcn_s_sleep(1);
        if ((++sp & 255u) == 0u) { if (xb_ld(&bar[XB_TMO])) break; if (sp > XB_SPIN_CAP) { atomicAdd(&bar[XB_TMO], 1u); break; } }
    }
    nloc = mine > 0u ? mine : 1u; nx = cnt > 0u ? cnt : 1u;
}
__device__ __forceinline__ void xcd_barrier(const XcdBarrier& b) {
    asm volatile("s_waitcnt vmcnt(0)" ::: "memory");
    __syncthreads();
    if (threadIdx.x == 0) {
        unsigned* bar = b.bar;
        __builtin_amdgcn_s_waitcnt(0);
        unsigned nloc = b.st[0], nx = b.st[1];
        if (nloc == 0u) { xcd_barrier_complete(bar, b.x, nloc, nx); b.st[0] = nloc; b.st[1] = nx; }
        const unsigned old = xb_add(&bar[XB_XSUB(b.x)], 1u);
        const unsigned gen = old / nloc;
        if (old + 1u == (gen + 1u) * nloc) {
            __builtin_amdgcn_fence(__ATOMIC_RELEASE, "agent");
            asm volatile("s_waitcnt vmcnt(0)" ::: "memory");
            const unsigned og = xb_add(&bar[XB_TOP], 1u);
            const unsigned tg = og / nx;
            if (og + 1u == (tg + 1u) * nx) xb_add(&bar[XB_TOPGEN], 1u);
            else XB_SPIN(xb_ld(&bar[XB_TOPGEN]) == tg, bar);
            __builtin_amdgcn_fence(__ATOMIC_ACQUIRE, "agent");
            xb_add(&bar[XB_XGEN(b.x)], 1u);
            asm volatile("s_waitcnt vmcnt(0)" ::: "memory");
        } else {
            XB_SPIN(xb_ld(&bar[XB_XGEN(b.x)]) == gen, bar);
            __builtin_amdgcn_fence(__ATOMIC_ACQUIRE, "agent");
            asm volatile("s_waitcnt vmcnt(0)" ::: "memory");
        }
    }
    __syncthreads();
}

enum { I_X = 0, I_C, I_CTX, I_CCTX, I_MODW, I_MODB, I_NORMG, I_WGU, I_WDOWN, I_SWA_QKV, I_SWA_O, I_SWA_SINK, I_DIFF_QKV, I_DIFF_O, I_DIFF_LAM, I_DIFF_SUBLN,
       I_MLA_DOWN, I_MLA_QN, I_MLA_KVN, I_MLA_UQ, I_MLA_UKV, I_MLA_O, I_NA_QKV, I_NA_O, I_NA_RPB, N_IN };
struct Args { const float* in[N_IN]; float* out; unsigned char* ws; int ph_lo, ph_hi, li, pad; };

struct Frame {
    LAS unsigned char* lds;
    int tid, lane, wave, vcu, G;
    unsigned char* ws;
};
__device__ __forceinline__ float wave_sum(float v) {
#pragma unroll
    for (int o = 1; o < 64; o <<= 1) v += __shfl_xor(v, o);
    return v;
}
__device__ __forceinline__ float ssq4(const f32x4 v) { return (v[0] * v[0] + v[1] * v[1]) + (v[2] * v[2] + v[3] * v[3]); }

constexpr float DIFF_LAM_INIT = 0.35550906759096926f;
struct CJob { const float* W; bf16* WT; int K, Nsrc, Ng, gu, rmod, rlo, rmax, pt; const float* kg; int kmask; float ks; };
constexpr int CJ_ITEMS[18] = {1536, 1024, 3072, 1024, 640, 384, 512, 1024, 3072, 1024, 5632, 5632, 5632, 5632, 2816, 2816, 2816, 2816};
constexpr int CJ_TOTAL = 47104;
__device__ __forceinline__ CJob cjob(const Args& a, int j) {
    unsigned char* ws = a.ws; CJob c; c.gu = 0; c.rmod = 1 << 30; c.rlo = 0; c.rmax = 0; c.pt = 0; c.kg = nullptr; c.kmask = -1; c.ks = 1.f;
    switch (j) {
    case 0: c.W = a.in[I_SWA_QKV]; c.WT = (bf16*)(ws + W_SWA_QKV); c.K = 2048; c.Nsrc = 3072; c.Ng = 3072; c.rmax = 2560; c.pt = 1; break;
    case 1: c.W = a.in[I_SWA_O]; c.WT = (bf16*)(ws + W_SWA_O); c.K = 2048; c.Nsrc = 2048; c.Ng = 2048; break;
    case 2: c.W = a.in[I_DIFF_QKV]; c.WT = (bf16*)(ws + W_DIFF_QKV); c.K = 2048; c.Nsrc = 6144; c.Ng = 6144; c.rmax = 4096; c.pt = 1; break;
    case 3: c.W = a.in[I_DIFF_O]; c.WT = (bf16*)(ws + W_DIFF_O); c.K = 2048; c.Nsrc = 2048; c.Ng = 2048; c.kg = a.in[I_DIFF_SUBLN]; c.kmask = 255; c.ks = 1.f - DIFF_LAM_INIT; break;
    case 4: c.W = a.in[I_MLA_DOWN]; c.WT = (bf16*)(ws + W_MLA_DOWN); c.K = 2048; c.Nsrc = 1088; c.Ng = 1280; c.rlo = 1024; c.rmax = 1088; c.pt = 2; break;
    case 5: c.W = a.in[I_MLA_UQ]; c.WT = (bf16*)(ws + W_MLA_UQ); c.K = 512; c.Nsrc = 3072; c.Ng = 3072; c.rmod = 192; c.rlo = 128; c.rmax = 3072; c.pt = 2; c.kg = a.in[I_MLA_QN]; break;
    case 6: c.W = a.in[I_MLA_UKV]; c.WT = (bf16*)(ws + W_MLA_UKV); c.K = 512; c.Nsrc = 4096; c.Ng = 4096; c.kg = a.in[I_MLA_KVN]; break;
    case 7: c.W = a.in[I_MLA_O]; c.WT = (bf16*)(ws + W_MLA_O); c.K = 2048; c.Nsrc = 2048; c.Ng = 2048; break;
    case 8: c.W = a.in[I_NA_QKV]; c.WT = (bf16*)(ws + W_NA_QKV); c.K = 2048; c.Nsrc = 6144; c.Ng = 6144; break;
    case 9: c.W = a.in[I_NA_O]; c.WT = (bf16*)(ws + W_NA_O); c.K = 2048; c.Nsrc = 2048; c.Ng = 2048; break;
    case 10: case 11: case 12: case 13: c.W = a.in[I_WGU] + (size_t)(j - 10) * DM * 2 * FF; c.WT = (bf16*)(ws + W_GU + (size_t)(j - 10) * 44 * MiB); c.K = 2048; c.Nsrc = 2 * FF; c.Ng = 2 * FF; c.gu = 1; break;
    default: c.W = a.in[I_WDOWN] + (size_t)(j - 14) * FF * DM; c.WT = (bf16*)(ws + W_DOWN + (size_t)(j - 14) * 22 * MiB); c.K = FF; c.Nsrc = 2048; c.Ng = 2048; break;
    }
    return c;
}
__device__ __forceinline__ void convert_item(const CJob& c, int it, LAS float* scr, int lane) {
    const int ngr = c.Ng >> 6, kb = it / ngr, gi = it - kb * ngr, k0 = kb * 64, n0 = gi * 64;
    int sb = n0; if (c.gu) { const int pn = n0 >> 8, bj = (n0 >> 7) & 1, j = n0 & 127; sb = bj * FF + pn * 128 + j; }
    const bool zero = sb >= c.Nsrc, rope = ((n0 % c.rmod) >= c.rlo) && (n0 < c.rmax);
    if (!zero) {
        const GAS f32x4* wp = (const GAS f32x4*)(c.W + (size_t)(k0 + (lane >> 4)) * c.Nsrc + sb + (lane & 15) * 4);
        f32x4 v[16];
#pragma unroll
        for (int i = 0; i < 16; ++i) v[i] = wp[(size_t)i * c.Nsrc];
#pragma unroll
        for (int i = 0; i < 16; ++i) { LAS float* s = scr + (4 * i + (lane >> 4)) * 65 + (lane & 15) * 4; s[0] = v[i][0]; s[1] = v[i][1]; s[2] = v[i][2]; s[3] = v[i][3]; }
    }
    LDS_WAIT(); asm volatile("" ::: "memory");
    const int cch = lane & 7;
    float g[8];
#pragma unroll
    for (int t = 0; t < 8; ++t) g[t] = c.kg ? ((const GAS float*)c.kg)[(k0 + 8 * cch + t) & c.kmask] * c.ks : 1.f;
#pragma unroll
    for (int j8 = 0; j8 < 8; ++j8) { const int nn = (lane >> 3) + 8 * j8;
        int src = nn; if (rope) src = (c.pt == 1) ? ((nn & 1) * 32 + (nn >> 1)) : ((nn >> 5) * 32 + (nn & 1) * 16 + ((nn & 31) >> 1));
        const LAS float* s = scr + (8 * cch) * 65 + src; v4u o;
        if (zero) o = (v4u){0u, 0u, 0u, 0u};
        else { o.x = cvt_pk_bf16(s[0 * 65] * g[0], s[1 * 65] * g[1]); o.y = cvt_pk_bf16(s[2 * 65] * g[2], s[3 * 65] * g[3]); o.z = cvt_pk_bf16(s[4 * 65] * g[4], s[5 * 65] * g[5]); o.w = cvt_pk_bf16(s[6 * 65] * g[6], s[7 * 65] * g[7]); }
        *(GAS v4u*)(c.WT + (size_t)(n0 + nn) * c.K + k0 + 8 * cch) = o; }
    LDS_WAIT(); asm volatile("" ::: "memory");
}
__device__ __forceinline__ void p0a(Frame& F, const Args& a) {
    LAS float* scr = (LAS float*)(F.lds + F.wave * 16640);
    const int gw = F.vcu * NWAVES + F.wave, NGW = F.G * NWAVES, lane = F.lane;
    for (int t = gw; t < 4 * 48 * 8; t += NGW) {
        const int l = t / 384, rem = t - l * 384, cg = rem >> 3, ks = rem & 7;
#pragma unroll
        for (int r = 0; r < 5; ++r)
#pragma unroll
            for (int q = 0; q < 4; ++q) { const int k = ks * 256 + lane + 64 * q; const float v = (r < 4) ? ((const GAS float*)a.in[I_C])[r * DM + k] : ((const GAS float*)a.in[I_CCTX])[k];
                scr[r * 256 + lane + 64 * q] = v / (1.f + __expf(-v)); }
        LDS_WAIT(); asm volatile("" ::: "memory");
        f32x4 acc[5];
#pragma unroll
        for (int r = 0; r < 5; ++r) acc[r] = (f32x4){0.f, 0.f, 0.f, 0.f};
        const GAS f32x4* wp = (const GAS f32x4*)(a.in[I_MODW] + ((size_t)l * DM + ks * 256) * MODW + cg * 256 + lane * 4);
        for (int kk = 0; kk < 256; kk += 8) { f32x4 w[8];
#pragma unroll
            for (int i = 0; i < 8; ++i) w[i] = wp[(size_t)(kk + i) * (MODW / 4)];
#pragma unroll
            for (int i = 0; i < 8; ++i)
#pragma unroll
                for (int r = 0; r < 5; ++r) acc[r] += w[i] * scr[r * 256 + kk + i]; }
#pragma unroll
        for (int r = 0; r < 5; ++r) *(GAS f32x4*)((float*)(F.ws + WS_MODP) + ((size_t)(l * 8 + ks) * 5 + r) * MODW + cg * 256 + lane * 4) = acc[r];
        LDS_WAIT(); asm volatile("" ::: "memory");
    }
    for (int gidx = gw; gidx < CJ_TOTAL; gidx += NGW) {
        int j = 0, it = gidx;
#pragma unroll
        for (int q = 0; q < 17; ++q) { if (it >= CJ_ITEMS[q] && j == q) { it -= CJ_ITEMS[q]; j = q + 1; } }
        const CJob c = cjob(a, j);
        convert_item(c, it, scr, lane);
    }
    if (blockIdx.x == 0) {
        const float L2T = 13.287712379549449f;
        GAS f32x4* T128 = (GAS f32x4*)(F.ws + WS_TAB); GAS f32x4* T64 = (GAS f32x4*)(F.ws + WS_TAB + 16384);
        for (int e = F.tid; e < 1024 + 512; e += 512) {
            int pos, k, n; if (e < 1024) { pos = e >> 4; k = e & 15; n = 32; } else { pos = (e - 1024) >> 3; k = (e - 1024) & 7; n = 16; }
            f32x4 o;
#pragma unroll
            for (int q = 0; q < 2; ++q) { const float inv = exp2f(-(float)(2 * k + q) / (float)n * L2T); const float ang = (float)pos * inv; float rev = ang * 0.15915494309189535f; rev -= floorf(rev);
                o[2 * q] = __builtin_amdgcn_cosf(rev); o[2 * q + 1] = __builtin_amdgcn_sinf(rev); }
            if (e < 1024) T128[e] = o; else T64[e - 1024] = o;
        }
    }
    if (blockIdx.x == 1 && F.wave == 0) {
        const GAS float* lv = (const GAS float*)a.in[I_DIFF_LAM];
        const float s1 = wave_sum(lv[lane] * lv[128 + lane] + lv[64 + lane] * lv[192 + lane]), s2 = wave_sum(lv[256 + lane] * lv[384 + lane] + lv[320 + lane] * lv[448 + lane]);
        if (lane == 0) *(GAS float*)(F.ws + WS_TAB + 32768) = expf(s1) - expf(s2) + DIFF_LAM_INIT;
    }
}
__device__ __forceinline__ void p0b(Frame& F, const Args& a) {
    for (int gid = blockIdx.x * 512 + F.tid; gid < 4 * 5 * (MODW / 4); gid += F.G * 512) {
        const int l = gid / (5 * (MODW / 4)), rem = gid - l * (5 * (MODW / 4)), r = rem / (MODW / 4), j4 = rem - r * (MODW / 4);
        f32x4 s = *(const GAS f32x4*)(a.in[I_MODB] + (size_t)l * MODW + 4 * j4);
#pragma unroll
        for (int ks = 0; ks < 8; ++ks) s += *(const GAS f32x4*)((const float*)(F.ws + WS_MODP) + ((size_t)(l * 8 + ks) * 5 + r) * MODW + 4 * j4);
        *(GAS f32x4*)((float*)(F.ws + WS_MODS) + ((size_t)l * 5 + r) * MODW + 4 * j4) = s;
    }
}
template <int KIND>
__device__ __forceinline__ void thin_phase(Frame& F, const Args& a, int lg, int sub, bool latent_only, int ysplit, bool dry = false) {
    const int gw = F.vcu * NWAVES + F.wave, NGW = F.G * NWAVES, lane = F.lane;
    const int lu = (KIND == 0) ? 0 : (sub == 0 ? lg : lg + 1), subu = (KIND == 0) ? 0 : 1 - sub;
    const GAS float* MODS = (const GAS float*)(F.ws + WS_MODS); const GAS float* NG = (const GAS float*)a.in[I_NORMG];
    for (int m = gw; m < MROWS; m += NGW) {
        const int b = m / TPB, rr = m - b * TPB; const bool isctx = rr < CTXL; const int mr = isctx ? 4 : b;
        if ((latent_only || KIND == 2) && isctx) continue;
        f32x4 h[8];
        { const GAS f32x4* hp = (KIND == 0) ? (const GAS f32x4*)(isctx ? a.in[I_CTX] + ((size_t)b * CTXL + rr) * DM : a.in[I_X] + ((size_t)b * SEQ + (rr - CTXL)) * DM) : (const GAS f32x4*)((const float*)(F.ws + WS_H) + (size_t)m * DM);
#pragma unroll
          for (int j = 0; j < 8; ++j) h[j] = hp[64 * j + lane]; }
        if (KIND != 0) {
            f32x4 y[8]; float ss = 0.f;
            if (!(isctx && ysplit)) { const GAS unsigned long long* yp = (const GAS unsigned long long*)((const bf16*)(F.ws + WS_Y) + (size_t)m * DM);
#pragma unroll
                for (int j = 0; j < 8; ++j) { const unsigned long long w = yp[64 * j + lane]; const unsigned lo = (unsigned)w, hi = (unsigned)(w >> 32);
                    y[j] = (f32x4){__builtin_bit_cast(float, lo << 16), __builtin_bit_cast(float, lo & 0xffff0000u), __builtin_bit_cast(float, hi << 16), __builtin_bit_cast(float, hi & 0xffff0000u)}; }
            } else {
                const GAS f32x4* sp = (const GAS f32x4*)((const float*)(F.ws + WS_YP) + ((size_t)b * CTXL + rr) * DM);
#pragma unroll
                for (int j = 0; j < 8; ++j) y[j] = sp[64 * j + lane];
#pragma unroll 1
                for (int ks = 1; ks < ysplit; ++ks) { sp += (size_t)1024 * DM / 4;
#pragma unroll
                    for (int j = 0; j < 8; ++j) y[j] += sp[64 * j + lane]; } }
#pragma unroll
            for (int j = 0; j < 8; ++j) ss += ssq4(y[j]);
            const float rstd = __builtin_amdgcn_rsqf(wave_sum(ss) * (1.f / DM) + EPS);
            const GAS f32x4* gt = (const GAS f32x4*)(MODS + ((size_t)lg * 5 + mr) * MODW + (sub ? 5 : 2) * DM); const GAS f32x4* gp = (const GAS f32x4*)(NG + ((size_t)lg * 4 + (sub ? 3 : 1)) * DM);
#pragma unroll
            for (int j = 0; j < 8; ++j) h[j] += gt[64 * j + lane] * (y[j] * rstd) * gp[64 * j + lane];
        }
        if (KIND == 2) { GAS f32x4* op = (GAS f32x4*)(a.out + ((size_t)b * SEQ + (rr - CTXL)) * DM);
#pragma unroll
            for (int j = 0; j < 8; ++j) op[64 * j + lane] = h[j];
        } else {
            GAS f32x4* hp = (GAS f32x4*)((float*)(F.ws + (dry ? WS_O12 : WS_H)) + (size_t)m * DM); float ss = 0.f;
#pragma unroll
            for (int j = 0; j < 8; ++j) { hp[64 * j + lane] = h[j]; ss += ssq4(h[j]); }
            const float rstd = __builtin_amdgcn_rsqf(wave_sum(ss) * (1.f / DM) + EPS);
            const GAS float* mv = MODS + ((size_t)lu * 5 + mr) * MODW;
            const GAS f32x4* sh = (const GAS f32x4*)(mv + (subu ? 3 : 0) * DM); const GAS f32x4* scl = (const GAS f32x4*)(mv + (subu ? 4 : 1) * DM); const GAS f32x4* gp = (const GAS f32x4*)(NG + ((size_t)lu * 4 + (subu ? 2 : 0)) * DM);
            GAS unsigned long long* up = (GAS unsigned long long*)((bf16*)(F.ws + (dry ? WS_O : WS_U)) + (size_t)m * DM);
#pragma unroll
            for (int j = 0; j < 8; ++j) { const f32x4 u = (h[j] * rstd) * gp[64 * j + lane] * (scl[64 * j + lane] + 1.f) + sh[64 * j + lane];
                up[64 * j + lane] = (unsigned long long)cvt_pk_bf16(u[0], u[1]) | ((unsigned long long)cvt_pk_bf16(u[2], u[3]) << 32); }
        }
    }
}
__device__ __forceinline__ void diff_combine(Frame& F) {
    const int gw = F.vcu * NWAVES + F.wave, NGW = F.G * NWAVES, lane = F.lane;
    const float lam = *(const GAS float*)(F.ws + WS_TAB + 32768);
    for (int m = gw; m < MROWS; m += NGW) {
        const GAS v4u* p1 = (const GAS v4u*)((const bf16*)(F.ws + WS_O12) + (size_t)m * 4096); GAS v4u* po = (GAS v4u*)((bf16*)(F.ws + WS_O) + (size_t)m * DM);
#pragma unroll
        for (int s = 0; s < 4; ++s) { const v4u a1 = p1[64 * s + lane], a2 = p1[256 + 64 * s + lane]; float x[8]; float ss = 0.f;
#pragma unroll
            for (int q = 0; q < 4; ++q) { const unsigned w1 = a1[q], w2 = a2[q];
                x[2 * q] = __builtin_bit_cast(float, w1 << 16) - lam * __builtin_bit_cast(float, w2 << 16); x[2 * q + 1] = __builtin_bit_cast(float, w1 & 0xffff0000u) - lam * __builtin_bit_cast(float, w2 & 0xffff0000u);
                ss += x[2 * q] * x[2 * q] + x[2 * q + 1] * x[2 * q + 1]; }
#pragma unroll
            for (int o = 1; o < 32; o <<= 1) ss += __shfl_xor(ss, o);
            const float rstd = __builtin_amdgcn_rsqf(ss * (1.f / 256.f) + EPS);
            v4u w; w.x = cvt_pk_bf16(x[0] * rstd, x[1] * rstd); w.y = cvt_pk_bf16(x[2] * rstd, x[3] * rstd); w.z = cvt_pk_bf16(x[4] * rstd, x[5] * rstd); w.w = cvt_pk_bf16(x[6] * rstd, x[7] * rstd);
            po[64 * s + lane] = w; }
    }
}
__device__ __forceinline__ void attn_swa_phase(Frame& F, const Args& a) {
    const bf16* QKV = (const bf16*)(F.ws + WS_R1); bf16* O = (bf16*)(F.ws + WS_O);
    for (int u = F.vcu; u < 1024 + 64; u += F.G) {
        attn::Desc d; int b, hq; long qrow;
        if (u < 1024) { const int bh = u >> 4, qb = u & 15; b = bh >> 4; hq = bh & 15; qrow = (long)b * TPB + CTXL + 256 * qb;
            const int t0 = 256 * qb, tlo = t0 - 128 < 0 ? 0 : t0 - 128, thi = t0 + 384 > SEQ ? SEQ : t0 + 384;
            d.NT = 4 + (thi - tlo) / 64; d.row_lat = b * TPB + CTXL + tlo; d.a0 = tlo - t0;
        } else { const int bh = u - 1024; b = bh >> 4; hq = bh & 15; qrow = (long)b * TPB; d.NT = 4; d.row_lat = b * TPB + CTXL; d.a0 = 0; }
        const int hk = hq >> 2;
        d.NTreal = d.NT; d.row_ctx = b * TPB; d.a1 = 0; d.rpb = nullptr; d.K2 = nullptr; d.rot = 0;
        d.Q = QKV + qrow * 3072 + 128 * hq; d.K = QKV + 2048 + 128 * hk; d.V = QKV + 2560 + 128 * hk; d.O = O + qrow * DM + 128 * hq;
        d.ldq = 3072; d.ldk = 3072; d.ldv = 3072; d.ldo = DM;
        d.m0 = ((const GAS float*)a.in[I_SWA_SINK])[hq]; d.l0 = 1.f;
        attn::unit<1, false, 2, 8>(d, (LAS char*)F.lds);
    }
}
__device__ __forceinline__ void attn_diff_phase(Frame& F) {
    const bf16* Q = (const bf16*)(F.ws + WS_R1); const bf16* KH = (const bf16*)(F.ws + R1_KH); const bf16* VH = (const bf16*)(F.ws + R1_VH); bf16* O12 = (bf16*)(F.ws + WS_O12);
    for (int u = F.vcu; u < 2048 + 128; u += F.G) {
        attn::Desc d; int bhc; long qrow;
        if (u < 2048) { bhc = u >> 5; qrow = (long)(bhc >> 4) * TPB + CTXL + 128 * (u & 31); d.NT = 68; }
        else { bhc = (u - 2048) >> 1; qrow = (long)(bhc >> 4) * TPB + 128 * (u & 1); d.NT = 4; }
        const int b = bhc >> 4, h = (bhc >> 1) & 7, c = bhc & 1;
        d.NTreal = d.NT; d.row_ctx = b * TPB; d.row_lat = b * TPB + CTXL; d.a0 = 0; d.a1 = 0; d.rpb = nullptr; d.K2 = nullptr; d.m0 = -1e30f; d.l0 = 0.f; d.rot = 0;
        d.Q = Q + qrow * 2048 + 256 * h + 128 * c; d.K = KH + (size_t)(2 * h + c) * MROWS * 128; d.V = VH + (size_t)h * MROWS * 256; d.O = O12 + qrow * 4096 + 2048 * c + 256 * h;
        d.ldq = 2048; d.ldk = 128; d.ldv = 256; d.ldo = 4096;
        attn::unit_split(d, (LAS char*)F.lds);
    }
}
__device__ __forceinline__ void attn_mla_phase(Frame& F) {
    const bf16* Qp = (const bf16*)(F.ws + R1_MLA_Q); const bf16* KV = (const bf16*)(F.ws + R1_MLA_KV); const bf16* KPE = (const bf16*)(F.ws + R1_MLA_KPE); bf16* O = (bf16*)(F.ws + WS_O);
    for (int u = F.vcu; u < 1024 + 64; u += F.G) {
        attn::Desc d; int bh; long qrow;
        if (u < 1024) { bh = u >> 4; const int qb = u & 15; qrow = (long)(bh >> 4) * TPB + CTXL + 256 * qb; d.NT = 68; }
        else { bh = u - 1024; qrow = (long)(bh >> 4) * TPB; d.NT = 4; }
        const int b = bh >> 4, h = bh & 15;
        d.NTreal = d.NT; d.row_ctx = b * TPB; d.row_lat = b * TPB + CTXL; d.a0 = 0; d.a1 = 0; d.rpb = nullptr; d.m0 = -1e30f; d.l0 = 0.f; d.rot = 0;
        d.Q = Qp + qrow * 3072 + 192 * h; d.K = KV + 256 * h; d.V = KV + 256 * h + 128; d.K2 = KPE; d.O = O + qrow * DM + 128 * h;
        d.ldq = 3072; d.ldk = 4096; d.ldv = 4096; d.ldo = DM;
        attn::unit<0, true, 1, 8>(d, (LAS char*)F.lds);
    }
}
__device__ __forceinline__ void attn_na_phase(Frame& F, const Args& a) {
    const bf16* QKV = (const bf16*)(F.ws + WS_R1); bf16* O = (bf16*)(F.ws + WS_O);
    for (int u = F.vcu; u < 1024; u += F.G) {
        attn::Desc d; const int bh = u >> 4, R = u & 15, b = bh >> 4, h = bh & 15; const long qrow = (long)b * TPB + CTXL + 256 * R;
        const int krlo = 4 * R - 4 < 0 ? 0 : 4 * R - 4; int krhi = 4 * R - 1; krhi = (krhi < 0 ? 0 : (krhi > 56 ? 56 : krhi)) + 8;
        d.NTreal = 4 + (krhi - krlo); d.NT = (d.NTreal + 1) & ~1; d.row_ctx = b * TPB; d.row_lat = b * TPB + CTXL + 64 * krlo; d.a0 = krlo; d.a1 = 4 * R;
        d.rpb = a.in[I_NA_RPB] + h * 465; d.K2 = nullptr; d.m0 = -1e30f; d.l0 = 0.f; d.rot = 0;
        d.Q = QKV + qrow * 6144 + 128 * h; d.K = QKV + 2048 + 128 * h; d.V = QKV + 4096 + 128 * h; d.O = O + qrow * DM + 128 * h;
        d.ldq = 6144; d.ldk = 6144; d.ldv = 6144; d.ldo = DM;
        attn::unit<2, false, 1, 4>(d, (LAS char*)F.lds);
    }
}

constexpr int NPH = 33;
#ifndef PROBE_DUP
#define PROBE_DUP (-1)
#endif
constexpr int WO_SPLIT = 8, DN_SPLIT = 4;
__global__ void __launch_bounds__(NWAVES * 64, 2) fwd_kernel(Args args) {
    extern __shared__ __attribute__((aligned(16))) unsigned char lds_raw[];
    Frame F; F.lds = (LAS unsigned char*)lds_raw; F.tid = threadIdx.x; F.lane = F.tid & 63; F.wave = __builtin_amdgcn_readfirstlane(F.tid >> 6);
    F.G = gridDim.x; { const int bx = blockIdx.x; F.vcu = (F.G % 8 == 0) ? (bx % 8) * (F.G / 8) + bx / 8 : bx; }
    F.ws = args.ws;
    volatile LAS unsigned* MISC = (volatile LAS unsigned*)(F.lds + MISC_OFF);
    if (F.tid < 32) MISC[F.tid] = 0u;
    __syncthreads();
    XcdBarrier bar = xcd_barrier_post((unsigned*)(args.ws + WS_CTL) + CW_BAR + args.li * XCD_BAR_WORDS, MISC + 8);
    const int lo = args.ph_lo, hi = args.ph_hi;
#define IN(k) (lo <= (k) && (k) < hi)
#define SEAM(k) do { if ((k) + 1 < hi) xcd_barrier(bar); } while (0)
    unsigned char* ws = args.ws;
    const float* T128 = (const float*)(ws + WS_TAB); const float* T64 = (const float*)(ws + WS_TAB + 16384);
    bf16* U = (bf16*)(ws + WS_U); bf16* Y = (bf16*)(ws + WS_Y); float* YP = (float*)(ws + WS_YP); bf16* O = (bf16*)(ws + WS_O); bf16* R1 = (bf16*)(ws + WS_R1);
    const int bx = (int)blockIdx.x;
#define GEMM_ALL(Abuf, lda_, Wt, N_, K_, EpiT, ...) do { pg8::Gemm g{(const bf16*)(Abuf), (const bf16*)(Wt), MROWS, (N_), (K_), (lda_)}; pg8::StaticOrder S; S.init(MROWS, (N_), (K_), F.G, bx); \
        EpiT E{__VA_ARGS__}; pg8::gemm_phase<EpiT, pg8::StaticOrder>(F.lds, g, S, E); } while (0)
#define GEMM_LAT(Abuf, lda_, Wt, N_, K_, EpiT, ...) do { pg8::Gemm g{(const bf16*)(Abuf), (const bf16*)(Wt), MROWS, (N_), (K_), (lda_)}; pg8::LatentOrder S; S.init(NBATCH * SEQ, (N_), (K_), F.G, bx); \
        EpiT E{__VA_ARGS__}; pg8::gemm_phase<EpiT, pg8::LatentOrder>(F.lds, g, S, E); } while (0)
#define GEMM_CSP(Abuf, lda_, Wt, N_, K_, S_, EpiT, ...) do { pg8::Gemm g{(const bf16*)(Abuf), (const bf16*)(Wt), MROWS, (N_), (K_), (lda_)}; pg8::CtxSplitOrder S; S.init(NBATCH * SEQ, (N_), (K_), F.G, bx); S.S = (S_); S.ntS = (K_) / 64 / (S_); \
        EpiT E{__VA_ARGS__}; pg8::gemm_phase<EpiT, pg8::CtxSplitOrder>(F.lds, g, S, E); } while (0)
#ifdef PROBE_THIN
#define THIN_DRY(x) do { x; xcd_barrier(bar); } while (0)
#else
#define THIN_DRY(x) do { } while (0)
#endif
#ifdef PROBE_COLD
#define COLD_DUP(l, x) do { if ((l) == PROBE_COLD) { x; xcd_barrier(bar); } } while (0)
#else
#define COLD_DUP(l, x) do { } while (0)
#endif
#define PHASE(k, ...) do { if (IN(k)) { __VA_ARGS__; if (PROBE_DUP == (k)) { xcd_barrier(bar); __VA_ARGS__; } SEAM(k); } } while (0)
#define FFN_PART(l, p0) do { \
        PHASE((p0) + 0, THIN_DRY(thin_phase<1>(F, args, (l), 0, false, WO_SPLIT, true)); thin_phase<1>(F, args, (l), 0, false, WO_SPLIT)); \
        PHASE((p0) + 1, COLD_DUP(l, GEMM_ALL(U, DM, ws + W_GU + (size_t)(((l) + 1) & 3) * 44 * MiB, 2 * FF, DM, pg8::EpiSwiGLU, R1, FF)); GEMM_ALL(U, DM, ws + W_GU + (size_t)(l) * 44 * MiB, 2 * FF, DM, pg8::EpiSwiGLU, R1, FF)); \
        PHASE((p0) + 2, GEMM_CSP(R1, FF, ws + W_DOWN + (size_t)(l) * 22 * MiB, DM, FF, DN_SPLIT, pg8::EpiF32, Y, DM, YP)); \
        PHASE((p0) + 3, THIN_DRY(thin_phase<1>(F, args, (l), 1, false, DN_SPLIT, true)); thin_phase<1>(F, args, (l), 1, false, DN_SPLIT)); } while (0)

    PHASE(0, p0a(F, args));
    PHASE(1, p0b(F, args));
    PHASE(2, thin_phase<0>(F, args, 0, 0, false, 0));
#ifdef PROBE_XBAR
    for (int xb = 0; xb < PROBE_XBAR; ++xb) xcd_barrier(bar);
#endif
    PHASE(3, GEMM_ALL(U, DM, ws + W_SWA_QKV, 3072, DM, pg8::EpiQKV, R1, 3072, 8, 10, 0.08838834764831845f, T128, nullptr, nullptr, 0, 1));
    PHASE(4, attn_swa_phase(F, args));
    PHASE(5, GEMM_CSP(O, DM, ws + W_SWA_O, DM, DM, WO_SPLIT, pg8::EpiF32, Y, DM, YP));
    FFN_PART(0, 6);
    PHASE(10, GEMM_ALL(U, DM, ws + W_DIFF_QKV, 6144, DM, pg8::EpiQKV, R1, 2048, 8, 16, 0.08838834764831845f, T128, (bf16*)(ws + R1_KH), (bf16*)(ws + R1_VH), 16, 2));
    PHASE(11, attn_diff_phase(F));
    PHASE(12, diff_combine(F));
    PHASE(13, GEMM_CSP(O, DM, ws + W_DIFF_O, DM, DM, WO_SPLIT, pg8::EpiF32, Y, DM, YP));
    FFN_PART(1, 14);
    PHASE(18, GEMM_ALL(U, DM, ws + W_MLA_DOWN, 1280, DM, pg8::EpiMlaDown, (bf16*)(ws + R1_MLA_C), (bf16*)(ws + R1_MLA_KPE), (float*)(ws + WS_SSQ), T64));
    PHASE(19, GEMM_ALL(ws + R1_MLA_C, 1024, ws + W_MLA_UQ, 3072, 512, pg8::EpiMlaUp<true>, (bf16*)(ws + R1_MLA_Q), 3072, (const float*)(ws + WS_SSQ), 0, 0.07216878364870323f, T64);
              GEMM_ALL(ws + R1_MLA_C + 1024, 1024, ws + W_MLA_UKV, 4096, 512, pg8::EpiMlaUp<false>, (bf16*)(ws + R1_MLA_KV), 4096, (const float*)(ws + WS_SSQ), 1, 1.f, T64));
    PHASE(20, attn_mla_phase(F));
    PHASE(21, GEMM_CSP(O, DM, ws + W_MLA_O, DM, DM, WO_SPLIT, pg8::EpiF32, Y, DM, YP));
    FFN_PART(2, 22);
    PHASE(26, GEMM_ALL(U, DM, ws + W_NA_QKV, 6144, DM, pg8::EpiQKV, R1, 6144, 8, 0, 0.08838834764831845f, T128, nullptr, nullptr, 0, 1));
    PHASE(27, attn_na_phase(F, args));
    PHASE(28, GEMM_LAT(O, DM, ws + W_NA_O, DM, DM, pg8::EpiF32, Y, DM, YP));
    PHASE(29, thin_phase<1>(F, args, 3, 0, true, 0));
    PHASE(30, GEMM_LAT(U, DM, ws + W_GU + (size_t)3 * 44 * MiB, 2 * FF, DM, pg8::EpiSwiGLU, R1, FF));
    PHASE(31, GEMM_LAT(R1, FF, ws + W_DOWN + (size_t)3 * 22 * MiB, DM, FF, pg8::EpiF32, Y, DM, YP));
    PHASE(32, thin_phase<2>(F, args, 3, 1, true, 0));
#undef IN
#undef SEAM
}

#ifndef MK_PER_PHASE
#define MK_PER_PHASE 0
#endif
extern "C" void kernel_launch(void* const* d_in, const int* in_sizes, int n_in, void* d_out, int out_size, void* d_ws, size_t ws_size, hipStream_t stream) {
    static int grid = 0;
    if (grid == 0) {
        if (n_in != N_IN || in_sizes[0] != NBATCH * SEQ * DM || out_size != NBATCH * SEQ * DM || ws_size < WS_END) {
            fprintf(stderr, "kernel_launch: shape mismatch (n_in %d, in0 %d, out %d, ws %zu, need %zu)\n", n_in, n_in > 0 ? in_sizes[0] : -1, out_size, ws_size, (size_t)WS_END); grid = -1; return; }
        int dev = 0, cus = 0, per_cu = 0;
        if (hipGetDevice(&dev) != hipSuccess || hipDeviceGetAttribute(&cus, hipDeviceAttributeMultiprocessorCount, dev) != hipSuccess) { grid = -1; return; }
        if (hipFuncSetAttribute((const void*)fwd_kernel, hipFuncAttributeMaxDynamicSharedMemorySize, LDS_BYTES) != hipSuccess) { fprintf(stderr, "kernel_launch: hipFuncSetAttribute failed\n"); grid = -1; return; }
        if (hipOccupancyMaxActiveBlocksPerMultiprocessor(&per_cu, (const void*)fwd_kernel, NWAVES * 64, LDS_BYTES) != hipSuccess || per_cu < 1) { fprintf(stderr, "kernel_launch: occupancy query says %d\n", per_cu); }
        (void)hipGetLastError();
        grid = cus;
    }
    if (grid < 0) return;
    if (hipMemsetAsync((char*)d_ws + WS_CTL, 0, CTL_ZERO_BYTES, stream) != hipSuccess) return;
    Args a{};
    for (int i = 0; i < N_IN; ++i) a.in[i] = (const float*)d_in[i];
    a.out = (float*)d_out; a.ws = (unsigned char*)d_ws;
#if MK_PER_PHASE
    for (int p = 0; p < NPH; ++p) { a.ph_lo = p; a.ph_hi = p + 1; a.li = 0; hipLaunchKernelGGL(fwd_kernel, dim3(grid), dim3(NWAVES * 64), LDS_BYTES, stream, a); }
#else
    a.ph_lo = 0; a.ph_hi = NPH; a.li = 0;
    hipLaunchKernelGGL(fwd_kernel, dim3(grid), dim3(NWAVES * 64), LDS_BYTES, stream, a);
#endif
    const hipError_t le = hipPeekAtLastError();
    if (le != hipSuccess) fprintf(stderr, "kernel_launch: launch failed: %s\n", hipGetErrorName(le));
}
```

```cpp
#include <hip/hip_runtime.h>
#include <cstdio>
#include <cstdint>

#define GAS __attribute__((address_space(1)))
#define LAS __attribute__((address_space(3)))
typedef unsigned short bf16;
typedef unsigned v4u __attribute__((ext_vector_type(4)));
typedef float f32x4 __attribute__((ext_vector_type(4)));
typedef float f32x2 __attribute__((ext_vector_type(2)));
typedef float f32x16 __attribute__((ext_vector_type(16)));
typedef short bf16x8 __attribute__((ext_vector_type(8)));
typedef short s16x4 __attribute__((ext_vector_type(4)));
typedef GAS unsigned gu32;

constexpr int DM = 2048, NBATCH = 4, SEQ = 4096, CTXL = 256, TPB = SEQ + CTXL  ;
constexpr int MROWS = NBATCH * TPB  , FF = 5632, NLAYER = 4, MODW = 6 * DM  ;
constexpr float EPS = 1e-6f;
constexpr float LOG2E = 1.4426950408889634f;

__device__ __forceinline__ unsigned cvt_pk_bf16(float lo, float hi) { unsigned r; asm volatile("v_cvt_pk_bf16_f32 %0, %1, %2" : "=v"(r) : "v"(lo), "v"(hi)); return r; }
__device__ __forceinline__ float bf2f(unsigned short h) { return __builtin_bit_cast(float, (unsigned)h << 16); }

namespace pg8 {
typedef unsigned short bf16_t;
constexpr int BM = 256, BK = 64, HALF = 128, HTB = HALF * BK * 2, STAGE_BYTES = 8 * HTB, NXCD = 8, WGM = 8;
__host__ __device__ __forceinline__ int lds_byte(int r, int c) { const int st = (r >> 4) * 2 + (c >> 5), rr = r & 15, cc = c & 31, ob = rr * 64 + cc * 2; return st * 1024 + (ob ^ (((ob >> 9) & 1) << 5)); }
__host__ __device__ __forceinline__ void stage_rc(int b, int& R, int& C) { const int st = b / 1024, sb = b % 1024, swz = sb ^ (((sb >> 9) & 1) << 5); R = (st >> 1) * 16 + swz / 64; C = (st & 1) * 32 + (swz % 64) / 2; }
__host__ __device__ __forceinline__ int perm32(int rho) { const int n = rho >> 4, i = rho & 15; return 8 * (i >> 2) + 4 * n + (i & 3); }

struct Unit { int pm, pn, ks, koff, nt; };
struct Gemm { const bf16_t* A; const bf16_t* Bt; int M, N, K, lda; };

struct StaticOrder {
    int nM, nN, nwg, G, c, ntK;
    __host__ __device__ void init(int M, int N, int K, int G_, int c_) { nM = M / BM; nN = N / BM; nwg = nM * nN; G = G_; c = c_; ntK = K / BK; }
    __host__ __device__ bool next(int i, Unit& u) const {
        const long L = (long)i * G + c; if (L >= nwg) return false;
        u.ks = -1; u.koff = 0; u.nt = ntK;
        int wgid = (int)L; { const int q = nwg / NXCD, r = nwg % NXCD, xcd = wgid % NXCD, off = wgid / NXCD; wgid = (xcd < r ? xcd * (q + 1) : r * (q + 1) + (xcd - r) * q) + off; }
        const int nig = WGM * nN, gid = wgid / nig, fm = gid * WGM, gsz = (nM - fm) < WGM ? (nM - fm) : WGM;
        u.pm = fm + ((wgid % nig) % gsz); u.pn = (wgid % nig) / gsz; return true;
    }
};
struct LatentOrder : StaticOrder {
    __host__ __device__ bool next(int i, Unit& u) const { if (!StaticOrder::next(i, u)) return false; u.pm = u.pm + (u.pm >> 4) + 1; return true; }
};
struct CtxSplitOrder : LatentOrder {
    int S, ntS;
    __host__ __device__ bool next(int i, Unit& u) const {
        if (LatentOrder::next(i, u)) return true;
        const long s = (long)i * G + c - nwg; if (s < 0 || s >= (long)4 * nN * S) return false;
        const int ks = (int)(s % S), t = (int)(s / S); u.pn = t % nN; u.pm = (t / nN) * 17; u.ks = ks; u.koff = ks * ntS * BK * 2; u.nt = ntS; return true;
    }
};

__device__ __forceinline__ void rope2(f32x4& v, const f32x4 t) {
    const float a0 = v[0] * t[0] - v[1] * t[1], a1 = v[0] * t[1] + v[1] * t[0], a2 = v[2] * t[2] - v[3] * t[3], a3 = v[2] * t[3] + v[3] * t[2];
    v = (f32x4){a0, a1, a2, a3};
}
__device__ __forceinline__ v4u pack8(const f32x4 v0, const f32x4 v1) { v4u w; w.x = cvt_pk_bf16(v0[0], v0[1]); w.y = cvt_pk_bf16(v0[2], v0[3]); w.z = cvt_pk_bf16(v1[0], v1[1]); w.w = cvt_pk_bf16(v1[2], v1[3]); return w; }
struct EpiF32 {
    static constexpr bool PERM = true;
    bf16_t* O; int ldc; float* YP;
    __device__ __forceinline__ void operator()(const f32x4 (&acc)[2][2][4][2], const Unit& u, int wr, int wc, int fr, int fq) const {
        const int col0 = u.pn * BM + wc * 32 + 8 * fq;
        if (u.ks >= 0) { const int row0 = u.ks * 1024 + (u.pm / 17) * BM + wr * 64 + fr;
#pragma unroll
            for (int ai = 0; ai < 2; ++ai)
#pragma unroll
                for (int m = 0; m < 4; ++m) { GAS float* rowp = (GAS float*)YP + (size_t)(row0 + ai * HALF + m * 16) * ldc + col0;
#pragma unroll
                    for (int bj = 0; bj < 2; ++bj)
#pragma unroll
                        for (int n = 0; n < 2; ++n) *(GAS f32x4*)(rowp + bj * HALF + n * 4) = acc[ai][bj][m][n]; }
        } else { const int row0 = u.pm * BM + wr * 64 + fr;
#pragma unroll
            for (int ai = 0; ai < 2; ++ai)
#pragma unroll
                for (int m = 0; m < 4; ++m) { GAS bf16_t* rowp = (GAS bf16_t*)O + (size_t)(row0 + ai * HALF + m * 16) * ldc + col0;
#pragma unroll
                    for (int bj = 0; bj < 2; ++bj) *(GAS v4u*)(rowp + bj * HALF) = pack8(acc[ai][bj][m][0], acc[ai][bj][m][1]); }
        }
    }
};
struct EpiQKV {
    static constexpr bool PERM = true;
    bf16_t* O; int ldc, nq, nrope; float qscale; const float* tab;
    bf16_t* KH; bf16_t* VH; int nk, gv;
    __device__ __forceinline__ void operator()(const f32x4 (&acc)[2][2][4][2], const Unit& u, int wr, int wc, int fr, int fq) const {
        const int row0 = u.pm * BM + wr * 64 + fr, col0 = u.pn * BM + wc * 32 + 8 * fq;
        const float sc = (u.pn < nq) ? qscale : 1.f;
        const int pb = u.pm % 17; const bool rope = (u.pn < nrope) && (pb != 0);
        const GAS f32x4* T = (const GAS f32x4*)tab;
        const bool hm = (KH != nullptr) && (u.pn >= nq);
#pragma unroll
        for (int ai = 0; ai < 2; ++ai)
#pragma unroll
            for (int m = 0; m < 4; ++m) { const int row = row0 + ai * HALF + m * 16;
                const int pos = (wc < 2) ? (4 * (pb - 1) + 2 * ai + wr) : (16 * m + fr);
#pragma unroll
                for (int bj = 0; bj < 2; ++bj) { f32x4 v0 = acc[ai][bj][m][0] * sc, v1 = acc[ai][bj][m][1] * sc;
                    if (rope) { const int k0 = 8 * (wc & 1) + 2 * fq; rope2(v0, T[pos * 16 + k0]); rope2(v1, T[pos * 16 + k0 + 1]); }
                    GAS bf16_t* dst;
                    if (!hm) dst = (GAS bf16_t*)O + (size_t)row * ldc + col0 + bj * HALF;
                    else { const int ci = (u.pn - nq) * 2 + bj, cc = wc * 32 + 8 * fq;
                        if (ci < nk) dst = (GAS bf16_t*)KH + ((size_t)ci * MROWS + row) * 128 + cc;
                        else { const int cv = ci - nk, hd = cv / gv, part = cv - hd * gv; dst = (GAS bf16_t*)VH + ((size_t)hd * MROWS + row) * (128 * gv) + part * 128 + cc; } }
                    *(GAS v4u*)dst = pack8(v0, v1); } }
    }
};
struct EpiSwiGLU {
    static constexpr bool PERM = true;
    bf16_t* O; int ldc;
    __device__ __forceinline__ void operator()(const f32x4 (&acc)[2][2][4][2], const Unit& u, int wr, int wc, int fr, int fq) const {
        const int row0 = u.pm * BM + wr * 64 + fr, col0 = u.pn * HALF + wc * 32 + 8 * fq;
#pragma unroll
        for (int ai = 0; ai < 2; ++ai)
#pragma unroll
            for (int m = 0; m < 4; ++m) { GAS bf16_t* rowp = (GAS bf16_t*)O + (size_t)(row0 + ai * HALF + m * 16) * ldc + col0;
                f32x4 o[2];
#pragma unroll
                for (int n = 0; n < 2; ++n) { const f32x4 g = acc[ai][0][m][n], up = acc[ai][1][m][n];
#pragma unroll
                    for (int e = 0; e < 4; ++e) { const float s = __builtin_amdgcn_rcpf(1.f + __builtin_amdgcn_exp2f(-g[e] * LOG2E)); o[n][e] = g[e] * s * up[e]; } }
                *(GAS v4u*)rowp = pack8(o[0], o[1]); }
    }
};
struct EpiMlaDown {
    static constexpr bool PERM = true;
    bf16_t* C; bf16_t* KPE; float* SSQ; const float* tab64;
    __device__ __forceinline__ void operator()(const f32x4 (&acc)[2][2][4][2], const Unit& u, int wr, int wc, int fr, int fq) const {
        const int row0 = u.pm * BM + wr * 64 + fr; const int pb = u.pm % 17;
        if (u.pn < 4) {
            const int col0 = u.pn * BM + wc * 32 + 8 * fq;
#pragma unroll
            for (int ai = 0; ai < 2; ++ai)
#pragma unroll
                for (int m = 0; m < 4; ++m) { const int row = row0 + ai * HALF + m * 16; GAS bf16_t* rowp = (GAS bf16_t*)C + (size_t)row * 1024 + col0; float ss = 0.f;
#pragma unroll
                    for (int bj = 0; bj < 2; ++bj) { const f32x4 v0 = acc[ai][bj][m][0], v1 = acc[ai][bj][m][1];
                        ss += (v0[0] * v0[0] + v0[1] * v0[1]) + (v0[2] * v0[2] + v0[3] * v0[3]) + (v1[0] * v1[0] + v1[1] * v1[1]) + (v1[2] * v1[2] + v1[3] * v1[3]);
                        *(GAS v4u*)(rowp + bj * HALF) = pack8(v0, v1); }
                    ss += __shfl_xor(ss, 16); ss += __shfl_xor(ss, 32);
                    if (fq == 0) ((GAS float*)SSQ)[(size_t)row * 16 + u.pn * 4 + wc] = ss; }
        } else if (wc < 2) {
            const GAS f32x4* T = (const GAS f32x4*)tab64;
#pragma unroll
            for (int ai = 0; ai < 2; ++ai)
#pragma unroll
                for (int m = 0; m < 4; ++m) { const int row = row0 + ai * HALF + m * 16; f32x4 v0 = acc[ai][0][m][0], v1 = acc[ai][0][m][1];
                    if (pb != 0) { const int pos = (wc == 0) ? (4 * (pb - 1) + 2 * ai + wr) : (16 * m + fr); rope2(v0, T[pos * 8 + 2 * fq]); rope2(v1, T[pos * 8 + 2 * fq + 1]); }
                    *(GAS v4u*)((GAS bf16_t*)KPE + (size_t)row * 64 + wc * 32 + 8 * fq) = pack8(v0, v1); }
        }
    }
};
template <bool ROPE> struct EpiMlaUp {
    static constexpr bool PERM = true;
    bf16_t* O; int ldc; const float* SSQ; int which; float scale; const float* tab64;
    __device__ __forceinline__ void operator()(const f32x4 (&acc)[2][2][4][2], const Unit& u, int wr, int wc, int fr, int fq) const {
        const int row0 = u.pm * BM + wr * 64 + fr, col0 = u.pn * BM + wc * 32 + 8 * fq; const int pb = u.pm % 17;
        const GAS f32x4* T = (const GAS f32x4*)tab64;
#pragma unroll
        for (int ai = 0; ai < 2; ++ai)
#pragma unroll
            for (int m = 0; m < 4; ++m) { const int row = row0 + ai * HALF + m * 16; GAS bf16_t* rowp = (GAS bf16_t*)O + (size_t)row * ldc + col0;
                const GAS f32x4* sp = (const GAS f32x4*)((const GAS float*)SSQ + (size_t)row * 16 + which * 8); const f32x4 s0 = sp[0], s1 = sp[1];
                const float ss = ((s0[0] + s0[1]) + (s0[2] + s0[3])) + ((s1[0] + s1[1]) + (s1[2] + s1[3]));
                const float rs = __builtin_amdgcn_rsqf(ss * (1.f / 512.f) + EPS) * scale;
#pragma unroll
                for (int bj = 0; bj < 2; ++bj) { f32x4 v0 = acc[ai][bj][m][0] * rs, v1 = acc[ai][bj][m][1] * rs;
                    if (ROPE) { const int g = (u.pn * BM + bj * HALF + wc * 32) % 192;
                        if (g >= 128 && pb != 0) { const int pos = (g == 128) ? (4 * (pb - 1) + 2 * ai + wr) : (16 * m + fr); rope2(v0, T[pos * 8 + 2 * fq]); rope2(v1, T[pos * 8 + 2 * fq + 1]); } }
                    *(GAS v4u*)(rowp + bj * HALF) = pack8(v0, v1); } }
    }
};

template <class Epi, class Sched>
__device__ __forceinline__ void gemm_phase(LAS unsigned char* lds, const Gemm g, const Sched& S, const Epi& E) {
    const int tid = threadIdx.x, wid = __builtin_amdgcn_readfirstlane(tid >> 6), lane = tid & 63, wr = wid >> 2, wc = wid & 3, fr = lane & 15, fq = lane >> 4;
    const int K = g.K, lda = g.lda;
    unsigned voffA[2], voffB[2];
#pragma unroll
    for (int i = 0; i < 2; ++i) { int R, C; stage_rc(tid * 16 + i * 8192, R, C); const int Rb = Epi::PERM ? ((R & ~31) + perm32(R & 31)) : R;
        voffA[i] = (unsigned)(R * lda + C) * 2u; voffB[i] = (unsigned)(Rb * K + C) * 2u; }
    const size_t kstep = (size_t)(BK * 2);
    const size_t hsA = (size_t)HALF * lda * 2, hsB = (size_t)HALF * K * 2;
    const size_t tsA = 2 * hsA, tsB = 2 * hsB;
    const unsigned ldsw = (unsigned)wid * 1024u;
    const int aoff = lds_byte(wr * 64 + fr, fq * 8), boff = lds_byte(wc * 32 + fr, fq * 8);
#define PG8_SA(b, h) (((b) * 2 + (h)) * HTB)
#define PG8_SB(b, h) ((4 + (b) * 2 + (h)) * HTB)
#define PG8_STAGE(bufoff, gbase, voff) do { _Pragma("unroll") for (int _i = 0; _i < 2; ++_i) \
        __builtin_amdgcn_global_load_lds((const unsigned*)((const char*)(gbase) + (voff)[_i]), (LAS unsigned*)(lds + (bufoff) + ldsw + _i * 8192), 16, 0, 0); } while (0)
#define PG8_LDA(dst, b, h) do { _Pragma("unroll") for (int m = 0; m < 4; ++m) _Pragma("unroll") for (int k = 0; k < 2; ++k) dst[m][k] = *(const LAS bf16x8*)(lds + PG8_SA(b, h) + aoff + m * 2048 + k * 1024); } while (0)
#define PG8_LDB(dst, b, h) do { _Pragma("unroll") for (int n = 0; n < 2; ++n) _Pragma("unroll") for (int k = 0; k < 2; ++k) dst[n][k] = *(const LAS bf16x8*)(lds + PG8_SB(b, h) + boff + n * 2048 + k * 1024); } while (0)
#define PG8_MMA(ai, bj, At, Bt) do { __builtin_amdgcn_s_setprio(1); _Pragma("unroll") for (int m = 0; m < 4; ++m) _Pragma("unroll") for (int n = 0; n < 2; ++n) _Pragma("unroll") for (int k = 0; k < 2; ++k) \
        acc[ai][bj][m][n] = __builtin_amdgcn_mfma_f32_16x16x32_bf16(Bt[n][k], At[m][k], acc[ai][bj][m][n], 0, 0, 0); __builtin_amdgcn_s_setprio(0); } while (0)
#define PG8_WAIT_V(n) asm volatile("s_waitcnt vmcnt(" #n ")" ::: "memory")
#define PG8_WAIT_L(n) asm volatile("s_waitcnt lgkmcnt(" #n ")" ::: "memory")
#define PG8_BAR __builtin_amdgcn_s_barrier()
#define PG8_SCHED __builtin_amdgcn_sched_barrier(0)
    Unit cur, nxt; int ui = 0;
    if (!S.next(0, cur)) return;
    f32x4 acc[2][2][4][2];
#pragma unroll
    for (int a = 0; a < 2; ++a)
#pragma unroll
        for (int b = 0; b < 2; ++b)
#pragma unroll
            for (int m = 0; m < 4; ++m)
#pragma unroll
                for (int n = 0; n < 2; ++n) acc[a][b][m][n] = (f32x4){0.f, 0.f, 0.f, 0.f};
    bf16x8 At[4][2], B0[2][2], B1[2][2];
    const char* cA = (const char*)g.A + (size_t)cur.pm * tsA + cur.koff; const char* cB = (const char*)g.Bt + (size_t)cur.pn * tsB + cur.koff;
    PG8_STAGE(PG8_SB(0, 0), cB, voffB); PG8_STAGE(PG8_SB(0, 1), cB + hsB, voffB); PG8_STAGE(PG8_SA(0, 0), cA, voffA); PG8_STAGE(PG8_SA(0, 1), cA + hsA, voffA);
    if (wr == 1) PG8_BAR;
    PG8_WAIT_V(2); PG8_BAR;
    PG8_STAGE(PG8_SB(1, 0), cB + kstep, voffB); PG8_STAGE(PG8_SA(1, 0), cA + kstep, voffA); PG8_STAGE(PG8_SB(1, 1), cB + hsB + kstep, voffB);
    PG8_WAIT_V(6); PG8_BAR;
    for (;;) {
        const bool has_next = S.next(ui + 1, nxt);
        const char* nA = has_next ? (const char*)g.A + (size_t)nxt.pm * tsA + nxt.koff : cA; const char* nB = has_next ? (const char*)g.Bt + (size_t)nxt.pn * tsB + nxt.koff : cB;
        const int nt = cur.nt;
        for (int t = 0; t < nt; t += 2) {
            const bool last = (t == nt - 2);
            const char* a1 = cA + (size_t)(t + 1) * kstep;
            const char* a2 = last ? nA : cA + (size_t)(t + 2) * kstep; const char* b2 = last ? nB : cB + (size_t)(t + 2) * kstep;
            const char* a3 = a2 + kstep; const char* b3 = b2 + kstep;
            PG8_LDB(B0, 0, 0); PG8_LDB(B1, 0, 1); PG8_SCHED; PG8_LDA(At, 0, 0); PG8_STAGE(PG8_SA(1, 1), a1 + hsA, voffA);
            PG8_WAIT_V(8); PG8_WAIT_L(0); PG8_BAR; PG8_MMA(0, 0, At, B0); PG8_MMA(0, 1, At, B1); PG8_BAR; PG8_SCHED;
            PG8_LDA(At, 0, 1); PG8_STAGE(PG8_SB(0, 0), b2, voffB); PG8_STAGE(PG8_SB(0, 1), b2 + hsB, voffB); PG8_STAGE(PG8_SA(0, 0), a2, voffA);
            PG8_WAIT_V(8); PG8_WAIT_L(0); PG8_BAR; PG8_MMA(1, 0, At, B0); PG8_MMA(1, 1, At, B1); PG8_BAR; PG8_SCHED;
            PG8_LDB(B0, 1, 0); PG8_LDB(B1, 1, 1); PG8_SCHED; PG8_LDA(At, 1, 0); PG8_STAGE(PG8_SA(0, 1), a2 + hsA, voffA);
            PG8_WAIT_V(8); PG8_WAIT_L(0); PG8_BAR; PG8_MMA(0, 0, At, B0); PG8_MMA(0, 1, At, B1); PG8_BAR; PG8_SCHED;
            PG8_LDA(At, 1, 1); PG8_STAGE(PG8_SB(1, 0), b3, voffB); PG8_STAGE(PG8_SB(1, 1), b3 + hsB, voffB); PG8_STAGE(PG8_SA(1, 0), a3, voffA);
            PG8_WAIT_V(8); PG8_WAIT_L(0); PG8_BAR; PG8_MMA(1, 0, At, B0); PG8_MMA(1, 1, At, B1); PG8_BAR; PG8_SCHED;
        }
        if (wr == 0) PG8_BAR;
        E(acc, cur, wr, wc, fr, fq);
        if (!has_next) break;
#pragma unroll
        for (int a = 0; a < 2; ++a)
#pragma unroll
            for (int b = 0; b < 2; ++b)
#pragma unroll
                for (int m = 0; m < 4; ++m)
#pragma unroll
                    for (int n = 0; n < 2; ++n) acc[a][b][m][n] = (f32x4){0.f, 0.f, 0.f, 0.f};
        cur = nxt; cA = nA; cB = nB; ++ui;
        if (wr == 1) PG8_BAR;
    }
    PG8_WAIT_V(0);
    PG8_BAR;
#undef PG8_SA
#undef PG8_SB
#undef PG8_STAGE
#undef PG8_LDA
#undef PG8_LDB
#undef PG8_MMA
#undef PG8_WAIT_V
#undef PG8_WAIT_L
#undef PG8_BAR
#undef PG8_SCHED
}
}
namespace attn {
constexpr int NW = 8, QBLK = 32, KVBLK = 64;
constexpr int SHM_V = KVBLK * 128 * 2, SHM_K = KVBLK * 128 * 2, SHM_K2 = KVBLK * 64 * 2;
constexpr int L_V = 0, L_K = 2 * SHM_V, L_K2 = L_K + 2 * SHM_K, L_WS = L_K2 + 2 * SHM_K2, L_RPB = L_WS + NW * 64 * 4, L_Q2 = L_RPB + 2048, L_END = L_Q2 + NW * 4096;
constexpr float THR = 8.f;
#define KSWZ(row, colB) ((row) * 256 + ((colB) ^ (((row) & 7) << 4)))
#define K2SWZ(row, colB) ((row) * 128 + ((colB) ^ (((row) & 7) << 4)))
#define SBAR() __builtin_amdgcn_sched_barrier(0)
__device__ __forceinline__ int crow(int r, int hi) { return (r & 3) + 8 * (r >> 2) + 4 * hi; }

struct Desc {
    const bf16* Q; const bf16* K; const bf16* V; const bf16* K2; bf16* O;
    int ldq, ldk, ldv, ldo;
    int row_ctx, row_lat;
    int NT, NTreal;
    float m0, l0;
    int a0, a1;
    const float* rpb;
    int rot;
};

__device__ __forceinline__ void partialSM(f32x16& p0, f32x16& p1, float& m_reg, float& mn, float& alpha) {
  constexpr float C = LOG2E;
  float pmax = p0[0];
#pragma unroll
  for (int r = 1; r < 16; ++r) pmax = fmaxf(pmax, p0[r]);
#pragma unroll
  for (int r = 0; r < 16; ++r) pmax = fmaxf(pmax, p1[r]);
  { auto rr = __builtin_amdgcn_permlane32_swap(__float_as_uint(pmax), __float_as_uint(pmax), false, false);
    pmax = fmaxf(__uint_as_float(rr[0]), __uint_as_float(rr[1])); }
  if (__builtin_expect(__all(pmax - m_reg <= THR), 1)) { mn = m_reg; alpha = 1.f; }
  else { mn = fmaxf(m_reg, pmax); alpha = __builtin_amdgcn_exp2f((m_reg - mn) * C); m_reg = mn; }
  float mnC = -mn * C;
#pragma unroll
  for (int r = 0; r < 16; ++r) p0[r] = fmaf(p0[r], C, mnC);
#pragma unroll
  for (int r = 0; r < 16; ++r) p1[r] = fmaf(p1[r], C, mnC);
#pragma unroll
  for (int r = 0; r < 16; ++r) p0[r] = __builtin_amdgcn_exp2f(p0[r]);
}
__device__ __forceinline__ void finishSM(f32x16& p0, f32x16& p1, float alpha, float& l_reg, bf16x8& pa0, bf16x8& pa1, bf16x8& pa2, bf16x8& pa3) {
#pragma unroll
  for (int r = 0; r < 16; ++r) p1[r] = __builtin_amdgcn_exp2f(p1[r]);
  float ps = 0;
#pragma unroll
  for (int r = 0; r < 16; ++r) ps += p0[r];
#pragma unroll
  for (int r = 0; r < 16; ++r) ps += p1[r];
  { auto rr = __builtin_amdgcn_permlane32_swap(__float_as_uint(ps), __float_as_uint(ps), false, false);
    ps = __uint_as_float(rr[0]) + __uint_as_float(rr[1]); }
  l_reg = l_reg * alpha + ps;
#define PK4(P, BASE, OUT) do { unsigned a0 = cvt_pk_bf16(P[BASE + 0], P[BASE + 1]), a1 = cvt_pk_bf16(P[BASE + 2], P[BASE + 3]);   \
    unsigned b0 = cvt_pk_bf16(P[BASE + 4], P[BASE + 5]), b1 = cvt_pk_bf16(P[BASE + 6], P[BASE + 7]);                              \
    auto r0 = __builtin_amdgcn_permlane32_swap(a0, b0, false, false); auto r1 = __builtin_amdgcn_permlane32_swap(a1, b1, false, false); \
    v4u w = {r0[0], r1[0], r0[1], r1[1]}; OUT = __builtin_bit_cast(bf16x8, w); } while (0)
  PK4(p0, 0, pa0); PK4(p0, 8, pa1); PK4(p1, 0, pa2); PK4(p1, 8, pa3);
#undef PK4
}
template <bool K2, int NQR>
__device__ __forceinline__ void qkt(f32x16& p0, f32x16& p1, const LAS char* Ks, const LAS char* K2s, const bf16x8* qr, const LAS char* q2l, int r32, int hi) {
  p0 = f32x16{}; p1 = f32x16{};
#pragma unroll
  for (int d0 = 0; d0 < 8; ++d0) { int cb = (d0 * 16 + hi * 8) * 2;
    bf16x8 b0 = *(const LAS bf16x8*)(Ks + KSWZ(r32, cb));
    bf16x8 b1 = *(const LAS bf16x8*)(Ks + KSWZ(32 + r32, cb));
    bf16x8 q; if constexpr (true) { if (d0 < NQR) q = qr[d0 < NQR ? d0 : 0]; else q = *(const LAS bf16x8*)(q2l + (d0 - NQR) * 1024); }
    p0 = __builtin_amdgcn_mfma_f32_32x32x16_bf16(b0, q, p0, 0, 0, 0);
    p1 = __builtin_amdgcn_mfma_f32_32x32x16_bf16(b1, q, p1, 0, 0, 0); }
  if constexpr (K2) {
#pragma unroll
    for (int d0 = 0; d0 < 4; ++d0) { int cb = (d0 * 16 + hi * 8) * 2;
      bf16x8 b0 = *(const LAS bf16x8*)(K2s + K2SWZ(r32, cb));
      bf16x8 b1 = *(const LAS bf16x8*)(K2s + K2SWZ(32 + r32, cb));
      const bf16x8 q2 = *(const LAS bf16x8*)(q2l + (8 - NQR + d0) * 1024);
      p0 = __builtin_amdgcn_mfma_f32_32x32x16_bf16(b0, q2, p0, 0, 0, 0);
      p1 = __builtin_amdgcn_mfma_f32_32x32x16_bf16(b1, q2, p1, 0, 0, 0); }
  }
}
__device__ __forceinline__ int v_st(int k, int c) { const int kk = (k & ~0xC) | ((k & 4) << 1) | ((k & 8) >> 1); return ((kk >> 3) * 4 + (c >> 5)) * 512 + ((kk & 7) * 32 + (c & 31)) * 2; }
__device__ __forceinline__ int v_rd_base(int lane) { return ((lane & 3) << 3) | (((lane >> 2) & 3) << 6) | (((lane >> 4) & 1) << 5) | (((lane >> 5) & 1) << 8); }
constexpr int v_rd_off(int d0, int ks, int half) { return d0 * 512 + ks * 4096 + half * 2048; }
template <int OFF> __device__ __forceinline__ s16x4 tr_read(int vb) {
  s16x4 r; asm volatile("ds_read_b64_tr_b16 %0, %1 offset:%2" : "=&v"(r) : "v"(vb), "i"(OFF) : "memory"); return r;
}
template <int D0> __device__ __forceinline__ void pv_one(f32x16& od, int vb, bf16x8 pa0, bf16x8 pa1, bf16x8 pa2, bf16x8 pa3) {
  const s16x4 l0 = tr_read<v_rd_off(D0, 0, 0)>(vb), h0 = tr_read<v_rd_off(D0, 0, 1)>(vb), l1 = tr_read<v_rd_off(D0, 1, 0)>(vb), h1 = tr_read<v_rd_off(D0, 1, 1)>(vb);
  const s16x4 l2 = tr_read<v_rd_off(D0, 2, 0)>(vb), h2 = tr_read<v_rd_off(D0, 2, 1)>(vb), l3 = tr_read<v_rd_off(D0, 3, 0)>(vb), h3 = tr_read<v_rd_off(D0, 3, 1)>(vb);
  asm volatile("s_waitcnt lgkmcnt(0)" ::: "memory"); SBAR();
#define PK(L, H) (bf16x8){L[0], L[1], L[2], L[3], H[0], H[1], H[2], H[3]}
  od = __builtin_amdgcn_mfma_f32_32x32x16_bf16(pa0, PK(l0, h0), od, 0, 0, 0);
  od = __builtin_amdgcn_mfma_f32_32x32x16_bf16(pa1, PK(l1, h1), od, 0, 0, 0);
  od = __builtin_amdgcn_mfma_f32_32x32x16_bf16(pa2, PK(l2, h2), od, 0, 0, 0);
  od = __builtin_amdgcn_mfma_f32_32x32x16_bf16(pa3, PK(l3, h3), od, 0, 0, 0);
#undef PK
}
__device__ __forceinline__ void pv_d0(f32x16* o, int vb, bf16x8 pa0, bf16x8 pa1, bf16x8 pa2, bf16x8 pa3) {
  pv_one<0>(o[0], vb, pa0, pa1, pa2, pa3); pv_one<1>(o[1], vb, pa0, pa1, pa2, pa3); pv_one<2>(o[2], vb, pa0, pa1, pa2, pa3); pv_one<3>(o[3], vb, pa0, pa1, pa2, pa3);
}
__device__ __forceinline__ void qkt_pf(f32x16& p0, f32x16& p1, const LAS char* Ks, const bf16x8* qr, int r32, int hi) {
  bf16x8 kf[16];
#pragma unroll
  for (int d0 = 0; d0 < 8; ++d0) { const int cb = (d0 * 16 + hi * 8) * 2; kf[2 * d0] = *(const LAS bf16x8*)(Ks + KSWZ(r32, cb)); kf[2 * d0 + 1] = *(const LAS bf16x8*)(Ks + KSWZ(32 + r32, cb)); }
  SBAR();
  p0 = f32x16{}; p1 = f32x16{};
#pragma unroll
  for (int d0 = 0; d0 < 8; ++d0) { p0 = __builtin_amdgcn_mfma_f32_32x32x16_bf16(kf[2 * d0], qr[d0], p0, 0, 0, 0); p1 = __builtin_amdgcn_mfma_f32_32x32x16_bf16(kf[2 * d0 + 1], qr[d0], p1, 0, 0, 0); }
}
template <int D0> __device__ __forceinline__ void vfrag(s16x4 (&f)[8], int vb) {
  f[0] = tr_read<v_rd_off(D0, 0, 0)>(vb); f[1] = tr_read<v_rd_off(D0, 0, 1)>(vb); f[2] = tr_read<v_rd_off(D0, 1, 0)>(vb); f[3] = tr_read<v_rd_off(D0, 1, 1)>(vb);
  f[4] = tr_read<v_rd_off(D0, 2, 0)>(vb); f[5] = tr_read<v_rd_off(D0, 2, 1)>(vb); f[6] = tr_read<v_rd_off(D0, 3, 0)>(vb); f[7] = tr_read<v_rd_off(D0, 3, 1)>(vb);
}
__device__ __forceinline__ void pv4(f32x16& od, const s16x4 (&f)[8], bf16x8 pa0, bf16x8 pa1, bf16x8 pa2, bf16x8 pa3) {
#define PK(L, H) (bf16x8){L[0], L[1], L[2], L[3], H[0], H[1], H[2], H[3]}
  od = __builtin_amdgcn_mfma_f32_32x32x16_bf16(pa0, PK(f[0], f[1]), od, 0, 0, 0);
  od = __builtin_amdgcn_mfma_f32_32x32x16_bf16(pa1, PK(f[2], f[3]), od, 0, 0, 0);
  od = __builtin_amdgcn_mfma_f32_32x32x16_bf16(pa2, PK(f[4], f[5]), od, 0, 0, 0);
  od = __builtin_amdgcn_mfma_f32_32x32x16_bf16(pa3, PK(f[6], f[7]), od, 0, 0, 0);
#undef PK
}
__device__ __forceinline__ void pv_pipe(f32x16* o, int vb, bf16x8 pa0, bf16x8 pa1, bf16x8 pa2, bf16x8 pa3) {
  s16x4 fa[8], fb[8];
  vfrag<0>(fa, vb); SBAR();
  vfrag<1>(fb, vb); asm volatile("s_waitcnt lgkmcnt(8)" ::: "memory"); SBAR(); pv4(o[0], fa, pa0, pa1, pa2, pa3); SBAR();
  vfrag<2>(fa, vb); asm volatile("s_waitcnt lgkmcnt(8)" ::: "memory"); SBAR(); pv4(o[1], fb, pa0, pa1, pa2, pa3); SBAR();
  vfrag<3>(fb, vb); asm volatile("s_waitcnt lgkmcnt(8)" ::: "memory"); SBAR(); pv4(o[2], fa, pa0, pa1, pa2, pa3); SBAR();
  asm volatile("s_waitcnt lgkmcnt(0)" ::: "memory"); SBAR(); pv4(o[3], fb, pa0, pa1, pa2, pa3);
}
template <int MODE>
__device__ __forceinline__ void mask_tile(f32x16& p0, f32x16& p1, const Desc& d, int j, int wid, int r32, int hi, const LAS float* rpbL) {
  if constexpr (MODE == 1) {
    if (j >= 4) { const int base = d.a0 + 64 * (j - 4) - (wid * 32 + r32);
#pragma unroll
      for (int r = 0; r < 16; ++r) { const int dd = base + crow(r, hi); if (dd > 128 || dd < -128) p0[r] = -1e30f; if (dd + 32 > 128 || dd + 32 < -128) p1[r] = -1e30f; } }
  } else if constexpr (MODE == 2) {
    if (j >= 4) {
      const int kr = d.a0 + (j - 4), qr_ = d.a1 + (wid >> 1), c = 32 * (wid & 1) + r32;
      int r0 = qr_ - 4; r0 = r0 < 0 ? 0 : (r0 > 56 ? 56 : r0); int c0 = c - 8; c0 = c0 < 0 ? 0 : (c0 > 48 ? 48 : c0);
      asm volatile("" : "+v"(c0));
      const bool rv = (j < d.NTreal) && (kr >= r0) && (kr < r0 + 8);
      if (!rv) {
#pragma unroll
        for (int r = 0; r < 16; ++r) { p0[r] = -1e30f; p1[r] = -1e30f; }
      } else { const LAS float* brow = rpbL + (kr - qr_ + 7) * 31 + (15 - c);
#pragma unroll
        for (int rc = 0; rc < 16; rc += 4) {
#pragma unroll
          for (int r = rc; r < rc + 4; ++r) { const int k0 = crow(r, hi), k1 = k0 + 32; const bool ok0 = (unsigned)(k0 - c0) < 16u, ok1 = (unsigned)(k1 - c0) < 16u;
            const float b0 = brow[ok0 ? k0 : c], b1 = brow[ok1 ? k1 : c];
            p0[r] = ok0 ? p0[r] + b0 : -1e30f; p1[r] = ok1 ? p1[r] + b1 : -1e30f; }
          SBAR(); } }
    }
  }
}

template <int MODE, bool K2, int SDEPTH, int NQR>
__device__ __forceinline__ void unit(const Desc& d, LAS char* lds) {
  static_assert((K2 ? 12 : 8) - NQR <= 4, "at most four Q fragments live in LDS");
  const int tid = threadIdx.x, wid = __builtin_amdgcn_readfirstlane(tid >> 6), lane = tid & 63, r32 = lane & 31, hi = lane >> 5;
  LAS char* V_lds = lds + L_V; LAS char* K_lds = lds + L_K; LAS char* K2_lds = lds + L_K2;
  LAS float* ws = (LAS float*)(lds + L_WS) + wid * 64; LAS float* li_l = ws; LAS float* al_l = ws + 32;
  LAS float* rpbL = (LAS float*)(lds + L_RPB);
  if constexpr (MODE == 2) { if (tid < 465) rpbL[tid] = ((const GAS float*)d.rpb)[tid]; }
  float m_reg = d.m0, l_reg = d.l0; f32x16 o[4] = {}; bf16x8 qr[NQR];
  LAS char* q2l = lds + L_Q2 + wid * 4096 + lane * 16;
  { const GAS bf16* Qw = (const GAS bf16*)d.Q + (long)(wid * QBLK + r32) * d.ldq + hi * 8;
#pragma unroll
    for (int d0 = 0; d0 < NQR; ++d0) qr[d0] = *(const GAS bf16x8*)(Qw + d0 * 16);
#pragma unroll
    for (int d0 = NQR; d0 < (K2 ? 12 : 8); ++d0) *(LAS bf16x8*)(q2l + (d0 - NQR) * 1024) = *(const GAS bf16x8*)(Qw + d0 * 16); }
  const int sr = tid >> 4, sc = (tid & 15) * 8, vst0 = v_st(sr, sc), vst1 = v_st(32 + sr, sc);
  const int vb0 = (int)(unsigned)(uintptr_t)V_lds + v_rd_base(lane);
  const GAS bf16* Kp = (const GAS bf16*)d.K + (long)sr * d.ldk + sc; const GAS bf16* Vp = (const GAS bf16*)d.V + (long)sr * d.ldv + sc;
  const GAS bf16* K2p = K2 ? (const GAS bf16*)d.K2 + (long)(tid >> 3) * 64 + (tid & 7) * 8 : nullptr;
  const int k2st = K2SWZ(tid >> 3, (tid & 7) * 16);
  struct { bf16x8 vs0, vs1, ks0, ks1, k2; } sr_[SDEPTH];
  const int NT = d.NT, NTr = d.NTreal;
#define TROW(j) ((j) < 4 ? d.row_ctx + 64 * (j) : d.row_lat + 64 * (((j) < NTr ? (j) : NTr - 1) - 4))
#define SLOAD(i, j) do { const long kr_ = TROW(j); sr_[i].vs0 = *(const GAS bf16x8*)(Vp + kr_ * d.ldv); sr_[i].vs1 = *(const GAS bf16x8*)(Vp + (kr_ + 32) * d.ldv); \
    sr_[i].ks0 = *(const GAS bf16x8*)(Kp + kr_ * d.ldk); sr_[i].ks1 = *(const GAS bf16x8*)(Kp + (kr_ + 32) * d.ldk); \
    if constexpr (K2) sr_[i].k2 = *(const GAS bf16x8*)(K2p + kr_ * 64); } while (0)
#define SWRITE(b, i) do { *(LAS bf16x8*)(V_lds + (b) * SHM_V + vst0) = sr_[i].vs0; *(LAS bf16x8*)(V_lds + (b) * SHM_V + vst1) = sr_[i].vs1; const int kc = sc * 2; \
    *(LAS bf16x8*)(K_lds + (b) * SHM_K + KSWZ(sr, kc)) = sr_[i].ks0; *(LAS bf16x8*)(K_lds + (b) * SHM_K + KSWZ(32 + sr, kc)) = sr_[i].ks1; \
    if constexpr (K2) *(LAS bf16x8*)(K2_lds + (b) * SHM_K2 + k2st) = sr_[i].k2; } while (0)
#define SWAIT() do { if constexpr (SDEPTH == 2) asm volatile("s_waitcnt vmcnt(4)" ::: "memory"); else asm volatile("s_waitcnt vmcnt(0)" ::: "memory"); } while (0)
#define RESC(a) do { if (__any((a) < 1.f)) { if (hi == 0) al_l[r32] = (a); asm volatile("s_waitcnt lgkmcnt(0)" ::: "memory"); \
    _Pragma("unroll") for (int dd = 0; dd < 4; ++dd) _Pragma("unroll") for (int r = 0; r < 16; ++r) o[dd][r] *= al_l[crow(r, hi)]; } } while (0)
  f32x16 pA0, pA1, pB0, pB1; float mnA, mnB, alA, alB; bf16x8 pa0, pa1, pa2, pa3;
  constexpr int SE = 0, SO = SDEPTH - 1;
  SLOAD(SE, 0); asm volatile("s_waitcnt vmcnt(0)" ::: "memory"); SWRITE(0, SE); __syncthreads();
  qkt<K2, NQR>(pA0, pA1, K_lds, K2_lds, qr, q2l, r32, hi); partialSM(pA0, pA1, m_reg, mnA, alA);
  SLOAD(SO, 1); if constexpr (SDEPTH == 2) { if (2 < NT) SLOAD(SE, 2); }
  SWAIT(); SWRITE(1, SO); __syncthreads();
  for (int j = 1; j + 1 < NT; j += 2) {
    SBAR(); qkt<K2, NQR>(pB0, pB1, K_lds + SHM_K, K2_lds + SHM_K2, qr, q2l, r32, hi);
    finishSM(pA0, pA1, alA, l_reg, pa0, pa1, pa2, pa3); SBAR();
    SLOAD(SO, j + SDEPTH); SBAR();
    pv_d0(o, vb0, pa0, pa1, pa2, pa3); if constexpr (MODE != 0) { SBAR(); mask_tile<MODE>(pB0, pB1, d, j, wid, r32, hi, rpbL); SBAR(); } partialSM(pB0, pB1, m_reg, mnB, alB);
    __syncthreads(); SWAIT(); SWRITE(0, SE);
    RESC(alB); __syncthreads();
    SBAR(); qkt<K2, NQR>(pA0, pA1, K_lds, K2_lds, qr, q2l, r32, hi);
    finishSM(pB0, pB1, alB, l_reg, pa0, pa1, pa2, pa3); SBAR();
    if (SDEPTH == 1 || j + 3 < NT) SLOAD(SE, j + 1 + SDEPTH); SBAR();
    pv_d0(o, vb0 + SHM_V, pa0, pa1, pa2, pa3); if constexpr (MODE != 0) { SBAR(); mask_tile<MODE>(pA0, pA1, d, j + 1, wid, r32, hi, rpbL); SBAR(); } partialSM(pA0, pA1, m_reg, mnA, alA);
    __syncthreads(); SWAIT(); SWRITE(1, SO);
    RESC(alA); __syncthreads();
  }
  SBAR(); qkt<K2, NQR>(pB0, pB1, K_lds + SHM_K, K2_lds + SHM_K2, qr, q2l, r32, hi);
  finishSM(pA0, pA1, alA, l_reg, pa0, pa1, pa2, pa3); SBAR();
  pv_d0(o, vb0, pa0, pa1, pa2, pa3); if constexpr (MODE != 0) { SBAR(); mask_tile<MODE>(pB0, pB1, d, NT - 1, wid, r32, hi, rpbL); SBAR(); } partialSM(pB0, pB1, m_reg, mnB, alB);
  __syncthreads(); RESC(alB);
  finishSM(pB0, pB1, alB, l_reg, pa0, pa1, pa2, pa3); SBAR();
  pv_d0(o, vb0 + SHM_V, pa0, pa1, pa2, pa3);
  if (hi == 0) li_l[r32] = l_reg; asm volatile("s_waitcnt lgkmcnt(0)" ::: "memory");
  float rli[16];
#pragma unroll
  for (int r = 0; r < 16; ++r) rli[r] = __builtin_amdgcn_rcpf(li_l[crow(r, hi)]);
  GAS bf16* Ow = (GAS bf16*)d.O + (long)(wid * QBLK) * d.ldo;
#pragma unroll
  for (int r = 0; r < 16; ++r) { const int orow = crow(r, hi);
#pragma unroll
    for (int d0 = 0; d0 < 4; ++d0) { const float x = o[d0][r] * rli[r]; Ow[(long)orow * d.ldo + d0 * 32 + r32] = (bf16)(cvt_pk_bf16(x, x) & 0xffffu); } }
  __syncthreads();
#undef TROW
#undef SLOAD
#undef SWRITE
#undef SWAIT
#undef RESC
}
constexpr int X_V = 0, X_K = 4 * SHM_V, X_P = X_K + 3 * SHM_K, X_WS = X_P + 4 * 4096, X_END = X_WS + NW * 64 * 4;
__device__ __forceinline__ void unit_split(const Desc& d, LAS char* lds) {
  const int tid = threadIdx.x, wid = __builtin_amdgcn_readfirstlane(tid >> 6), lane = tid & 63, r32 = lane & 31, hi = lane >> 5;
  const bool isS = wid < 4; const int w4 = wid & 3;
  LAS char* V_lds = lds + X_V; LAS char* K_lds = lds + X_K; LAS char* P_l = lds + X_P + w4 * 4096 + lane * 16;
  LAS float* wsS = (LAS float*)(lds + X_WS) + w4 * 64; LAS float* al_l = wsS; LAS float* li_l = wsS + 32;
  volatile LAS unsigned* flag = (volatile LAS unsigned*)((LAS float*)(lds + X_WS) + (w4 + 4) * 64);
  const int NT = d.NT;
#define KOFF(i, L) ((4 * (w4 + 4 * (i)) + ((L) >> 4)) * d.ldk + ((((L) & 15) ^ ((4 * (w4 + 4 * (i)) + ((L) >> 4)) & 7)) * 8))
#define VKK(i, L) (((w4 + 4 * (i)) >> 1) * 8 + (((L) & 31) >> 2))
#define VOFF(i, L) (((VKK(i, L) & ~0xC) | ((VKK(i, L) & 4) << 1) | ((VKK(i, L) & 8) >> 1)) * d.ldv + ((w4 + 4 * (i)) & 1) * 64 + ((L) >> 5) * 32 + ((L) & 3) * 8)
#define TROT(j) (((j) + d.rot) >= NT ? ((j) + d.rot) - NT : ((j) + d.rot))
#define TROW(j) (TROT(j) < 4 ? d.row_ctx + 64 * TROT(j) : d.row_lat + 64 * (TROT(j) - 4))
#define GLDS(src, dst) __builtin_amdgcn_global_load_lds((const unsigned*)(src), (LAS unsigned*)(dst), 16, 0, 0)
#define KDMA(j) do { int L_ = lane; asm volatile("" : "+v"(L_)); const GAS bf16* kp_ = (const GAS bf16*)d.K + (long)TROW(j) * d.ldk; LAS char* kb_ = K_lds + ((j) % 3) * SHM_K + w4 * 1024; \
    GLDS(kp_ + KOFF(0, L_), kb_); GLDS(kp_ + KOFF(1, L_), kb_ + 4096); GLDS(kp_ + KOFF(2, L_), kb_ + 8192); GLDS(kp_ + KOFF(3, L_), kb_ + 12288); } while (0)
#define VDMA(j) do { int L_ = lane; asm volatile("" : "+v"(L_)); const GAS bf16* vp_ = (const GAS bf16*)d.V + (long)TROW(j) * d.ldv; LAS char* vb_ = V_lds + ((j) & 1) * 2 * SHM_V + w4 * 1024; \
    _Pragma("unroll") for (int i_ = 0; i_ < 4; ++i_) { const int v_ = VOFF(i_, L_); GLDS(vp_ + v_, vb_ + i_ * 4096); GLDS(vp_ + 128 + v_, vb_ + SHM_V + i_ * 4096); } } while (0)
#define WAITV(n) asm volatile("s_waitcnt vmcnt(" #n ")" ::: "memory")
#define BAR() asm volatile("s_waitcnt lgkmcnt(0)\n\ts_barrier" ::: "memory")
#define KBUF(j) (K_lds + ((j) % 3) * SHM_K)
#define VOFS(j) (((j) & 1) * 2 * SHM_V)
  if (isS) { KDMA(0); VDMA(0); KDMA(1); } WAITV(4); BAR();
  if (isS) {
    float m_reg = d.m0, l_reg = d.l0; bf16x8 qr[8];
    { const GAS bf16* Qw = (const GAS bf16*)d.Q + (long)(w4 * QBLK + r32) * d.ldq + hi * 8;
#pragma unroll
      for (int d0 = 0; d0 < 8; ++d0) qr[d0] = *(const GAS bf16x8*)(Qw + d0 * 16); }
    f32x16 pA0, pA1, pB0, pB1; float mnA, mnB, alA, alB; bf16x8 pa0, pa1, pa2, pa3;
    qkt_pf(pA0, pA1, KBUF(0), qr, r32, hi); partialSM(pA0, pA1, m_reg, mnA, alA);
    WAITV(0); BAR();
    if (2 < NT) KDMA(2);
#define PUBP() do { *(LAS bf16x8*)(P_l) = pa0; *(LAS bf16x8*)(P_l + 1024) = pa1; *(LAS bf16x8*)(P_l + 2048) = pa2; *(LAS bf16x8*)(P_l + 3072) = pa3; } while (0)
#ifdef PROBE_S
#define PROBE_SVALU() do { float dm_ = 1.0f; _Pragma("unroll") for (int q_ = 0; q_ < 32; ++q_) asm volatile("v_exp_f32 %0, %0" : "+v"(dm_)); asm volatile("" :: "v"(dm_)); } while (0)
#else
#define PROBE_SVALU() do { } while (0)
#endif
#define SSTEP(J, PN0, PN1, MNN, ALN, PO0, PO1, ALO, W0, W1) do { \
      SBAR(); qkt_pf(PN0, PN1, KBUF(J), qr, r32, hi); finishSM(PO0, PO1, ALO, l_reg, pa0, pa1, pa2, pa3); SBAR(); PUBP(); \
      W0; BAR();                                                                         \
      VDMA(J); \
      partialSM(PN0, PN1, m_reg, MNN, ALN); PROBE_SVALU(); { const bool rs_ = __any((ALN) < 1.f); if (rs_ && hi == 0) al_l[r32] = (ALN); if (lane == 0) *flag = rs_ ? 1u : 0u; } \
      W1; BAR();                                                                         \
      if ((J) + 2 < NT) KDMA((J) + 2); \
    } while (0)
    for (int j = 1; j + 4 < NT; j += 2) {
      SSTEP(j, pB0, pB1, mnB, alB, pA0, pA1, alA, WAITV(4), WAITV(8));
      SSTEP(j + 1, pA0, pA1, mnA, alA, pB0, pB1, alB, WAITV(4), WAITV(8));
    }
    SSTEP(NT - 3, pB0, pB1, mnB, alB, pA0, pA1, alA, WAITV(4), WAITV(8));
    SSTEP(NT - 2, pA0, pA1, mnA, alA, pB0, pB1, alB, WAITV(0), WAITV(0));
    SSTEP(NT - 1, pB0, pB1, mnB, alB, pA0, pA1, alA, WAITV(0), WAITV(0));
    finishSM(pB0, pB1, alB, l_reg, pa0, pa1, pa2, pa3); SBAR(); PUBP();
    if (hi == 0) li_l[r32] = l_reg;
    WAITV(0); BAR();
    BAR();
#undef PUBP
#undef SSTEP
  } else {
    f32x16 o[8] = {}; bf16x8 pa0, pa1, pa2, pa3; f32x16 dmy = {};
    const int vb0 = (int)(unsigned)(uintptr_t)V_lds + v_rd_base(lane);
    WAITV(0); BAR();
#define GETP() do { pa0 = *(const LAS bf16x8*)(P_l); pa1 = *(const LAS bf16x8*)(P_l + 1024); pa2 = *(const LAS bf16x8*)(P_l + 2048); pa3 = *(const LAS bf16x8*)(P_l + 3072); } while (0)
#ifdef PROBE_V
#define PROBE_VMFMA() do { _Pragma("unroll") for (int q_ = 0; q_ < 16; ++q_) dmy = __builtin_amdgcn_mfma_f32_32x32x16_bf16(pa0, pa1, dmy, 0, 0, 0); asm volatile("" : "+v"(dmy)); } while (0)
#else
#define PROBE_VMFMA() do { } while (0)
#endif
#define VSTEP(J, W0, W1) do { \
      W0; BAR();                                                                         \
      GETP(); asm volatile("s_waitcnt lgkmcnt(0)" ::: "memory"); pv_pipe(o, vb0 + VOFS((J) - 1), pa0, pa1, pa2, pa3); PROBE_VMFMA(); \
      W1; BAR();                                                                         \
      pv_pipe(o + 4, vb0 + VOFS((J) - 1) + SHM_V, pa0, pa1, pa2, pa3); \
      if (__builtin_amdgcn_readfirstlane(*flag)) { \
        _Pragma("unroll") for (int dd = 0; dd < 8; ++dd) _Pragma("unroll") for (int r = 0; r < 16; ++r) o[dd][r] *= al_l[crow(r, hi)]; } \
    } while (0)
    for (int j = 1; j + 4 < NT; j += 2) { VSTEP(j, , ); VSTEP(j + 1, , ); }
    VSTEP(NT - 3, , );
    VSTEP(NT - 2, , );
    VSTEP(NT - 1, , );
    WAITV(0); BAR();
    GETP(); asm volatile("s_waitcnt lgkmcnt(0)" ::: "memory"); pv_pipe(o, vb0 + VOFS(NT - 1), pa0, pa1, pa2, pa3); pv_pipe(o + 4, vb0 + VOFS(NT - 1) + SHM_V, pa0, pa1, pa2, pa3);
    float rli[16];
#pragma unroll
    for (int r = 0; r < 16; ++r) rli[r] = __builtin_amdgcn_rcpf(li_l[crow(r, hi)]);
    GAS bf16* Ow = (GAS bf16*)d.O + (long)(w4 * QBLK) * d.ldo;
    { LAS bf16* stg = (LAS bf16*)(lds + X_P + w4 * 4096);
#pragma unroll
      for (int g = 0; g < 4; ++g) {
#pragma unroll
        for (int r = 0; r < 16; ++r) { const int orow = crow(r, hi); const float x0 = o[2 * g][r] * rli[r], x1 = o[2 * g + 1][r] * rli[r];
          stg[orow * 64 + r32] = (bf16)(cvt_pk_bf16(x0, x0) & 0xffffu); stg[orow * 64 + 32 + r32] = (bf16)(cvt_pk_bf16(x1, x1) & 0xffffu); }
        asm volatile("s_waitcnt lgkmcnt(0)" ::: "memory");
#pragma unroll
        for (int q = 0; q < 4; ++q) { const int idx = q * 64 + lane, row = idx >> 3, ch = idx & 7; const v4u v = *(const LAS v4u*)(stg + row * 64 + ch * 8);
          *(GAS v4u*)(Ow + (long)row * d.ldo + g * 64 + ch * 8) = v; }
        asm volatile("s_waitcnt lgkmcnt(0)" ::: "memory"); } }
    BAR();
#undef GETP
#undef VSTEP
  }
#undef KOFF
#undef VKK
#undef VOFF
#undef TROW
#undef TROT
#undef GLDS
#undef KDMA
#undef VDMA
#undef WAITV
#undef BAR
#undef KBUF
#undef VOFS
}
}
constexpr int NWAVES = 8;
constexpr size_t MiB = 1u << 20;
constexpr size_t WS_CTL = 0, CTL_ZERO_BYTES = 1 * MiB;
constexpr size_t WS_MODP = 1 * MiB;
constexpr size_t WS_MODS = 9 * MiB;
constexpr size_t WS_TAB = 10 * MiB;
constexpr size_t WS_SSQ = 11 * MiB;
constexpr size_t WS_W = 13 * MiB;
constexpr size_t W_SWA_QKV = WS_W, W_SWA_O = W_SWA_QKV + 12 * MiB, W_DIFF_QKV = W_SWA_O + 8 * MiB, W_DIFF_O = W_DIFF_QKV + 24 * MiB;
constexpr size_t W_MLA_DOWN = W_DIFF_O + 8 * MiB, W_MLA_UQ = W_MLA_DOWN + 5 * MiB, W_MLA_UKV = W_MLA_UQ + 3 * MiB, W_MLA_O = W_MLA_UKV + 4 * MiB;
constexpr size_t W_NA_QKV = W_MLA_O + 8 * MiB, W_NA_O = W_NA_QKV + 24 * MiB, W_GU = W_NA_O + 8 * MiB, W_DOWN = W_GU + 4 * 44 * MiB, W_END = W_DOWN + 4 * 22 * MiB;
constexpr size_t WS_H = W_END;
constexpr size_t WS_U = WS_H + 136 * MiB;
constexpr size_t WS_Y = WS_U + 68 * MiB;
constexpr size_t WS_O = WS_Y + 136 * MiB;
constexpr size_t WS_O12 = WS_O + 68 * MiB;
constexpr size_t WS_R1 = WS_O12 + 136 * MiB;
constexpr size_t R1_MLA_Q = WS_R1, R1_MLA_KV = WS_R1 + 102 * MiB, R1_MLA_C = R1_MLA_KV + 136 * MiB, R1_MLA_KPE = R1_MLA_C + 34 * MiB;
constexpr size_t R1_KH = WS_R1 + 68 * MiB, R1_VH = WS_R1 + 136 * MiB;
constexpr size_t WS_YP = WS_R1 + 276 * MiB;
constexpr size_t WS_END = WS_YP + 64 * MiB;
static_assert(W_END == (13 + 368) * MiB && (size_t)MROWS * 6144 * 2 <= 276 * MiB && (size_t)MROWS * FF * 2 <= 276 * MiB && R1_MLA_KPE + (size_t)MROWS * 64 * 2 <= WS_END, "ws map");
constexpr int CW_BAR = 4096;
constexpr int RING_BYTES = 133120, MISC_OFF = 135168, LDS_BYTES = 147456;
static_assert(attn::L_END <= RING_BYTES && attn::X_END <= RING_BYTES && pg8::STAGE_BYTES <= RING_BYTES && 8 * 16640 <= RING_BYTES && MISC_OFF + 128 <= LDS_BYTES, "LDS map");

#define RLX_AGENT __ATOMIC_RELAXED, __HIP_MEMORY_SCOPE_AGENT
#define LDS_WAIT() asm volatile("s_waitcnt lgkmcnt(0)" ::: "memory")

#define XB_TMO      128
#define XB_XCNT(j)  (256  + 64 * (j))
#define XB_XSUB(j)  (1280 + 64 * (j))
#define XB_XGEN(j)  (2304 + 64 * (j))
#define XB_TOP      3328
#define XB_TOPGEN   3392
#define XCD_BAR_WORDS 3456
#define XB_SPIN_CAP (1u << 18)
__device__ __forceinline__ unsigned xb_ld(unsigned* p)              { return __hip_atomic_load(p, __ATOMIC_RELAXED, __HIP_MEMORY_SCOPE_AGENT); }
__device__ __forceinline__ unsigned xb_add(unsigned* p, unsigned v) { return __hip_atomic_fetch_add(p, v, __ATOMIC_RELAXED, __HIP_MEMORY_SCOPE_AGENT); }
__device__ __forceinline__ unsigned xb_xcc_id() { return (unsigned)__builtin_amdgcn_s_getreg((3 << 11) | 20) & 0xFu; }
#define XB_SPIN(cond, bar) do { unsigned _sp = 0; while (cond) { __builtin_amdgcn_s_sleep(1); \
    if ((++_sp & 255u) == 0u) { if (xb_ld(&(bar)[XB_TMO])) break; if (_sp > XB_SPIN_CAP) { atomicAdd(&(bar)[XB_TMO], 1u); break; } } } } while (0)
struct XcdBarrier { unsigned* bar; unsigned x; volatile LAS unsigned* st; };
__device__ __forceinline__ XcdBarrier xcd_barrier_post(unsigned* bar, volatile LAS unsigned* st) {
    XcdBarrier b; b.bar = bar; b.x = xb_xcc_id(); b.st = st;
    if (threadIdx.x == 0) (void)xb_add(&bar[XB_XCNT(b.x)], 1u);
    return b;
}
__device__ __forceinline__ void xcd_barrier_complete(unsigned* bar, unsigned x, unsigned& nloc, unsigned& nx) {
    const unsigned G = gridDim.x * gridDim.y * gridDim.z;
    unsigned sum, cnt, mine, sp = 0u;
    for (;;) {
        sum = 0u; cnt = 0u; mine = 0u;
#pragma unroll
        for (unsigned j = 0; j < 16; ++j) { const unsigned c = xb_ld(&bar[XB_XCNT(j)]); sum += c; cnt += (c > 0u) ? 1u : 0u; mine = (j == x) ? c : mine; }
        if (sum == G) break;
        __builtin_amdgcn_s_sleep(1);
        if ((++sp & 255u) == 0u) { if (xb_ld(&bar[XB_TMO])) break; if (sp > XB_SPIN_CAP) { atomicAdd(&bar[XB_TMO], 1u); break; } }
    }
    nloc = mine > 0u ? mine : 1u; nx = cnt > 0u ? cnt : 1u;
}
__device__ __forceinline__ void xcd_barrier(const XcdBarrier& b) {
    asm volatile("s_waitcnt vmcnt(0)" ::: "memory");
    __syncthreads();
    if (threadIdx.x == 0) {
        unsigned* bar = b.bar;
        __builtin_amdgcn_s_waitcnt(0);
        unsigned nloc = b.st[0], nx = b.st[1];
        if (nloc == 0u) { xcd_barrier_complete(bar, b.x, nloc, nx); b.st[0] = nloc; b.st[1] = nx; }
        const unsigned old = xb_add(&bar[XB_XSUB(b.x)], 1u);
        const unsigned gen = old / nloc;
        if (old + 1u == (gen + 1u) * nloc) {
            __builtin_amdgcn_fence(__ATOMIC_RELEASE, "agent");
            asm volatile("s_waitcnt vmcnt(0)" ::: "memory");
            const unsigned og = xb_add(&bar[XB_TOP], 1u);
            const unsigned tg = og / nx;
            if (og + 1u == (tg + 1u) * nx) xb_add(&bar[XB_TOPGEN], 1u);
            else XB_SPIN(xb_ld(&bar[XB_TOPGEN]) == tg, bar);
            __builtin_amdgcn_fence(__ATOMIC_ACQUIRE, "agent");
            xb_add(&bar[XB_XGEN(b.x)], 1u);
            asm volatile("s_waitcnt vmcnt(0)" ::: "memory");
        } else {
            XB_SPIN(xb_ld(&bar[XB_XGEN(b.x)]) == gen, bar);
            __builtin_amdgcn_fence(__ATOMIC_ACQUIRE, "agent");
            asm volatile("s_waitcnt vmcnt(0)" ::: "memory");
        }
    }
    __syncthreads();
}

enum { I_X = 0, I_C, I_CTX, I_CCTX, I_MODW, I_MODB, I_NORMG, I_WGU, I_WDOWN, I_SWA_QKV, I_SWA_O, I_SWA_SINK, I_DIFF_QKV, I_DIFF_O, I_DIFF_LAM, I_DIFF_SUBLN,
       I_MLA_DOWN, I_MLA_QN, I_MLA_KVN, I_MLA_UQ, I_MLA_UKV, I_MLA_O, I_NA_QKV, I_NA_O, I_NA_RPB, N_IN };
struct Args { const float* in[N_IN]; float* out; unsigned char* ws; int ph_lo, ph_hi, li, pad; };

struct Frame {
    LAS unsigned char* lds;
    int tid, lane, wave, vcu, G;
    unsigned char* ws;
};
__device__ __forceinline__ float wave_sum(float v) {
#pragma unroll
    for (int o = 1; o < 64; o <<= 1) v += __shfl_xor(v, o);
    return v;
}
__device__ __forceinline__ float ssq4(const f32x4 v) { return (v[0] * v[0] + v[1] * v[1]) + (v[2] * v[2] + v[3] * v[3]); }

constexpr float DIFF_LAM_INIT = 0.35550906759096926f;
struct CJob { const float* W; bf16* WT; int K, Nsrc, Ng, gu, rmod, rlo, rmax, pt; const float* kg; int kmask; float ks; };
constexpr int CJ_ITEMS[18] = {1536, 1024, 3072, 1024, 640, 384, 512, 1024, 3072, 1024, 5632, 5632, 5632, 5632, 2816, 2816, 2816, 2816};
constexpr int CJ_TOTAL = 47104;
__device__ __forceinline__ CJob cjob(const Args& a, int j) {
    unsigned char* ws = a.ws; CJob c; c.gu = 0; c.rmod = 1 << 30; c.rlo = 0; c.rmax = 0; c.pt = 0; c.kg = nullptr; c.kmask = -1; c.ks = 1.f;
    switch (j) {
    case 0: c.W = a.in[I_SWA_QKV]; c.WT = (bf16*)(ws + W_SWA_QKV); c.K = 2048; c.Nsrc = 3072; c.Ng = 3072; c.rmax = 2560; c.pt = 1; break;
    case 1: c.W = a.in[I_SWA_O]; c.WT = (bf16*)(ws + W_SWA_O); c.K = 2048; c.Nsrc = 2048; c.Ng = 2048; break;
    case 2: c.W = a.in[I_DIFF_QKV]; c.WT = (bf16*)(ws + W_DIFF_QKV); c.K = 2048; c.Nsrc = 6144; c.Ng = 6144; c.rmax = 4096; c.pt = 1; break;
    case 3: c.W = a.in[I_DIFF_O]; c.WT = (bf16*)(ws + W_DIFF_O); c.K = 2048; c.Nsrc = 2048; c.Ng = 2048; c.kg = a.in[I_DIFF_SUBLN]; c.kmask = 255; c.ks = 1.f - DIFF_LAM_INIT; break;
    case 4: c.W = a.in[I_MLA_DOWN]; c.WT = (bf16*)(ws + W_MLA_DOWN); c.K = 2048; c.Nsrc = 1088; c.Ng = 1280; c.rlo = 1024; c.rmax = 1088; c.pt = 2; break;
    case 5: c.W = a.in[I_MLA_UQ]; c.WT = (bf16*)(ws + W_MLA_UQ); c.K = 512; c.Nsrc = 3072; c.Ng = 3072; c.rmod = 192; c.rlo = 128; c.rmax = 3072; c.pt = 2; c.kg = a.in[I_MLA_QN]; break;
    case 6: c.W = a.in[I_MLA_UKV]; c.WT = (bf16*)(ws + W_MLA_UKV); c.K = 512; c.Nsrc = 4096; c.Ng = 4096; c.kg = a.in[I_MLA_KVN]; break;
    case 7: c.W = a.in[I_MLA_O]; c.WT = (bf16*)(ws + W_MLA_O); c.K = 2048; c.Nsrc = 2048; c.Ng = 2048; break;
    case 8: c.W = a.in[I_NA_QKV]; c.WT = (bf16*)(ws + W_NA_QKV); c.K = 2048; c.Nsrc = 6144; c.Ng = 6144; break;
    case 9: c.W = a.in[I_NA_O]; c.WT = (bf16*)(ws + W_NA_O); c.K = 2048; c.Nsrc = 2048; c.Ng = 2048; break;
    case 10: case 11: case 12: case 13: c.W = a.in[I_WGU] + (size_t)(j - 10) * DM * 2 * FF; c.WT = (bf16*)(ws + W_GU + (size_t)(j - 10) * 44 * MiB); c.K = 2048; c.Nsrc = 2 * FF; c.Ng = 2 * FF; c.gu = 1; break;
    default: c.W = a.in[I_WDOWN] + (size_t)(j - 14) * FF * DM; c.WT = (bf16*)(ws + W_DOWN + (size_t)(j - 14) * 22 * MiB); c.K = FF; c.Nsrc = 2048; c.Ng = 2048; break;
    }
    return c;
}
__device__ __forceinline__ void convert_item(const CJob& c, int it, LAS float* scr, int lane) {
    const int ngr = c.Ng >> 6, kb = it / ngr, gi = it - kb * ngr, k0 = kb * 64, n0 = gi * 64;
    int sb = n0; if (c.gu) { const int pn = n0 >> 8, bj = (n0 >> 7) & 1, j = n0 & 127; sb = bj * FF + pn * 128 + j; }
    const bool zero = sb >= c.Nsrc, rope = ((n0 % c.rmod) >= c.rlo) && (n0 < c.rmax);
    if (!zero) {
        const GAS f32x4* wp = (const GAS f32x4*)(c.W + (size_t)(k0 + (lane >> 4)) * c.Nsrc + sb + (lane & 15) * 4);
        f32x4 v[16];
#pragma unroll
        for (int i = 0; i < 16; ++i) v[i] = wp[(size_t)i * c.Nsrc];
#pragma unroll
        for (int i = 0; i < 16; ++i) { LAS float* s = scr + (4 * i + (lane >> 4)) * 65 + (lane & 15) * 4; s[0] = v[i][0]; s[1] = v[i][1]; s[2] = v[i][2]; s[3] = v[i][3]; }
    }
    LDS_WAIT(); asm volatile("" ::: "memory");
    const int cch = lane & 7;
    float g[8];
#pragma unroll
    for (int t = 0; t < 8; ++t) g[t] = c.kg ? ((const GAS float*)c.kg)[(k0 + 8 * cch + t) & c.kmask] * c.ks : 1.f;
#pragma unroll
    for (int j8 = 0; j8 < 8; ++j8) { const int nn = (lane >> 3) + 8 * j8;
        int src = nn; if (rope) src = (c.pt == 1) ? ((nn & 1) * 32 + (nn >> 1)) : ((nn >> 5) * 32 + (nn & 1) * 16 + ((nn & 31) >> 1));
        const LAS float* s = scr + (8 * cch) * 65 + src; v4u o;
        if (zero) o = (v4u){0u, 0u, 0u, 0u};
        else { o.x = cvt_pk_bf16(s[0 * 65] * g[0], s[1 * 65] * g[1]); o.y = cvt_pk_bf16(s[2 * 65] * g[2], s[3 * 65] * g[3]); o.z = cvt_pk_bf16(s[4 * 65] * g[4], s[5 * 65] * g[5]); o.w = cvt_pk_bf16(s[6 * 65] * g[6], s[7 * 65] * g[7]); }
        *(GAS v4u*)(c.WT + (size_t)(n0 + nn) * c.K + k0 + 8 * cch) = o; }
    LDS_WAIT(); asm volatile("" ::: "memory");
}
__device__ __forceinline__ void p0a(Frame& F, const Args& a) {
    LAS float* scr = (LAS float*)(F.lds + F.wave * 16640);
    const int gw = F.vcu * NWAVES + F.wave, NGW = F.G * NWAVES, lane = F.lane;
    for (int t = gw; t < 4 * 48 * 8; t += NGW) {
        const int l = t / 384, rem = t - l * 384, cg = rem >> 3, ks = rem & 7;
#pragma unroll
        for (int r = 0; r < 5; ++r)
#pragma unroll
            for (int q = 0; q < 4; ++q) { const int k = ks * 256 + lane + 64 * q; const float v = (r < 4) ? ((const GAS float*)a.in[I_C])[r * DM + k] : ((const GAS float*)a.in[I_CCTX])[k];
                scr[r * 256 + lane + 64 * q] = v / (1.f + __expf(-v)); }
        LDS_WAIT(); asm volatile("" ::: "memory");
        f32x4 acc[5];
#pragma unroll
        for (int r = 0; r < 5; ++r) acc[r] = (f32x4){0.f, 0.f, 0.f, 0.f};
        const GAS f32x4* wp = (const GAS f32x4*)(a.in[I_MODW] + ((size_t)l * DM + ks * 256) * MODW + cg * 256 + lane * 4);
        for (int kk = 0; kk < 256; kk += 8) { f32x4 w[8];
#pragma unroll
            for (int i = 0; i < 8; ++i) w[i] = wp[(size_t)(kk + i) * (MODW / 4)];
#pragma unroll
            for (int i = 0; i < 8; ++i)
#pragma unroll
                for (int r = 0; r < 5; ++r) acc[r] += w[i] * scr[r * 256 + kk + i]; }
#pragma unroll
        for (int r = 0; r < 5; ++r) *(GAS f32x4*)((float*)(F.ws + WS_MODP) + ((size_t)(l * 8 + ks) * 5 + r) * MODW + cg * 256 + lane * 4) = acc[r];
        LDS_WAIT(); asm volatile("" ::: "memory");
    }
    for (int gidx = gw; gidx < CJ_TOTAL; gidx += NGW) {
        int j = 0, it = gidx;
#pragma unroll
        for (int q = 0; q < 17; ++q) { if (it >= CJ_ITEMS[q] && j == q) { it -= CJ_ITEMS[q]; j = q + 1; } }
        const CJob c = cjob(a, j);
        convert_item(c, it, scr, lane);
    }
    if (blockIdx.x == 0) {
        const float L2T = 13.287712379549449f;
        GAS f32x4* T128 = (GAS f32x4*)(F.ws + WS_TAB); GAS f32x4* T64 = (GAS f32x4*)(F.ws + WS_TAB + 16384);
        for (int e = F.tid; e < 1024 + 512; e += 512) {
            int pos, k, n; if (e < 1024) { pos = e >> 4; k = e & 15; n = 32; } else { pos = (e - 1024) >> 3; k = (e - 1024) & 7; n = 16; }
            f32x4 o;
#pragma unroll
            for (int q = 0; q < 2; ++q) { const float inv = exp2f(-(float)(2 * k + q) / (float)n * L2T); const float ang = (float)pos * inv; float rev = ang * 0.15915494309189535f; rev -= floorf(rev);
                o[2 * q] = __builtin_amdgcn_cosf(rev); o[2 * q + 1] = __builtin_amdgcn_sinf(rev); }
            if (e < 1024) T128[e] = o; else T64[e - 1024] = o;
        }
    }
    if (blockIdx.x == 1 && F.wave == 0) {
        const GAS float* lv = (const GAS float*)a.in[I_DIFF_LAM];
        const float s1 = wave_sum(lv[lane] * lv[128 + lane] + lv[64 + lane] * lv[192 + lane]), s2 = wave_sum(lv[256 + lane] * lv[384 + lane] + lv[320 + lane] * lv[448 + lane]);
        if (lane == 0) *(GAS float*)(F.ws + WS_TAB + 32768) = expf(s1) - expf(s2) + DIFF_LAM_INIT;
    }
}
__device__ __forceinline__ void p0b(Frame& F, const Args& a) {
    for (int gid = blockIdx.x * 512 + F.tid; gid < 4 * 5 * (MODW / 4); gid += F.G * 512) {
        const int l = gid / (5 * (MODW / 4)), rem = gid - l * (5 * (MODW / 4)), r = rem / (MODW / 4), j4 = rem - r * (MODW / 4);
        f32x4 s = *(const GAS f32x4*)(a.in[I_MODB] + (size_t)l * MODW + 4 * j4);
#pragma unroll
        for (int ks = 0; ks < 8; ++ks) s += *(const GAS f32x4*)((const float*)(F.ws + WS_MODP) + ((size_t)(l * 8 + ks) * 5 + r) * MODW + 4 * j4);
        *(GAS f32x4*)((float*)(F.ws + WS_MODS) + ((size_t)l * 5 + r) * MODW + 4 * j4) = s;
    }
}
template <int KIND>
__device__ __forceinline__ void thin_phase(Frame& F, const Args& a, int lg, int sub, bool latent_only, int ysplit, bool dry = false) {
    const int gw = F.vcu * NWAVES + F.wave, NGW = F.G * NWAVES, lane = F.lane;
    const int lu = (KIND == 0) ? 0 : (sub == 0 ? lg : lg + 1), subu = (KIND == 0) ? 0 : 1 - sub;
    const GAS float* MODS = (const GAS float*)(F.ws + WS_MODS); const GAS float* NG = (const GAS float*)a.in[I_NORMG];
    for (int m = gw; m < MROWS; m += NGW) {
        const int b = m / TPB, rr = m - b * TPB; const bool isctx = rr < CTXL; const int mr = isctx ? 4 : b;
        if ((latent_only || KIND == 2) && isctx) continue;
        f32x4 h[8];
        if (KIND == 0) { const GAS f32x4* hp = (const GAS f32x4*)(isctx ? a.in[I_CTX] + ((size_t)b * CTXL + rr) * DM : a.in[I_X] + ((size_t)b * SEQ + (rr - CTXL)) * DM);
#pragma unroll
          for (int j = 0; j < 8; ++j) h[j] = hp[64 * j + lane]; }
        else { const GAS unsigned long long* hp = (const GAS unsigned long long*)((const bf16*)(F.ws + WS_H) + (size_t)m * DM);
#pragma unroll
          for (int j = 0; j < 8; ++j) { const unsigned long long w = hp[64 * j + lane]; const unsigned lo = (unsigned)w, hi = (unsigned)(w >> 32);
            h[j] = (f32x4){__builtin_bit_cast(float, lo << 16), __builtin_bit_cast(float, lo & 0xffff0000u), __builtin_bit_cast(float, hi << 16), __builtin_bit_cast(float, hi & 0xffff0000u)}; } }
        if (KIND != 0) {
            f32x4 y[8]; float ss = 0.f;
            if (!(isctx && ysplit)) { const GAS unsigned long long* yp = (const GAS unsigned long long*)((const bf16*)(F.ws + WS_Y) + (size_t)m * DM);
#pragma unroll
                for (int j = 0; j < 8; ++j) { const unsigned long long w = yp[64 * j + lane]; const unsigned lo = (unsigned)w, hi = (unsigned)(w >> 32);
                    y[j] = (f32x4){__builtin_bit_cast(float, lo << 16), __builtin_bit_cast(float, lo & 0xffff0000u), __builtin_bit_cast(float, hi << 16), __builtin_bit_cast(float, hi & 0xffff0000u)}; }
            } else {
                const GAS f32x4* sp = (const GAS f32x4*)((const float*)(F.ws + WS_YP) + ((size_t)b * CTXL + rr) * DM);
#pragma unroll
                for (int j = 0; j < 8; ++j) y[j] = sp[64 * j + lane];
#pragma unroll 1
                for (int ks = 1; ks < ysplit; ++ks) { sp += (size_t)1024 * DM / 4;
#pragma unroll
                    for (int j = 0; j < 8; ++j) y[j] += sp[64 * j + lane]; } }
#pragma unroll
            for (int j = 0; j < 8; ++j) ss += ssq4(y[j]);
            const float rstd = __builtin_amdgcn_rsqf(wave_sum(ss) * (1.f / DM) + EPS);
            const GAS f32x4* gt = (const GAS f32x4*)(MODS + ((size_t)lg * 5 + mr) * MODW + (sub ? 5 : 2) * DM); const GAS f32x4* gp = (const GAS f32x4*)(NG + ((size_t)lg * 4 + (sub ? 3 : 1)) * DM);
#pragma unroll
            for (int j = 0; j < 8; ++j) h[j] += gt[64 * j + lane] * (y[j] * rstd) * gp[64 * j + lane];
        }
        if (KIND == 2) { GAS f32x4* op = (GAS f32x4*)(a.out + ((size_t)b * SEQ + (rr - CTXL)) * DM);
#pragma unroll
            for (int j = 0; j < 8; ++j) op[64 * j + lane] = h[j];
        } else {
            GAS unsigned long long* hp = (GAS unsigned long long*)((bf16*)(F.ws + (dry ? WS_O12 : WS_H)) + (size_t)m * DM); float ss = 0.f;
#pragma unroll
            for (int j = 0; j < 8; ++j) { hp[64 * j + lane] = (unsigned long long)cvt_pk_bf16(h[j][0], h[j][1]) | ((unsigned long long)cvt_pk_bf16(h[j][2], h[j][3]) << 32); ss += ssq4(h[j]); }
            const float rstd = __builtin_amdgcn_rsqf(wave_sum(ss) * (1.f / DM) + EPS);
            const GAS float* mv = MODS + ((size_t)lu * 5 + mr) * MODW;
            const GAS f32x4* sh = (const GAS f32x4*)(mv + (subu ? 3 : 0) * DM); const GAS f32x4* scl = (const GAS f32x4*)(mv + (subu ? 4 : 1) * DM); const GAS f32x4* gp = (const GAS f32x4*)(NG + ((size_t)lu * 4 + (subu ? 2 : 0)) * DM);
            GAS unsigned long long* up = (GAS unsigned long long*)((bf16*)(F.ws + (dry ? WS_O : WS_U)) + (size_t)m * DM);
#pragma unroll
            for (int j = 0; j < 8; ++j) { const f32x4 u = (h[j] * rstd) * gp[64 * j + lane] * (scl[64 * j + lane] + 1.f) + sh[64 * j + lane];
                up[64 * j + lane] = (unsigned long long)cvt_pk_bf16(u[0], u[1]) | ((unsigned long long)cvt_pk_bf16(u[2], u[3]) << 32); }
        }
    }
}
__device__ __forceinline__ void diff_combine(Frame& F) {
    const int gw = F.vcu * NWAVES + F.wave, NGW = F.G * NWAVES, lane = F.lane;
    const float lam = *(const GAS float*)(F.ws + WS_TAB + 32768);
    for (int m = gw; m < MROWS; m += NGW) {
        const GAS v4u* p1 = (const GAS v4u*)((const bf16*)(F.ws + WS_O12) + (size_t)m * 4096); GAS v4u* po = (GAS v4u*)((bf16*)(F.ws + WS_O) + (size_t)m * DM);
#pragma unroll
        for (int s = 0; s < 4; ++s) { const v4u a1 = p1[64 * s + lane], a2 = p1[256 + 64 * s + lane]; float x[8]; float ss = 0.f;
#pragma unroll
            for (int q = 0; q < 4; ++q) { const unsigned w1 = a1[q], w2 = a2[q];
                x[2 * q] = __builtin_bit_cast(float, w1 << 16) - lam * __builtin_bit_cast(float, w2 << 16); x[2 * q + 1] = __builtin_bit_cast(float, w1 & 0xffff0000u) - lam * __builtin_bit_cast(float, w2 & 0xffff0000u);
                ss += x[2 * q] * x[2 * q] + x[2 * q + 1] * x[2 * q + 1]; }
#pragma unroll
            for (int o = 1; o < 32; o <<= 1) ss += __shfl_xor(ss, o);
            const float rstd = __builtin_amdgcn_rsqf(ss * (1.f / 256.f) + EPS);
            v4u w; w.x = cvt_pk_bf16(x[0] * rstd, x[1] * rstd); w.y = cvt_pk_bf16(x[2] * rstd, x[3] * rstd); w.z = cvt_pk_bf16(x[4] * rstd, x[5] * rstd); w.w = cvt_pk_bf16(x[6] * rstd, x[7] * rstd);
            po[64 * s + lane] = w; }
    }
}
__device__ __forceinline__ void attn_swa_phase(Frame& F, const Args& a) {
    const bf16* QKV = (const bf16*)(F.ws + WS_R1); bf16* O = (bf16*)(F.ws + WS_O);
    for (int u = F.vcu; u < 1024 + 64; u += F.G) {
        attn::Desc d; int b, hq; long qrow;
        if (u < 1024) { const int bh = u >> 4, qb = u & 15; b = bh >> 4; hq = bh & 15; qrow = (long)b * TPB + CTXL + 256 * qb;
            const int t0 = 256 * qb, tlo = t0 - 128 < 0 ? 0 : t0 - 128, thi = t0 + 384 > SEQ ? SEQ : t0 + 384;
            d.NT = 4 + (thi - tlo) / 64; d.row_lat = b * TPB + CTXL + tlo; d.a0 = tlo - t0;
        } else { const int bh = u - 1024; b = bh >> 4; hq = bh & 15; qrow = (long)b * TPB; d.NT = 4; d.row_lat = b * TPB + CTXL; d.a0 = 0; }
        const int hk = hq >> 2;
        d.NTreal = d.NT; d.row_ctx = b * TPB; d.a1 = 0; d.rpb = nullptr; d.K2 = nullptr; d.rot = 0;
        d.Q = QKV + qrow * 3072 + 128 * hq; d.K = QKV + 2048 + 128 * hk; d.V = QKV + 2560 + 128 * hk; d.O = O + qrow * DM + 128 * hq;
        d.ldq = 3072; d.ldk = 3072; d.ldv = 3072; d.ldo = DM;
        d.m0 = ((const GAS float*)a.in[I_SWA_SINK])[hq]; d.l0 = 1.f;
        attn::unit<1, false, 2, 8>(d, (LAS char*)F.lds);
    }
}
__device__ __forceinline__ void attn_diff_phase(Frame& F) {
    const bf16* Q = (const bf16*)(F.ws + WS_R1); const bf16* KH = (const bf16*)(F.ws + R1_KH); const bf16* VH = (const bf16*)(F.ws + R1_VH); bf16* O12 = (bf16*)(F.ws + WS_O12);
    for (int u = F.vcu; u < 2048 + 128; u += F.G) {
        attn::Desc d; int bhc; long qrow;
        if (u < 2048) { bhc = u >> 5; qrow = (long)(bhc >> 4) * TPB + CTXL + 128 * (u & 31); d.NT = 68; }
        else { bhc = (u - 2048) >> 1; qrow = (long)(bhc >> 4) * TPB + 128 * (u & 1); d.NT = 4; }
        const int b = bhc >> 4, h = (bhc >> 1) & 7, c = bhc & 1;
        d.NTreal = d.NT; d.row_ctx = b * TPB; d.row_lat = b * TPB + CTXL; d.a0 = 0; d.a1 = 0; d.rpb = nullptr; d.K2 = nullptr; d.m0 = -1e30f; d.l0 = 0.f; d.rot = 0;
        d.Q = Q + qrow * 2048 + 256 * h + 128 * c; d.K = KH + (size_t)(2 * h + c) * MROWS * 128; d.V = VH + (size_t)h * MROWS * 256; d.O = O12 + qrow * 4096 + 2048 * c + 256 * h;
        d.ldq = 2048; d.ldk = 128; d.ldv = 256; d.ldo = 4096;
        attn::unit_split(d, (LAS char*)F.lds);
    }
}
__device__ __forceinline__ void attn_mla_phase(Frame& F) {
    const bf16* Qp = (const bf16*)(F.ws + R1_MLA_Q); const bf16* KV = (const bf16*)(F.ws + R1_MLA_KV); const bf16* KPE = (const bf16*)(F.ws + R1_MLA_KPE); bf16* O = (bf16*)(F.ws + WS_O);
    for (int u = F.vcu; u < 1024 + 64; u += F.G) {
        attn::Desc d; int bh; long qrow;
        if (u < 1024) { bh = u >> 4; const int qb = u & 15; qrow = (long)(bh >> 4) * TPB + CTXL + 256 * qb; d.NT = 68; }
        else { bh = u - 1024; qrow = (long)(bh >> 4) * TPB; d.NT = 4; }
        const int b = bh >> 4, h = bh & 15;
        d.NTreal = d.NT; d.row_ctx = b * TPB; d.row_lat = b * TPB + CTXL; d.a0 = 0; d.a1 = 0; d.rpb = nullptr; d.m0 = -1e30f; d.l0 = 0.f; d.rot = 0;
        d.Q = Qp + qrow * 3072 + 192 * h; d.K = KV + 256 * h; d.V = KV + 256 * h + 128; d.K2 = KPE; d.O = O + qrow * DM + 128 * h;
        d.ldq = 3072; d.ldk = 4096; d.ldv = 4096; d.ldo = DM;
        attn::unit<0, true, 1, 8>(d, (LAS char*)F.lds);
    }
}
__device__ __forceinline__ void attn_na_phase(Frame& F, const Args& a) {
    const bf16* QKV = (const bf16*)(F.ws + WS_R1); bf16* O = (bf16*)(F.ws + WS_O);
    for (int u = F.vcu; u < 1024; u += F.G) {
        attn::Desc d; const int bh = u >> 4, R = u & 15, b = bh >> 4, h = bh & 15; const long qrow = (long)b * TPB + CTXL + 256 * R;
        const int krlo = 4 * R - 4 < 0 ? 0 : 4 * R - 4; int krhi = 4 * R - 1; krhi = (krhi < 0 ? 0 : (krhi > 56 ? 56 : krhi)) + 8;
        d.NTreal = 4 + (krhi - krlo); d.NT = (d.NTreal + 1) & ~1; d.row_ctx = b * TPB; d.row_lat = b * TPB + CTXL + 64 * krlo; d.a0 = krlo; d.a1 = 4 * R;
        d.rpb = a.in[I_NA_RPB] + h * 465; d.K2 = nullptr; d.m0 = -1e30f; d.l0 = 0.f; d.rot = 0;
        d.Q = QKV + qrow * 6144 + 128 * h; d.K = QKV + 2048 + 128 * h; d.V = QKV + 4096 + 128 * h; d.O = O + qrow * DM + 128 * h;
        d.ldq = 6144; d.ldk = 6144; d.ldv = 6144; d.ldo = DM;
        attn::unit<2, false, 1, 4>(d, (LAS char*)F.lds);
    }
}

constexpr int NPH = 33;
#ifndef PROBE_DUP
#define PROBE_DUP (-1)
#endif
constexpr int WO_SPLIT = 8, DN_SPLIT = 4;
__global__ void __launch_bounds__(NWAVES * 64, 2) fwd_kernel(Args args) {
    extern __shared__ __attribute__((aligned(16))) unsigned char lds_raw[];
    Frame F; F.lds = (LAS unsigned char*)lds_raw; F.tid = threadIdx.x; F.lane = F.tid & 63; F.wave = __builtin_amdgcn_readfirstlane(F.tid >> 6);
    F.G = gridDim.x; { const int bx = blockIdx.x; F.vcu = (F.G % 8 == 0) ? (bx % 8) * (F.G / 8) + bx / 8 : bx; }
    F.ws = args.ws;
    volatile LAS unsigned* MISC = (volatile LAS unsigned*)(F.lds + MISC_OFF);
    if (F.tid < 32) MISC[F.tid] = 0u;
    __syncthreads();
    XcdBarrier bar = xcd_barrier_post((unsigned*)(args.ws + WS_CTL) + CW_BAR + args.li * XCD_BAR_WORDS, MISC + 8);
    const int lo = args.ph_lo, hi = args.ph_hi;
#define IN(k) (lo <= (k) && (k) < hi)
#define SEAM(k) do { if ((k) + 1 < hi) xcd_barrier(bar); } while (0)
    unsigned char* ws = args.ws;
    const float* T128 = (const float*)(ws + WS_TAB); const float* T64 = (const float*)(ws + WS_TAB + 16384);
    bf16* U = (bf16*)(ws + WS_U); bf16* Y = (bf16*)(ws + WS_Y); float* YP = (float*)(ws + WS_YP); bf16* O = (bf16*)(ws + WS_O); bf16* R1 = (bf16*)(ws + WS_R1);
    const int bx = (int)blockIdx.x;
#define GEMM_ALL(Abuf, lda_, Wt, N_, K_, EpiT, ...) do { pg8::Gemm g{(const bf16*)(Abuf), (const bf16*)(Wt), MROWS, (N_), (K_), (lda_)}; pg8::StaticOrder S; S.init(MROWS, (N_), (K_), F.G, bx); \
        EpiT E{__VA_ARGS__}; pg8::gemm_phase<EpiT, pg8::StaticOrder>(F.lds, g, S, E); } while (0)
#define GEMM_LAT(Abuf, lda_, Wt, N_, K_, EpiT, ...) do { pg8::Gemm g{(const bf16*)(Abuf), (const bf16*)(Wt), MROWS, (N_), (K_), (lda_)}; pg8::LatentOrder S; S.init(NBATCH * SEQ, (N_), (K_), F.G, bx); \
        EpiT E{__VA_ARGS__}; pg8::gemm_phase<EpiT, pg8::LatentOrder>(F.lds, g, S, E); } while (0)
#define GEMM_CSP(Abuf, lda_, Wt, N_, K_, S_, EpiT, ...) do { pg8::Gemm g{(const bf16*)(Abuf), (const bf16*)(Wt), MROWS, (N_), (K_), (lda_)}; pg8::CtxSplitOrder S; S.init(NBATCH * SEQ, (N_), (K_), F.G, bx); S.S = (S_); S.ntS = (K_) / 64 / (S_); \
        EpiT E{__VA_ARGS__}; pg8::gemm_phase<EpiT, pg8::CtxSplitOrder>(F.lds, g, S, E); } while (0)
#ifdef PROBE_THIN
#define THIN_DRY(x) do { x; xcd_barrier(bar); } while (0)
#else
#define THIN_DRY(x) do { } while (0)
#endif
#ifdef PROBE_COLD
#define COLD_DUP(l, x) do { if ((l) == PROBE_COLD) { x; xcd_barrier(bar); } } while (0)
#else
#define COLD_DUP(l, x) do { } while (0)
#endif
#define PHASE(k, ...) do { if (IN(k)) { __VA_ARGS__; if (PROBE_DUP == (k)) { xcd_barrier(bar); __VA_ARGS__; } SEAM(k); } } while (0)
#define FFN_PART(l, p0) do { \
        PHASE((p0) + 0, THIN_DRY(thin_phase<1>(F, args, (l), 0, false, WO_SPLIT, true)); thin_phase<1>(F, args, (l), 0, false, WO_SPLIT)); \
        PHASE((p0) + 1, COLD_DUP(l, GEMM_ALL(U, DM, ws + W_GU + (size_t)(((l) + 1) & 3) * 44 * MiB, 2 * FF, DM, pg8::EpiSwiGLU, R1, FF)); GEMM_ALL(U, DM, ws + W_GU + (size_t)(l) * 44 * MiB, 2 * FF, DM, pg8::EpiSwiGLU, R1, FF)); \
        PHASE((p0) + 2, GEMM_CSP(R1, FF, ws + W_DOWN + (size_t)(l) * 22 * MiB, DM, FF, DN_SPLIT, pg8::EpiF32, Y, DM, YP)); \
        PHASE((p0) + 3, THIN_DRY(thin_phase<1>(F, args, (l), 1, false, DN_SPLIT, true)); thin_phase<1>(F, args, (l), 1, false, DN_SPLIT)); } while (0)

    PHASE(0, p0a(F, args));
    PHASE(1, p0b(F, args));
    PHASE(2, thin_phase<0>(F, args, 0, 0, false, 0));
#ifdef PROBE_XBAR
    for (int xb = 0; xb < PROBE_XBAR; ++xb) xcd_barrier(bar);
#endif
    PHASE(3, GEMM_ALL(U, DM, ws + W_SWA_QKV, 3072, DM, pg8::EpiQKV, R1, 3072, 8, 10, 0.08838834764831845f, T128, nullptr, nullptr, 0, 1));
    PHASE(4, attn_swa_phase(F, args));
    PHASE(5, GEMM_CSP(O, DM, ws + W_SWA_O, DM, DM, WO_SPLIT, pg8::EpiF32, Y, DM, YP));
    FFN_PART(0, 6);
    PHASE(10, GEMM_ALL(U, DM, ws + W_DIFF_QKV, 6144, DM, pg8::EpiQKV, R1, 2048, 8, 16, 0.08838834764831845f, T128, (bf16*)(ws + R1_KH), (bf16*)(ws + R1_VH), 16, 2));
    PHASE(11, attn_diff_phase(F));
    PHASE(12, diff_combine(F));
    PHASE(13, GEMM_CSP(O, DM, ws + W_DIFF_O, DM, DM, WO_SPLIT, pg8::EpiF32, Y, DM, YP));
    FFN_PART(1, 14);
    PHASE(18, GEMM_ALL(U, DM, ws + W_MLA_DOWN, 1280, DM, pg8::EpiMlaDown, (bf16*)(ws + R1_MLA_C), (bf16*)(ws + R1_MLA_KPE), (float*)(ws + WS_SSQ), T64));
    PHASE(19, GEMM_ALL(ws + R1_MLA_C, 1024, ws + W_MLA_UQ, 3072, 512, pg8::EpiMlaUp<true>, (bf16*)(ws + R1_MLA_Q), 3072, (const float*)(ws + WS_SSQ), 0, 0.07216878364870323f, T64);
              GEMM_ALL(ws + R1_MLA_C + 1024, 1024, ws + W_MLA_UKV, 4096, 512, pg8::EpiMlaUp<false>, (bf16*)(ws + R1_MLA_KV), 4096, (const float*)(ws + WS_SSQ), 1, 1.f, T64));
    PHASE(20, attn_mla_phase(F));
    PHASE(21, GEMM_CSP(O, DM, ws + W_MLA_O, DM, DM, WO_SPLIT, pg8::EpiF32, Y, DM, YP));
    FFN_PART(2, 22);
    PHASE(26, GEMM_ALL(U, DM, ws + W_NA_QKV, 6144, DM, pg8::EpiQKV, R1, 6144, 8, 0, 0.08838834764831845f, T128, nullptr, nullptr, 0, 1));
    PHASE(27, attn_na_phase(F, args));
    PHASE(28, GEMM_LAT(O, DM, ws + W_NA_O, DM, DM, pg8::EpiF32, Y, DM, YP));
    PHASE(29, thin_phase<1>(F, args, 3, 0, true, 0));
    PHASE(30, GEMM_LAT(U, DM, ws + W_GU + (size_t)3 * 44 * MiB, 2 * FF, DM, pg8::EpiSwiGLU, R1, FF));
    PHASE(31, GEMM_LAT(R1, FF, ws + W_DOWN + (size_t)3 * 22 * MiB, DM, FF, pg8::EpiF32, Y, DM, YP));
    PHASE(32, thin_phase<2>(F, args, 3, 1, true, 0));
#undef IN
#undef SEAM
}

#ifndef MK_PER_PHASE
#define MK_PER_PHASE 0
#endif
extern "C" void kernel_launch(void* const* d_in, const int* in_sizes, int n_in, void* d_out, int out_size, void* d_ws, size_t ws_size, hipStream_t stream) {
    static int grid = 0;
    if (grid == 0) {
        if (n_in != N_IN || in_sizes[0] != NBATCH * SEQ * DM || out_size != NBATCH * SEQ * DM || ws_size < WS_END) {
            fprintf(stderr, "kernel_launch: shape mismatch (n_in %d, in0 %d, out %d, ws %zu, need %zu)\n", n_in, n_in > 0 ? in_sizes[0] : -1, out_size, ws_size, (size_t)WS_END); grid = -1; return; }
        int dev = 0, cus = 0, per_cu = 0;
        if (hipGetDevice(&dev) != hipSuccess || hipDeviceGetAttribute(&cus, hipDeviceAttributeMultiprocessorCount, dev) != hipSuccess) { grid = -1; return; }
        if (hipFuncSetAttribute((const void*)fwd_kernel, hipFuncAttributeMaxDynamicSharedMemorySize, LDS_BYTES) != hipSuccess) { fprintf(stderr, "kernel_launch: hipFuncSetAttribute failed\n"); grid = -1; return; }
        if (hipOccupancyMaxActiveBlocksPerMultiprocessor(&per_cu, (const void*)fwd_kernel, NWAVES * 64, LDS_BYTES) != hipSuccess || per_cu < 1) { fprintf(stderr, "kernel_launch: occupancy query says %d\n", per_cu); }
        (void)hipGetLastError();
        grid = cus;
    }
    if (grid < 0) return;
    if (hipMemsetAsync((char*)d_ws + WS_CTL, 0, CTL_ZERO_BYTES, stream) != hipSuccess) return;
    Args a{};
    for (int i = 0; i < N_IN; ++i) a.in[i] = (const float*)d_in[i];
    a.out = (float*)d_out; a.ws = (unsigned char*)d_ws;
#if MK_PER_PHASE
    for (int p = 0; p < NPH; ++p) { a.ph_lo = p; a.ph_hi = p + 1; a.li = 0; hipLaunchKernelGGL(fwd_kernel, dim3(grid), dim3(NWAVES * 64), LDS_BYTES, stream, a); }
#else
    a.ph_lo = 0; a.ph_hi = NPH; a.li = 0;
    hipLaunchKernelGGL(fwd_kernel, dim3(grid), dim3(NWAVES * 64), LDS_BYTES, stream, a);
#endif
    const hipError_t le = hipPeekAtLastError();
    if (le != hipSuccess) fprintf(stderr, "kernel_launch: launch failed: %s\n", hipGetErrorName(le));
}
```

```cpp
#include <hip/hip_runtime.h>
#include <cstdio>
#include <cstdint>

#define GAS __attribute__((address_space(1)))
#define LAS __attribute__((address_space(3)))
typedef unsigned short bf16;
typedef unsigned v4u __attribute__((ext_vector_type(4)));
typedef float f32x4 __attribute__((ext_vector_type(4)));
typedef float f32x2 __attribute__((ext_vector_type(2)));
typedef float f32x16 __attribute__((ext_vector_type(16)));
typedef short bf16x8 __attribute__((ext_vector_type(8)));
typedef short s16x4 __attribute__((ext_vector_type(4)));
typedef GAS unsigned gu32;

constexpr int DM = 2048, NBATCH = 4, SEQ = 4096, CTXL = 256, TPB = SEQ + CTXL  ;
constexpr int MROWS = NBATCH * TPB  , FF = 5632, NLAYER = 4, MODW = 6 * DM  ;
constexpr float EPS = 1e-6f;
constexpr float LOG2E = 1.4426950408889634f;

__device__ __forceinline__ unsigned cvt_pk_bf16(float lo, float hi) { unsigned r; asm volatile("v_cvt_pk_bf16_f32 %0, %1, %2" : "=v"(r) : "v"(lo), "v"(hi)); return r; }
__device__ __forceinline__ float bf2f(unsigned short h) { return __builtin_bit_cast(float, (unsigned)h << 16); }

namespace pg8 {
typedef unsigned short bf16_t;
constexpr int BM = 256, BK = 64, HALF = 128, HTB = HALF * BK * 2, STAGE_BYTES = 8 * HTB, NXCD = 8, WGM = 8;
__host__ __device__ __forceinline__ int lds_byte(int r, int c) { const int st = (r >> 4) * 2 + (c >> 5), rr = r & 15, cc = c & 31, ob = rr * 64 + cc * 2; return st * 1024 + (ob ^ (((ob >> 9) & 1) << 5)); }
__host__ __device__ __forceinline__ void stage_rc(int b, int& R, int& C) { const int st = b / 1024, sb = b % 1024, swz = sb ^ (((sb >> 9) & 1) << 5); R = (st >> 1) * 16 + swz / 64; C = (st & 1) * 32 + (swz % 64) / 2; }
__host__ __device__ __forceinline__ int perm32(int rho) { const int n = rho >> 4, i = rho & 15; return 8 * (i >> 2) + 4 * n + (i & 3); }

struct Unit { int pm, pn, ks, koff, nt; };
struct Gemm { const bf16_t* A; const bf16_t* Bt; int M, N, K, lda; };

struct StaticOrder {
    int nM, nN, nwg, G, c, ntK;
    __host__ __device__ void init(int M, int N, int K, int G_, int c_) { nM = M / BM; nN = N / BM; nwg = nM * nN; G = G_; c = c_; ntK = K / BK; }
    __host__ __device__ bool next(int i, Unit& u) const {
        const long L = (long)i * G + c; if (L >= nwg) return false;
        u.ks = -1; u.koff = 0; u.nt = ntK;
        int wgid = (int)L; { const int q = nwg / NXCD, r = nwg % NXCD, xcd = wgid % NXCD, off = wgid / NXCD; wgid = (xcd < r ? xcd * (q + 1) : r * (q + 1) + (xcd - r) * q) + off; }
        const int nig = WGM * nN, gid = wgid / nig, fm = gid * WGM, gsz = (nM - fm) < WGM ? (nM - fm) : WGM;
        u.pm = fm + ((wgid % nig) % gsz); u.pn = (wgid % nig) / gsz; return true;
    }
};
struct LatentOrder : StaticOrder {
    __host__ __device__ bool next(int i, Unit& u) const { if (!StaticOrder::next(i, u)) return false; u.pm = u.pm + (u.pm >> 4) + 1; return true; }
};
struct CtxSplitOrder : LatentOrder {
    int S, ntA, ntB;
    __host__ __device__ bool next(int i, Unit& u) const {
        if (LatentOrder::next(i, u)) return true;
        const long s = (long)i * G + c - nwg; if (s < 0 || s >= (long)4 * nN * S) return false;
        const int ks = (int)(s % S), t = (int)(s / S); u.pn = t % nN; u.pm = (t / nN) * 17; u.ks = ks;
        u.koff = ((ks >> 1) * (ntA + ntB) + (ks & 1) * ntA) * BK * 2; u.nt = (ks & 1) ? ntB : ntA; return true;
    }
};

__device__ __forceinline__ void rope2(f32x4& v, const f32x4 t) {
    const float a0 = v[0] * t[0] - v[1] * t[1], a1 = v[0] * t[1] + v[1] * t[0], a2 = v[2] * t[2] - v[3] * t[3], a3 = v[2] * t[3] + v[3] * t[2];
    v = (f32x4){a0, a1, a2, a3};
}
__device__ __forceinline__ v4u pack8(const f32x4 v0, const f32x4 v1) { v4u w; w.x = cvt_pk_bf16(v0[0], v0[1]); w.y = cvt_pk_bf16(v0[2], v0[3]); w.z = cvt_pk_bf16(v1[0], v1[1]); w.w = cvt_pk_bf16(v1[2], v1[3]); return w; }
struct EpiF32 {
    static constexpr bool PERM = true;
    bf16_t* O; int ldc; float* YP;
    __device__ __forceinline__ void operator()(const f32x4 (&acc)[2][2][4][2], const Unit& u, int wr, int wc, int fr, int fq) const {
        const int col0 = u.pn * BM + wc * 32 + 8 * fq;
        if (u.ks >= 0) { const int row0 = u.ks * 1024 + (u.pm / 17) * BM + wr * 64 + fr;
#pragma unroll
            for (int ai = 0; ai < 2; ++ai)
#pragma unroll
                for (int m = 0; m < 4; ++m) { GAS float* rowp = (GAS float*)YP + (size_t)(row0 + ai * HALF + m * 16) * ldc + col0;
#pragma unroll
                    for (int bj = 0; bj < 2; ++bj)
#pragma unroll
                        for (int n = 0; n < 2; ++n) *(GAS f32x4*)(rowp + bj * HALF + n * 4) = acc[ai][bj][m][n]; }
        } else { const int row0 = u.pm * BM + wr * 64 + fr;
#pragma unroll
            for (int ai = 0; ai < 2; ++ai)
#pragma unroll
                for (int m = 0; m < 4; ++m) { GAS bf16_t* rowp = (GAS bf16_t*)O + (size_t)(row0 + ai * HALF + m * 16) * ldc + col0;
#pragma unroll
                    for (int bj = 0; bj < 2; ++bj) *(GAS v4u*)(rowp + bj * HALF) = pack8(acc[ai][bj][m][0], acc[ai][bj][m][1]); }
        }
    }
};
struct EpiQKV {
    static constexpr bool PERM = true;
    bf16_t* O; int ldc, nq, nrope; float qscale; const float* tab;
    bf16_t* KH; bf16_t* VH; int nk, gv;
    __device__ __forceinline__ void operator()(const f32x4 (&acc)[2][2][4][2], const Unit& u, int wr, int wc, int fr, int fq) const {
        const int row0 = u.pm * BM + wr * 64 + fr, col0 = u.pn * BM + wc * 32 + 8 * fq;
        const float sc = (u.pn < nq) ? qscale : 1.f;
        const int pb = u.pm % 17; const bool rope = (u.pn < nrope) && (pb != 0);
        const GAS f32x4* T = (const GAS f32x4*)tab;
        const bool hm = (KH != nullptr) && (u.pn >= nq);
#pragma unroll
        for (int ai = 0; ai < 2; ++ai)
#pragma unroll
            for (int m = 0; m < 4; ++m) { const int row = row0 + ai * HALF + m * 16;
                const int pos = (wc < 2) ? (4 * (pb - 1) + 2 * ai + wr) : (16 * m + fr);
#pragma unroll
                for (int bj = 0; bj < 2; ++bj) { f32x4 v0 = acc[ai][bj][m][0] * sc, v1 = acc[ai][bj][m][1] * sc;
                    if (rope) { const int k0 = 8 * (wc & 1) + 2 * fq; rope2(v0, T[pos * 16 + k0]); rope2(v1, T[pos * 16 + k0 + 1]); }
                    GAS bf16_t* dst;
                    if (!hm) dst = (GAS bf16_t*)O + (size_t)row * ldc + col0 + bj * HALF;
                    else { const int ci = (u.pn - nq) * 2 + bj, cc = wc * 32 + 8 * fq;
                        if (ci < nk) dst = (GAS bf16_t*)KH + ((size_t)ci * MROWS + row) * 128 + cc;
                        else { const int cv = ci - nk, hd = cv / gv, part = cv - hd * gv; dst = (GAS bf16_t*)VH + ((size_t)hd * MROWS + row) * (128 * gv) + part * 128 + cc; } }
                    *(GAS v4u*)dst = pack8(v0, v1); } }
    }
};
struct EpiSwiGLU {
    static constexpr bool PERM = true;
    bf16_t* O; int ldc;
    __device__ __forceinline__ void operator()(const f32x4 (&acc)[2][2][4][2], const Unit& u, int wr, int wc, int fr, int fq) const {
        const int row0 = u.pm * BM + wr * 64 + fr, col0 = u.pn * HALF + wc * 32 + 8 * fq;
#pragma unroll
        for (int ai = 0; ai < 2; ++ai)
#pragma unroll
            for (int m = 0; m < 4; ++m) { GAS bf16_t* rowp = (GAS bf16_t*)O + (size_t)(row0 + ai * HALF + m * 16) * ldc + col0;
                f32x4 o[2];
#pragma unroll
                for (int n = 0; n < 2; ++n) { const f32x4 g = acc[ai][0][m][n], up = acc[ai][1][m][n];
#pragma unroll
                    for (int e = 0; e < 4; ++e) { const float s = __builtin_amdgcn_rcpf(1.f + __builtin_amdgcn_exp2f(-g[e] * LOG2E)); o[n][e] = g[e] * s * up[e]; } }
                *(GAS v4u*)rowp = pack8(o[0], o[1]); }
    }
};
struct EpiMlaDown {
    static constexpr bool PERM = true;
    bf16_t* C; bf16_t* KPE; float* SSQ; const float* tab64;
    __device__ __forceinline__ void operator()(const f32x4 (&acc)[2][2][4][2], const Unit& u, int wr, int wc, int fr, int fq) const {
        const int row0 = u.pm * BM + wr * 64 + fr; const int pb = u.pm % 17;
        if (u.pn < 4) {
            const int col0 = u.pn * BM + wc * 32 + 8 * fq;
#pragma unroll
            for (int ai = 0; ai < 2; ++ai)
#pragma unroll
                for (int m = 0; m < 4; ++m) { const int row = row0 + ai * HALF + m * 16; GAS bf16_t* rowp = (GAS bf16_t*)C + (size_t)row * 1024 + col0; float ss = 0.f;
#pragma unroll
                    for (int bj = 0; bj < 2; ++bj) { const f32x4 v0 = acc[ai][bj][m][0], v1 = acc[ai][bj][m][1];
                        ss += (v0[0] * v0[0] + v0[1] * v0[1]) + (v0[2] * v0[2] + v0[3] * v0[3]) + (v1[0] * v1[0] + v1[1] * v1[1]) + (v1[2] * v1[2] + v1[3] * v1[3]);
                        *(GAS v4u*)(rowp + bj * HALF) = pack8(v0, v1); }
                    ss += __shfl_xor(ss, 16); ss += __shfl_xor(ss, 32);
                    if (fq == 0) ((GAS float*)SSQ)[(size_t)row * 16 + u.pn * 4 + wc] = ss; }
        } else if (wc < 2) {
            const GAS f32x4* T = (const GAS f32x4*)tab64;
#pragma unroll
            for (int ai = 0; ai < 2; ++ai)
#pragma unroll
                for (int m = 0; m < 4; ++m) { const int row = row0 + ai * HALF + m * 16; f32x4 v0 = acc[ai][0][m][0], v1 = acc[ai][0][m][1];
                    if (pb != 0) { const int pos = (wc == 0) ? (4 * (pb - 1) + 2 * ai + wr) : (16 * m + fr); rope2(v0, T[pos * 8 + 2 * fq]); rope2(v1, T[pos * 8 + 2 * fq + 1]); }
                    *(GAS v4u*)((GAS bf16_t*)KPE + (size_t)row * 64 + wc * 32 + 8 * fq) = pack8(v0, v1); }
        }
    }
};
template <bool ROPE> struct EpiMlaUp {
    static constexpr bool PERM = true;
    bf16_t* O; int ldc; const float* SSQ; int which; float scale; const float* tab64;
    __device__ __forceinline__ void operator()(const f32x4 (&acc)[2][2][4][2], const Unit& u, int wr, int wc, int fr, int fq) const {
        const int row0 = u.pm * BM + wr * 64 + fr, col0 = u.pn * BM + wc * 32 + 8 * fq; const int pb = u.pm % 17;
        const GAS f32x4* T = (const GAS f32x4*)tab64;
#pragma unroll
        for (int ai = 0; ai < 2; ++ai)
#pragma unroll
            for (int m = 0; m < 4; ++m) { const int row = row0 + ai * HALF + m * 16; GAS bf16_t* rowp = (GAS bf16_t*)O + (size_t)row * ldc + col0;
                const GAS f32x4* sp = (const GAS f32x4*)((const GAS float*)SSQ + (size_t)row * 16 + which * 8); const f32x4 s0 = sp[0], s1 = sp[1];
                const float ss = ((s0[0] + s0[1]) + (s0[2] + s0[3])) + ((s1[0] + s1[1]) + (s1[2] + s1[3]));
                const float rs = __builtin_amdgcn_rsqf(ss * (1.f / 512.f) + EPS) * scale;
#pragma unroll
                for (int bj = 0; bj < 2; ++bj) { f32x4 v0 = acc[ai][bj][m][0] * rs, v1 = acc[ai][bj][m][1] * rs;
                    if (ROPE) { const int g = (u.pn * BM + bj * HALF + wc * 32) % 192;
                        if (g >= 128 && pb != 0) { const int pos = (g == 128) ? (4 * (pb - 1) + 2 * ai + wr) : (16 * m + fr); rope2(v0, T[pos * 8 + 2 * fq]); rope2(v1, T[pos * 8 + 2 * fq + 1]); } }
                    *(GAS v4u*)(rowp + bj * HALF) = pack8(v0, v1); } }
    }
};

template <class Epi, class Sched>
__device__ __forceinline__ void gemm_phase(LAS unsigned char* lds, const Gemm g, const Sched& S, const Epi& E, unsigned char* g_probe = nullptr) {
    const int tid = threadIdx.x, wid = __builtin_amdgcn_readfirstlane(tid >> 6), lane = tid & 63, wr = wid >> 2, wc = wid & 3, fr = lane & 15, fq = lane >> 4;
    const int K = g.K, lda = g.lda;
    unsigned voffA[2], voffB[2];
#pragma unroll
    for (int i = 0; i < 2; ++i) { int R, C; stage_rc(tid * 16 + i * 8192, R, C); const int Rb = Epi::PERM ? ((R & ~31) + perm32(R & 31)) : R;
        voffA[i] = (unsigned)(R * lda + C) * 2u; voffB[i] = (unsigned)(Rb * K + C) * 2u; }
    const size_t kstep = (size_t)(BK * 2);
    const size_t hsA = (size_t)HALF * lda * 2, hsB = (size_t)HALF * K * 2;
    const size_t tsA = 2 * hsA, tsB = 2 * hsB;
    const unsigned ldsw = (unsigned)wid * 1024u;
    const int aoff = lds_byte(wr * 64 + fr, fq * 8), boff = lds_byte(wc * 32 + fr, fq * 8);
#define PG8_SA(b, h) (((b) * 2 + (h)) * HTB)
#define PG8_SB(b, h) ((4 + (b) * 2 + (h)) * HTB)
#define PG8_STAGE(bufoff, gbase, voff) do { _Pragma("unroll") for (int _i = 0; _i < 2; ++_i) \
        __builtin_amdgcn_global_load_lds((const unsigned*)((const char*)(gbase) + (voff)[_i]), (LAS unsigned*)(lds + (bufoff) + ldsw + _i * 8192), 16, 0, 0); } while (0)
#define PG8_LDA(dst, b, h) do { _Pragma("unroll") for (int m = 0; m < 4; ++m) _Pragma("unroll") for (int k = 0; k < 2; ++k) dst[m][k] = *(const LAS bf16x8*)(lds + PG8_SA(b, h) + aoff + m * 2048 + k * 1024); } while (0)
#define PG8_LDB(dst, b, h) do { _Pragma("unroll") for (int n = 0; n < 2; ++n) _Pragma("unroll") for (int k = 0; k < 2; ++k) dst[n][k] = *(const LAS bf16x8*)(lds + PG8_SB(b, h) + boff + n * 2048 + k * 1024); } while (0)
#define PG8_MMA(ai, bj, At, Bt) do { __builtin_amdgcn_s_setprio(1); _Pragma("unroll") for (int m = 0; m < 4; ++m) _Pragma("unroll") for (int n = 0; n < 2; ++n) _Pragma("unroll") for (int k = 0; k < 2; ++k) \
        acc[ai][bj][m][n] = __builtin_amdgcn_mfma_f32_16x16x32_bf16(Bt[n][k], At[m][k], acc[ai][bj][m][n], 0, 0, 0); __builtin_amdgcn_s_setprio(0); } while (0)
#define PG8_WAIT_V(n) asm volatile("s_waitcnt vmcnt(" #n ")" ::: "memory")
#define PG8_WAIT_L(n) asm volatile("s_waitcnt lgkmcnt(" #n ")" ::: "memory")
#define PG8_BAR __builtin_amdgcn_s_barrier()
#define PG8_SCHED __builtin_amdgcn_sched_barrier(0)
    Unit cur, nxt; int ui = 0;
    if (!S.next(0, cur)) return;
    f32x4 acc[2][2][4][2];
#pragma unroll
    for (int a = 0; a < 2; ++a)
#pragma unroll
        for (int b = 0; b < 2; ++b)
#pragma unroll
            for (int m = 0; m < 4; ++m)
#pragma unroll
                for (int n = 0; n < 2; ++n) acc[a][b][m][n] = (f32x4){0.f, 0.f, 0.f, 0.f};
    bf16x8 At[4][2], B0[2][2], B1[2][2];
    const char* cA = (const char*)g.A + (size_t)cur.pm * tsA + cur.koff; const char* cB = (const char*)g.Bt + (size_t)cur.pn * tsB + cur.koff;
    PG8_STAGE(PG8_SB(0, 0), cB, voffB); PG8_STAGE(PG8_SB(0, 1), cB + hsB, voffB); PG8_STAGE(PG8_SA(0, 0), cA, voffA); PG8_STAGE(PG8_SA(0, 1), cA + hsA, voffA);
    if (wr == 1) PG8_BAR;
    PG8_WAIT_V(2); PG8_BAR;
    PG8_STAGE(PG8_SB(1, 0), cB + kstep, voffB); PG8_STAGE(PG8_SA(1, 0), cA + kstep, voffA); PG8_STAGE(PG8_SB(1, 1), cB + hsB + kstep, voffB);
    PG8_WAIT_V(6); PG8_BAR;
    for (;;) {
        const bool has_next = S.next(ui + 1, nxt);
        const char* nA = has_next ? (const char*)g.A + (size_t)nxt.pm * tsA + nxt.koff : cA; const char* nB = has_next ? (const char*)g.Bt + (size_t)nxt.pn * tsB + nxt.koff : cB;
        const int nt = cur.nt;
        for (int t = 0; t < nt; t += 2) {
            const bool last = (t == nt - 2);
            const char* a1 = cA + (size_t)(t + 1) * kstep;
            const char* a2 = last ? nA : cA + (size_t)(t + 2) * kstep; const char* b2 = last ? nB : cB + (size_t)(t + 2) * kstep;
            const char* a3 = a2 + kstep; const char* b3 = b2 + kstep;
            PG8_LDB(B0, 0, 0); PG8_LDB(B1, 0, 1); PG8_SCHED; PG8_LDA(At, 0, 0); PG8_STAGE(PG8_SA(1, 1), a1 + hsA, voffA);
            PG8_WAIT_V(8); PG8_WAIT_L(0); PG8_BAR; PG8_MMA(0, 0, At, B0); PG8_MMA(0, 1, At, B1); PG8_BAR; PG8_SCHED;
            PG8_LDA(At, 0, 1); PG8_STAGE(PG8_SB(0, 0), b2, voffB); PG8_STAGE(PG8_SB(0, 1), b2 + hsB, voffB); PG8_STAGE(PG8_SA(0, 0), a2, voffA);
            PG8_WAIT_V(8); PG8_WAIT_L(0); PG8_BAR; PG8_MMA(1, 0, At, B0); PG8_MMA(1, 1, At, B1); PG8_BAR; PG8_SCHED;
            PG8_LDB(B0, 1, 0); PG8_LDB(B1, 1, 1); PG8_SCHED; PG8_LDA(At, 1, 0); PG8_STAGE(PG8_SA(0, 1), a2 + hsA, voffA);
            PG8_WAIT_V(8); PG8_WAIT_L(0); PG8_BAR; PG8_MMA(0, 0, At, B0); PG8_MMA(0, 1, At, B1); PG8_BAR; PG8_SCHED;
            PG8_LDA(At, 1, 1); PG8_STAGE(PG8_SB(1, 0), b3, voffB); PG8_STAGE(PG8_SB(1, 1), b3 + hsB, voffB); PG8_STAGE(PG8_SA(1, 0), a3, voffA);
            PG8_WAIT_V(8); PG8_WAIT_L(0); PG8_BAR; PG8_MMA(1, 0, At, B0); PG8_MMA(1, 1, At, B1); PG8_BAR; PG8_SCHED;
        }
#ifdef PROBE_EPI
        unsigned long long te0_ = __builtin_amdgcn_s_memrealtime();
#endif
        if (wr == 0) PG8_BAR;
        E(acc, cur, wr, wc, fr, fq);
#ifdef PROBE_EPI
        if (PROBE_EPI == 1) asm volatile("s_waitcnt vmcnt(0)" ::: "memory");
        if (blockIdx.x == 0 && tid == 0 && g_probe) { GAS unsigned long long* tw = (GAS unsigned long long*)g_probe; tw[5] += __builtin_amdgcn_s_memrealtime() - te0_; }
#endif
        if (!has_next) break;
#pragma unroll
        for (int a = 0; a < 2; ++a)
#pragma unroll
            for (int b = 0; b < 2; ++b)
#pragma unroll
                for (int m = 0; m < 4; ++m)
#pragma unroll
                    for (int n = 0; n < 2; ++n) acc[a][b][m][n] = (f32x4){0.f, 0.f, 0.f, 0.f};
        cur = nxt; cA = nA; cB = nB; ++ui;
        if (wr == 1) PG8_BAR;
    }
    PG8_WAIT_V(0);
    PG8_BAR;
#undef PG8_SA
#undef PG8_SB
#undef PG8_STAGE
#undef PG8_LDA
#undef PG8_LDB
#undef PG8_MMA
#undef PG8_WAIT_V
#undef PG8_WAIT_L
#undef PG8_BAR
#undef PG8_SCHED
}
}
namespace attn {
constexpr int NW = 8, QBLK = 32, KVBLK = 64;
constexpr int SHM_V = KVBLK * 128 * 2, SHM_K = KVBLK * 128 * 2, SHM_K2 = KVBLK * 64 * 2;
constexpr int L_V = 0, L_K = 2 * SHM_V, L_K2 = L_K + 2 * SHM_K, L_WS = L_K2 + 2 * SHM_K2, L_RPB = L_WS + NW * 64 * 4, L_Q2 = L_RPB + 2048, L_END = L_Q2 + NW * 4096;
constexpr float THR = 8.f;
#define KSWF(row) ((((row) & 7) | ((((row) >> 4) & 1) << 3)))
#define KSWZ(row, colB) ((row) * 256 + ((colB) ^ (KSWF(row) << 4)))
#define K2SWF(row) (((((row) >> 1) & 3) | ((((row) >> 4) & 1) << 2)))
#define K2SWZ(row, colB) ((row) * 128 + ((colB) ^ (K2SWF(row) << 4)))
#define SBAR() __builtin_amdgcn_sched_barrier(0)
__device__ __forceinline__ int crow(int r, int hi) { return (r & 3) + 8 * (r >> 2) + 4 * hi; }

struct Desc {
    const bf16* Q; const bf16* K; const bf16* V; const bf16* K2; bf16* O;
    int ldq, ldk, ldv, ldo;
    int row_ctx, row_lat;
    int NT, NTreal;
    float m0, l0;
    int a0, a1;
    const float* rpb;
    unsigned char* probe;
    const bf16* O1; float lam;
    int rot;
};

__device__ __forceinline__ void partialSM(f32x16& p0, f32x16& p1, float& m_reg, float& mn, float& alpha) {
  constexpr float C = LOG2E;
  float pmax = p0[0];
#pragma unroll
  for (int r = 1; r < 16; ++r) pmax = fmaxf(pmax, p0[r]);
#pragma unroll
  for (int r = 0; r < 16; ++r) pmax = fmaxf(pmax, p1[r]);
  { auto rr = __builtin_amdgcn_permlane32_swap(__float_as_uint(pmax), __float_as_uint(pmax), false, false);
    pmax = fmaxf(__uint_as_float(rr[0]), __uint_as_float(rr[1])); }
  if (__builtin_expect(__all(pmax - m_reg <= THR), 1)) { mn = m_reg; alpha = 1.f; }
  else { mn = fmaxf(m_reg, pmax); alpha = __builtin_amdgcn_exp2f((m_reg - mn) * C); m_reg = mn; }
  float mnC = -mn * C;
#pragma unroll
  for (int r = 0; r < 16; ++r) p0[r] = fmaf(p0[r], C, mnC);
#pragma unroll
  for (int r = 0; r < 16; ++r) p1[r] = fmaf(p1[r], C, mnC);
#pragma unroll
  for (int r = 0; r < 16; ++r) p0[r] = __builtin_amdgcn_exp2f(p0[r]);
}
__device__ __forceinline__ void finishSM(f32x16& p0, f32x16& p1, float alpha, float& l_reg, bf16x8& pa0, bf16x8& pa1, bf16x8& pa2, bf16x8& pa3) {
#pragma unroll
  for (int r = 0; r < 16; ++r) p1[r] = __builtin_amdgcn_exp2f(p1[r]);
  float ps = 0;
#pragma unroll
  for (int r = 0; r < 16; ++r) ps += p0[r];
#pragma unroll
  for (int r = 0; r < 16; ++r) ps += p1[r];
  { auto rr = __builtin_amdgcn_permlane32_swap(__float_as_uint(ps), __float_as_uint(ps), false, false);
    ps = __uint_as_float(rr[0]) + __uint_as_float(rr[1]); }
  l_reg = l_reg * alpha + ps;
#define PK4(P, BASE, OUT) do { unsigned a0 = cvt_pk_bf16(P[BASE + 0], P[BASE + 1]), a1 = cvt_pk_bf16(P[BASE + 2], P[BASE + 3]);   \
    unsigned b0 = cvt_pk_bf16(P[BASE + 4], P[BASE + 5]), b1 = cvt_pk_bf16(P[BASE + 6], P[BASE + 7]);                              \
    auto r0 = __builtin_amdgcn_permlane32_swap(a0, b0, false, false); auto r1 = __builtin_amdgcn_permlane32_swap(a1, b1, false, false); \
    v4u w = {r0[0], r1[0], r0[1], r1[1]}; OUT = __builtin_bit_cast(bf16x8, w); } while (0)
  PK4(p0, 0, pa0); PK4(p0, 8, pa1); PK4(p1, 0, pa2); PK4(p1, 8, pa3);
#undef PK4
}
template <bool K2, int NQR>
__device__ __forceinline__ void qkt(f32x16& p0, f32x16& p1, const LAS char* Ks, const LAS char* K2s, const bf16x8* qr, const LAS char* q2l, int r32, int hi) {
  p0 = f32x16{}; p1 = f32x16{};
#pragma unroll
  for (int d0 = 0; d0 < 8; ++d0) { int cb = (d0 * 16 + hi * 8) * 2;
    bf16x8 b0 = *(const LAS bf16x8*)(Ks + KSWZ(r32, cb));
    bf16x8 b1 = *(const LAS bf16x8*)(Ks + KSWZ(32 + r32, cb));
    bf16x8 q; if constexpr (true) { if (d0 < NQR) q = qr[d0 < NQR ? d0 : 0]; else q = *(const LAS bf16x8*)(q2l + (d0 - NQR) * 1024); }
    p0 = __builtin_amdgcn_mfma_f32_32x32x16_bf16(b0, q, p0, 0, 0, 0);
    p1 = __builtin_amdgcn_mfma_f32_32x32x16_bf16(b1, q, p1, 0, 0, 0); }
  if constexpr (K2) {
#pragma unroll
    for (int d0 = 0; d0 < 4; ++d0) { int cb = (d0 * 16 + hi * 8) * 2;
      bf16x8 b0 = *(const LAS bf16x8*)(K2s + K2SWZ(r32, cb));
      bf16x8 b1 = *(const LAS bf16x8*)(K2s + K2SWZ(32 + r32, cb));
      const bf16x8 q2 = *(const LAS bf16x8*)(q2l + (8 - NQR + d0) * 1024);
      p0 = __builtin_amdgcn_mfma_f32_32x32x16_bf16(b0, q2, p0, 0, 0, 0);
      p1 = __builtin_amdgcn_mfma_f32_32x32x16_bf16(b1, q2, p1, 0, 0, 0); }
  }
}
__device__ __forceinline__ int v_st(int k, int c) { const int kk = (k & ~0xC) | ((k & 4) << 1) | ((k & 8) >> 1); return ((kk >> 3) * 4 + (c >> 5)) * 512 + ((kk & 7) * 32 + (c & 31)) * 2; }
__device__ __forceinline__ int v_rd_base(int lane) { return ((lane & 3) << 3) | (((lane >> 2) & 3) << 6) | (((lane >> 4) & 1) << 5) | (((lane >> 5) & 1) << 8); }
constexpr int v_rd_off(int d0, int ks, int half) { return d0 * 512 + ks * 4096 + half * 2048; }
template <int OFF> __device__ __forceinline__ s16x4 tr_read(int vb) {
  s16x4 r; asm volatile("ds_read_b64_tr_b16 %0, %1 offset:%2" : "=&v"(r) : "v"(vb), "i"(OFF) : "memory"); return r;
}
template <int D0> __device__ __forceinline__ void pv_one(f32x16& od, int vb, bf16x8 pa0, bf16x8 pa1, bf16x8 pa2, bf16x8 pa3) {
  const s16x4 l0 = tr_read<v_rd_off(D0, 0, 0)>(vb), h0 = tr_read<v_rd_off(D0, 0, 1)>(vb), l1 = tr_read<v_rd_off(D0, 1, 0)>(vb), h1 = tr_read<v_rd_off(D0, 1, 1)>(vb);
  const s16x4 l2 = tr_read<v_rd_off(D0, 2, 0)>(vb), h2 = tr_read<v_rd_off(D0, 2, 1)>(vb), l3 = tr_read<v_rd_off(D0, 3, 0)>(vb), h3 = tr_read<v_rd_off(D0, 3, 1)>(vb);
  asm volatile("s_waitcnt lgkmcnt(0)" ::: "memory"); SBAR();
#define PK(L, H) (bf16x8){L[0], L[1], L[2], L[3], H[0], H[1], H[2], H[3]}
  od = __builtin_amdgcn_mfma_f32_32x32x16_bf16(pa0, PK(l0, h0), od, 0, 0, 0);
  od = __builtin_amdgcn_mfma_f32_32x32x16_bf16(pa1, PK(l1, h1), od, 0, 0, 0);
  od = __builtin_amdgcn_mfma_f32_32x32x16_bf16(pa2, PK(l2, h2), od, 0, 0, 0);
  od = __builtin_amdgcn_mfma_f32_32x32x16_bf16(pa3, PK(l3, h3), od, 0, 0, 0);
#undef PK
}
__device__ __forceinline__ void pv_d0(f32x16* o, int vb, bf16x8 pa0, bf16x8 pa1, bf16x8 pa2, bf16x8 pa3) {
  pv_one<0>(o[0], vb, pa0, pa1, pa2, pa3); pv_one<1>(o[1], vb, pa0, pa1, pa2, pa3); pv_one<2>(o[2], vb, pa0, pa1, pa2, pa3); pv_one<3>(o[3], vb, pa0, pa1, pa2, pa3);
}
__device__ __forceinline__ void qkt_pf(f32x16& p0, f32x16& p1, const LAS char* Ks, const bf16x8* qr, int r32, int hi) {
  bf16x8 kf[16];
#pragma unroll
  for (int d0 = 0; d0 < 8; ++d0) { const int cb = (d0 * 16 + hi * 8) * 2; kf[2 * d0] = *(const LAS bf16x8*)(Ks + KSWZ(r32, cb)); kf[2 * d0 + 1] = *(const LAS bf16x8*)(Ks + KSWZ(32 + r32, cb)); }
  SBAR();
  p0 = f32x16{}; p1 = f32x16{};
#pragma unroll
  for (int d0 = 0; d0 < 8; ++d0) { p0 = __builtin_amdgcn_mfma_f32_32x32x16_bf16(kf[2 * d0], qr[d0], p0, 0, 0, 0); p1 = __builtin_amdgcn_mfma_f32_32x32x16_bf16(kf[2 * d0 + 1], qr[d0], p1, 0, 0, 0); }
}
template <int D0> __device__ __forceinline__ void vfrag(s16x4 (&f)[8], int vb) {
  f[0] = tr_read<v_rd_off(D0, 0, 0)>(vb); f[1] = tr_read<v_rd_off(D0, 0, 1)>(vb); f[2] = tr_read<v_rd_off(D0, 1, 0)>(vb); f[3] = tr_read<v_rd_off(D0, 1, 1)>(vb);
  f[4] = tr_read<v_rd_off(D0, 2, 0)>(vb); f[5] = tr_read<v_rd_off(D0, 2, 1)>(vb); f[6] = tr_read<v_rd_off(D0, 3, 0)>(vb); f[7] = tr_read<v_rd_off(D0, 3, 1)>(vb);
}
__device__ __forceinline__ void pv4(f32x16& od, const s16x4 (&f)[8], bf16x8 pa0, bf16x8 pa1, bf16x8 pa2, bf16x8 pa3) {
#define PK(L, H) (bf16x8){L[0], L[1], L[2], L[3], H[0], H[1], H[2], H[3]}
  od = __builtin_amdgcn_mfma_f32_32x32x16_bf16(pa0, PK(f[0], f[1]), od, 0, 0, 0);
  od = __builtin_amdgcn_mfma_f32_32x32x16_bf16(pa1, PK(f[2], f[3]), od, 0, 0, 0);
  od = __builtin_amdgcn_mfma_f32_32x32x16_bf16(pa2, PK(f[4], f[5]), od, 0, 0, 0);
  od = __builtin_amdgcn_mfma_f32_32x32x16_bf16(pa3, PK(f[6], f[7]), od, 0, 0, 0);
#undef PK
}
__device__ __forceinline__ void pv_pipe(f32x16* o, int vb, bf16x8 pa0, bf16x8 pa1, bf16x8 pa2, bf16x8 pa3) {
  s16x4 fa[8], fb[8];
  vfrag<0>(fa, vb); SBAR();
  vfrag<1>(fb, vb); asm volatile("s_waitcnt lgkmcnt(8)" ::: "memory"); SBAR(); pv4(o[0], fa, pa0, pa1, pa2, pa3); SBAR();
  vfrag<2>(fa, vb); asm volatile("s_waitcnt lgkmcnt(8)" ::: "memory"); SBAR(); pv4(o[1], fb, pa0, pa1, pa2, pa3); SBAR();
  vfrag<3>(fb, vb); asm volatile("s_waitcnt lgkmcnt(8)" ::: "memory"); SBAR(); pv4(o[2], fa, pa0, pa1, pa2, pa3); SBAR();
  asm volatile("s_waitcnt lgkmcnt(0)" ::: "memory"); SBAR(); pv4(o[3], fb, pa0, pa1, pa2, pa3);
}
#define PV_PIPE_HOOKS(o_, vb_, pa0, pa1, pa2, pa3, H0, H1, H2, H3) do { s16x4 fa_[8], fb_[8]; \
  vfrag<0>(fa_, vb_); SBAR(); \
  vfrag<1>(fb_, vb_); asm volatile("s_waitcnt lgkmcnt(8)" ::: "memory"); SBAR(); pv4((o_)[0], fa_, pa0, pa1, pa2, pa3); H0; SBAR(); \
  vfrag<2>(fa_, vb_); asm volatile("s_waitcnt lgkmcnt(8)" ::: "memory"); SBAR(); pv4((o_)[1], fb_, pa0, pa1, pa2, pa3); H1; SBAR(); \
  vfrag<3>(fb_, vb_); asm volatile("s_waitcnt lgkmcnt(8)" ::: "memory"); SBAR(); pv4((o_)[2], fa_, pa0, pa1, pa2, pa3); H2; SBAR(); \
  asm volatile("s_waitcnt lgkmcnt(0)" ::: "memory"); SBAR(); pv4((o_)[3], fb_, pa0, pa1, pa2, pa3); H3; SBAR(); } while (0)
template <int MODE>
__device__ __forceinline__ void mask_tile(f32x16& p0, f32x16& p1, const Desc& d, int j, int wid, int r32, int hi, const LAS float* rpbL) {
  if constexpr (MODE == 1) {
    if (j >= 4) { const int base = d.a0 + 64 * (j - 4) - (wid * 32 + r32);
#pragma unroll
      for (int r = 0; r < 16; ++r) { const int dd = base + crow(r, hi); if (dd > 128 || dd < -128) p0[r] = -1e30f; if (dd + 32 > 128 || dd + 32 < -128) p1[r] = -1e30f; } }
  } else if constexpr (MODE == 2) {
    if (j >= 4) {
      const int kr = d.a0 + (j - 4), qr_ = d.a1 + (wid >> 1), c = 32 * (wid & 1) + r32;
      int r0 = qr_ - 4; r0 = r0 < 0 ? 0 : (r0 > 56 ? 56 : r0); int c0 = c - 8; c0 = c0 < 0 ? 0 : (c0 > 48 ? 48 : c0);
      asm volatile("" : "+v"(c0));
      const bool rv = (j < d.NTreal) && (kr >= r0) && (kr < r0 + 8);
      if (!rv) {
#pragma unroll
        for (int r = 0; r < 16; ++r) { p0[r] = -1e30f; p1[r] = -1e30f; }
      } else { const LAS float* brow = rpbL + (kr - qr_ + 7) * 31 + (15 - c);
#pragma unroll
        for (int rc = 0; rc < 16; rc += 4) {
#pragma unroll
          for (int r = rc; r < rc + 4; ++r) { const int k0 = crow(r, hi), k1 = k0 + 32; const bool ok0 = (unsigned)(k0 - c0) < 16u, ok1 = (unsigned)(k1 - c0) < 16u;
            const float b0 = brow[ok0 ? k0 : c], b1 = brow[ok1 ? k1 : c];
            p0[r] = ok0 ? p0[r] + b0 : -1e30f; p1[r] = ok1 ? p1[r] + b1 : -1e30f; }
          SBAR(); } }
    }
  }
}

template <int MODE, bool K2, int SDEPTH, int NQR>
__device__ __forceinline__ void unit(const Desc& d, LAS char* lds) {
  static_assert((K2 ? 12 : 8) - NQR <= 4, "at most four Q fragments live in LDS");
  const int tid = threadIdx.x, wid = __builtin_amdgcn_readfirstlane(tid >> 6), lane = tid & 63, r32 = lane & 31, hi = lane >> 5;
  LAS char* V_lds = lds + L_V; LAS char* K_lds = lds + L_K; LAS char* K2_lds = lds + L_K2;
  LAS float* ws = (LAS float*)(lds + L_WS) + wid * 64; LAS float* li_l = ws; LAS float* al_l = ws + 32;
  LAS float* rpbL = (LAS float*)(lds + L_RPB);
  if constexpr (MODE == 2) { if (tid < 465) rpbL[tid] = ((const GAS float*)d.rpb)[tid]; }
  float m_reg = d.m0, l_reg = d.l0; f32x16 o[4] = {}; bf16x8 qr[NQR];
  LAS char* q2l = lds + L_Q2 + wid * 4096 + lane * 16;
  { const GAS bf16* Qw = (const GAS bf16*)d.Q + (long)(wid * QBLK + r32) * d.ldq + hi * 8;
#pragma unroll
    for (int d0 = 0; d0 < NQR; ++d0) qr[d0] = *(const GAS bf16x8*)(Qw + d0 * 16);
#pragma unroll
    for (int d0 = NQR; d0 < (K2 ? 12 : 8); ++d0) *(LAS bf16x8*)(q2l + (d0 - NQR) * 1024) = *(const GAS bf16x8*)(Qw + d0 * 16); }
  const int sr = tid >> 4, sc = (tid & 15) * 8, vst0 = v_st(sr, sc), vst1 = v_st(32 + sr, sc);
  const int vb0 = (int)(unsigned)(uintptr_t)V_lds + v_rd_base(lane);
  const GAS bf16* Kp = (const GAS bf16*)d.K + (long)sr * d.ldk + sc; const GAS bf16* Vp = (const GAS bf16*)d.V + (long)sr * d.ldv + sc;
  const GAS bf16* K2p = K2 ? (const GAS bf16*)d.K2 + (long)(tid >> 3) * 64 + (tid & 7) * 8 : nullptr;
  const int k2st = K2SWZ(tid >> 3, (tid & 7) * 16);
  struct { bf16x8 vs0, vs1, ks0, ks1, k2; } sr_[SDEPTH];
  const int NT = d.NT, NTr = d.NTreal;
#define TROW(j) ((j) < 4 ? d.row_ctx + 64 * (j) : d.row_lat + 64 * (((j) < NTr ? (j) : NTr - 1) - 4))
#define SLOAD(i, j) do { const long kr_ = TROW(j); sr_[i].vs0 = *(const GAS bf16x8*)(Vp + kr_ * d.ldv); sr_[i].vs1 = *(const GAS bf16x8*)(Vp + (kr_ + 32) * d.ldv); \
    sr_[i].ks0 = *(const GAS bf16x8*)(Kp + kr_ * d.ldk); sr_[i].ks1 = *(const GAS bf16x8*)(Kp + (kr_ + 32) * d.ldk); \
    if constexpr (K2) sr_[i].k2 = *(const GAS bf16x8*)(K2p + kr_ * 64); } while (0)
#define SWRITE(b, i) do { *(LAS bf16x8*)(V_lds + (b) * SHM_V + vst0) = sr_[i].vs0; *(LAS bf16x8*)(V_lds + (b) * SHM_V + vst1) = sr_[i].vs1; const int kc = sc * 2; \
    *(LAS bf16x8*)(K_lds + (b) * SHM_K + KSWZ(sr, kc)) = sr_[i].ks0; *(LAS bf16x8*)(K_lds + (b) * SHM_K + KSWZ(32 + sr, kc)) = sr_[i].ks1; \
    if constexpr (K2) *(LAS bf16x8*)(K2_lds + (b) * SHM_K2 + k2st) = sr_[i].k2; } while (0)
#define SWAIT() do { if constexpr (SDEPTH == 2) asm volatile("s_waitcnt vmcnt(4)" ::: "memory"); else asm volatile("s_waitcnt vmcnt(0)" ::: "memory"); } while (0)
#define RESC(a) do { if (__any((a) < 1.f)) { if (hi == 0) al_l[r32] = (a); asm volatile("s_waitcnt lgkmcnt(0)" ::: "memory"); \
    _Pragma("unroll") for (int dd = 0; dd < 4; ++dd) _Pragma("unroll") for (int r = 0; r < 16; ++r) o[dd][r] *= al_l[crow(r, hi)]; } } while (0)
  f32x16 pA0, pA1, pB0, pB1; float mnA, mnB, alA, alB; bf16x8 pa0, pa1, pa2, pa3;
  constexpr int SE = 0, SO = SDEPTH - 1;
  SLOAD(SE, 0); asm volatile("s_waitcnt vmcnt(0)" ::: "memory"); SWRITE(0, SE); __syncthreads();
  qkt<K2, NQR>(pA0, pA1, K_lds, K2_lds, qr, q2l, r32, hi); partialSM(pA0, pA1, m_reg, mnA, alA);
  SLOAD(SO, 1); if constexpr (SDEPTH == 2) { if (2 < NT) SLOAD(SE, 2); }
  SWAIT(); SWRITE(1, SO); __syncthreads();
  for (int j = 1; j + 1 < NT; j += 2) {
    SBAR(); qkt<K2, NQR>(pB0, pB1, K_lds + SHM_K, K2_lds + SHM_K2, qr, q2l, r32, hi);
    finishSM(pA0, pA1, alA, l_reg, pa0, pa1, pa2, pa3); SBAR();
    SLOAD(SO, j + SDEPTH); SBAR();
    pv_d0(o, vb0, pa0, pa1, pa2, pa3); if constexpr (MODE != 0) { SBAR(); mask_tile<MODE>(pB0, pB1, d, j, wid, r32, hi, rpbL); SBAR(); } partialSM(pB0, pB1, m_reg, mnB, alB);
    __syncthreads(); SWAIT(); SWRITE(0, SE);
    RESC(alB); __syncthreads();
    SBAR(); qkt<K2, NQR>(pA0, pA1, K_lds, K2_lds, qr, q2l, r32, hi);
    finishSM(pB0, pB1, alB, l_reg, pa0, pa1, pa2, pa3); SBAR();
    if (SDEPTH == 1 || j + 3 < NT) SLOAD(SE, j + 1 + SDEPTH); SBAR();
    pv_d0(o, vb0 + SHM_V, pa0, pa1, pa2, pa3); if constexpr (MODE != 0) { SBAR(); mask_tile<MODE>(pA0, pA1, d, j + 1, wid, r32, hi, rpbL); SBAR(); } partialSM(pA0, pA1, m_reg, mnA, alA);
    __syncthreads(); SWAIT(); SWRITE(1, SO);
    RESC(alA); __syncthreads();
  }
  SBAR(); qkt<K2, NQR>(pB0, pB1, K_lds + SHM_K, K2_lds + SHM_K2, qr, q2l, r32, hi);
  finishSM(pA0, pA1, alA, l_reg, pa0, pa1, pa2, pa3); SBAR();
  pv_d0(o, vb0, pa0, pa1, pa2, pa3); if constexpr (MODE != 0) { SBAR(); mask_tile<MODE>(pB0, pB1, d, NT - 1, wid, r32, hi, rpbL); SBAR(); } partialSM(pB0, pB1, m_reg, mnB, alB);
  __syncthreads(); RESC(alB);
  finishSM(pB0, pB1, alB, l_reg, pa0, pa1, pa2, pa3); SBAR();
  pv_d0(o, vb0 + SHM_V, pa0, pa1, pa2, pa3);
  if (hi == 0) li_l[r32] = l_reg; asm volatile("s_waitcnt lgkmcnt(0)" ::: "memory");
  float rli[16];
#pragma unroll
  for (int r = 0; r < 16; ++r) rli[r] = __builtin_amdgcn_rcpf(li_l[crow(r, hi)]);
#pragma unroll
  for (int d0 = 0; d0 < 4; ++d0)
#pragma unroll
    for (int r = 0; r < 16; ++r) o[d0][r] *= rli[r];
  SBAR();
  GAS bf16* Ow = (GAS bf16*)d.O + (long)(wid * QBLK) * d.ldo;
  { int lo_ = lane; asm volatile("" : "+v"(lo_));
    LAS bf16* stg = (LAS bf16*)(K_lds + wid * 4096);
#pragma unroll
    for (int g = 0; g < 2; ++g) { SBAR();
#pragma unroll
      for (int r = 0; r < 16; ++r) { const int orow = crow(r, hi); const float x0 = o[2 * g][r], x1 = o[2 * g + 1][r];
        stg[orow * 64 + r32] = (bf16)(cvt_pk_bf16(x0, x0) & 0xffffu); stg[orow * 64 + 32 + r32] = (bf16)(cvt_pk_bf16(x1, x1) & 0xffffu); }
      asm volatile("s_waitcnt lgkmcnt(0)" ::: "memory");
#pragma unroll
      for (int q = 0; q < 4; ++q) { const int idx = q * 64 + lo_, row = idx >> 3, ch = idx & 7; const v4u v = *(const LAS v4u*)(stg + row * 64 + ch * 8);
        *(GAS v4u*)(Ow + (long)row * d.ldo + g * 64 + ch * 8) = v; }
      asm volatile("s_waitcnt lgkmcnt(0)" ::: "memory"); } }
  __syncthreads();
#undef TROW
#undef SLOAD
#undef SWRITE
#undef SWAIT
#undef RESC
}
constexpr int X_V = 0, X_K = 4 * SHM_V, X_P = X_K + 3 * SHM_K, X_WS = X_P + 4 * 4096, X_END = X_WS + NW * 64 * 4;
template <bool COMB>
__device__ __forceinline__ void unit_split(const Desc& d, LAS char* lds) {
  const int tid = threadIdx.x, wid = __builtin_amdgcn_readfirstlane(tid >> 6), lane = tid & 63, r32 = lane & 31, hi = lane >> 5;
  const bool isS = wid < 4; const int w4 = wid & 3;
  LAS char* V_lds = lds + X_V; LAS char* K_lds = lds + X_K; LAS char* P_l = lds + X_P + w4 * 4096 + lane * 16;
  LAS float* wsS = (LAS float*)(lds + X_WS) + w4 * 64; LAS float* al_l = wsS; LAS float* li_l = wsS + 32;
  volatile LAS unsigned* flag = (volatile LAS unsigned*)((LAS float*)(lds + X_WS) + (w4 + 4) * 64);
  const int NT = d.NT;
#define KOFF(i, L) ((4 * (w4 + 4 * (i)) + ((L) >> 4)) * d.ldk + ((((L) & 15) ^ KSWF(4 * (w4 + 4 * (i)) + ((L) >> 4))) * 8))
#define VKK(i, L) (((w4 + 4 * (i)) >> 1) * 8 + (((L) & 31) >> 2))
#define VOFF(i, L) (((VKK(i, L) & ~0xC) | ((VKK(i, L) & 4) << 1) | ((VKK(i, L) & 8) >> 1)) * d.ldv + ((w4 + 4 * (i)) & 1) * 64 + ((L) >> 5) * 32 + ((L) & 3) * 8)
#define TROT(j) (((j) + d.rot) >= NT ? ((j) + d.rot) - NT : ((j) + d.rot))
#define TROW(j) (TROT(j) < 4 ? d.row_ctx + 64 * TROT(j) : d.row_lat + 64 * (TROT(j) - 4))
#define GLDS(src, dst) __builtin_amdgcn_global_load_lds((const unsigned*)(src), (LAS unsigned*)(dst), 16, 0, 0)
#define KDMA(j) do { int L_ = lane; asm volatile("" : "+v"(L_)); const GAS bf16* kp_ = (const GAS bf16*)d.K + (long)TROW(j) * d.ldk; LAS char* kb_ = K_lds + ((j) % 3) * SHM_K + w4 * 1024; \
    GLDS(kp_ + KOFF(0, L_), kb_); GLDS(kp_ + KOFF(1, L_), kb_ + 4096); GLDS(kp_ + KOFF(2, L_), kb_ + 8192); GLDS(kp_ + KOFF(3, L_), kb_ + 12288); } while (0)
#define VDMA(j) do { int L_ = lane; asm volatile("" : "+v"(L_)); const GAS bf16* vp_ = (const GAS bf16*)d.V + (long)TROW(j) * d.ldv; LAS char* vb_ = V_lds + ((j) & 1) * 2 * SHM_V + w4 * 1024; \
    _Pragma("unroll") for (int i_ = 0; i_ < 4; ++i_) { const int v_ = VOFF(i_, L_); GLDS(vp_ + v_, vb_ + i_ * 4096); GLDS(vp_ + 128 + v_, vb_ + SHM_V + i_ * 4096); } } while (0)
#define VPIECE(j, i) do { int L_ = lane; asm volatile("" : "+v"(L_)); const GAS bf16* vp_ = (const GAS bf16*)d.V + (long)TROW(j) * d.ldv + ((i) & 1) * 128; \
    GLDS(vp_ + VOFF((i) >> 1, L_), V_lds + ((j) & 1) * 2 * SHM_V + ((i) & 1) * SHM_V + w4 * 1024 + ((i) >> 1) * 4096); } while (0)
#define WAITV(n) asm volatile("s_waitcnt vmcnt(" #n ")" ::: "memory")
#define BAR() asm volatile("s_waitcnt lgkmcnt(0)\n\ts_barrier" ::: "memory")
#define KBUF(j) (K_lds + ((j) % 3) * SHM_K)
#define VOFS(j) (((j) & 1) * 2 * SHM_V)
  if (isS) {
    float m_reg = d.m0, l_reg = d.l0; bf16x8 qr[8];
    { const GAS bf16* Qw = (const GAS bf16*)d.Q + (long)(w4 * QBLK + r32) * d.ldq + hi * 8;
#pragma unroll
      for (int d0 = 0; d0 < 8; ++d0) qr[d0] = *(const GAS bf16x8*)(Qw + d0 * 16); }
    asm volatile("" ::: "memory");
    KDMA(0); KDMA(1); if (2 < NT) KDMA(2);
    f32x16 pA0, pA1, pB0, pB1; float mnA, mnB, alA, alB; bf16x8 pa0, pa1, pa2, pa3;
    if (2 < NT) WAITV(8); else WAITV(4);
    BAR();
    qkt_pf(pA0, pA1, KBUF(0), qr, r32, hi);
    if (2 < NT) WAITV(4); else WAITV(0);
    BAR();
#define PUBP() do { *(LAS bf16x8*)(P_l) = pa0; *(LAS bf16x8*)(P_l + 1024) = pa1; *(LAS bf16x8*)(P_l + 2048) = pa2; *(LAS bf16x8*)(P_l + 3072) = pa3; } while (0)
#define SSTEP(J, PC0, PC1, MNC, ALC, PN0, PN1) do { \
      partialSM(PC0, PC1, m_reg, MNC, ALC); PROBE_SVALU(); { const bool rs_ = __any((ALC) < 1.f); if (rs_ && hi == 0) al_l[r32] = (ALC); if (lane == 0) *flag = rs_ ? 1u : 0u; } \
      if ((J) + 1 < NT) { SBAR(); qkt_pf(PN0, PN1, KBUF((J) + 1), qr, r32, hi); SBAR(); } \
      BAR();                                                                             \
      finishSM(PC0, PC1, ALC, l_reg, pa0, pa1, pa2, pa3); PUBP(); \
      if ((J) + 1 == NT && hi == 0) li_l[r32] = l_reg; \
      if ((J) + 3 < NT) KDMA((J) + 3); \
      if ((J) + 3 < NT) WAITV(4); else WAITV(0); \
      BAR();                                                                             \
    } while (0)
#ifdef PROBE_S
#define PROBE_SVALU() do { float dm_ = 1.0f; _Pragma("unroll") for (int q_ = 0; q_ < 32; ++q_) asm volatile("v_exp_f32 %0, %0" : "+v"(dm_)); asm volatile("" :: "v"(dm_)); } while (0)
#else
#define PROBE_SVALU() do { } while (0)
#endif
    for (int j = 0; j < NT; j += 2) {
      SSTEP(j, pA0, pA1, mnA, alA, pB0, pB1);
      SSTEP(j + 1, pB0, pB1, mnB, alB, pA0, pA1);
    }
    BAR();
#undef PUBP
#undef SSTEP
  } else {
    f32x16 o[8] = {}; bf16x8 pa0, pa1, pa2, pa3;
    const int vb0 = (int)(unsigned)(uintptr_t)V_lds + v_rd_base(lane);
    BAR();
    BAR();
#define GETP() do { pa0 = *(const LAS bf16x8*)(P_l); pa1 = *(const LAS bf16x8*)(P_l + 1024); pa2 = *(const LAS bf16x8*)(P_l + 2048); pa3 = *(const LAS bf16x8*)(P_l + 3072); } while (0)
#ifdef PROBE_W
    unsigned long long wacc = 0, wprev = __builtin_amdgcn_s_memrealtime();
#define WST(k) do { const unsigned long long t_ = __builtin_amdgcn_s_memrealtime(); if ((k) == PROBE_W) wacc += t_ - wprev; wprev = t_; } while (0)
#else
#define WST(k) do { } while (0)
#endif
    VDMA(0);
    BAR();
    WAITV(0); BAR();
    for (int J = 1; J < NT; ++J) {
      WST(3);
      VDMA(J);
      GETP(); asm volatile("s_waitcnt lgkmcnt(0)" ::: "memory"); pv_pipe(o, vb0 + VOFS(J - 1), pa0, pa1, pa2, pa3);
      WST(0); BAR();
      WST(1);
      pv_pipe(o + 4, vb0 + VOFS(J - 1) + SHM_V, pa0, pa1, pa2, pa3);
      if (__builtin_amdgcn_readfirstlane(*flag)) {
#pragma unroll
        for (int dd = 0; dd < 8; ++dd)
#pragma unroll
          for (int r = 0; r < 16; ++r) o[dd][r] *= al_l[crow(r, hi)]; }
      WST(2); WAITV(0); BAR();
    }
    GETP(); asm volatile("s_waitcnt lgkmcnt(0)" ::: "memory"); pv_pipe(o, vb0 + VOFS(NT - 1), pa0, pa1, pa2, pa3); pv_pipe(o + 4, vb0 + VOFS(NT - 1) + SHM_V, pa0, pa1, pa2, pa3);
    float rli[16];
#pragma unroll
    for (int r = 0; r < 16; ++r) rli[r] = __builtin_amdgcn_rcpf(li_l[crow(r, hi)]);
    GAS bf16* Ow = (GAS bf16*)d.O + (long)(w4 * QBLK) * d.ldo;
    if constexpr (!COMB) {
    { LAS bf16* stg = (LAS bf16*)(lds + X_P + w4 * 4096);
#pragma unroll
      for (int g = 0; g < 4; ++g) {
#pragma unroll
        for (int r = 0; r < 16; ++r) { const int orow = crow(r, hi); const float x0 = o[2 * g][r] * rli[r], x1 = o[2 * g + 1][r] * rli[r];
          stg[orow * 64 + r32] = (bf16)(cvt_pk_bf16(x0, x0) & 0xffffu); stg[orow * 64 + 32 + r32] = (bf16)(cvt_pk_bf16(x1, x1) & 0xffffu); }
        asm volatile("s_waitcnt lgkmcnt(0)" ::: "memory");
#pragma unroll
        for (int q = 0; q < 4; ++q) { const int idx = q * 64 + lane, row = idx >> 3, ch = idx & 7; const v4u v = *(const LAS v4u*)(stg + row * 64 + ch * 8);
          *(GAS v4u*)(Ow + (long)row * d.ldo + g * 64 + ch * 8) = v; }
        asm volatile("s_waitcnt lgkmcnt(0)" ::: "memory"); } }
    } else {
      const GAS bf16* O1w = (const GAS bf16*)d.O1 + (long)(w4 * QBLK) * 4096; const float lam = d.lam;
      asm volatile("s_waitcnt vmcnt(0)" ::: "memory");
      LAS bf16* stg = (LAS bf16*)(lds + X_P + w4 * 4096);
      float dv[4][4][8]; float ssq[4] = {0.f, 0.f, 0.f, 0.f};
#pragma unroll
      for (int g = 0; g < 4; ++g) {
#pragma unroll
        for (int r = 0; r < 16; ++r) { const int orow = crow(r, hi); const float x0 = o[2 * g][r] * rli[r], x1 = o[2 * g + 1][r] * rli[r];
          stg[orow * 64 + r32] = (bf16)(cvt_pk_bf16(x0, x0) & 0xffffu); stg[orow * 64 + 32 + r32] = (bf16)(cvt_pk_bf16(x1, x1) & 0xffffu); }
        asm volatile("s_waitcnt lgkmcnt(0)" ::: "memory");
#pragma unroll
        for (int q = 0; q < 4; ++q) { const int idx = q * 64 + lane, row = idx >> 3, ch = idx & 7; const v4u v2 = *(const LAS v4u*)(stg + row * 64 + ch * 8);
          const v4u v1 = *(const GAS v4u*)(O1w + (long)row * 4096 + g * 64 + ch * 8);
#pragma unroll
          for (int j = 0; j < 4; ++j) { const unsigned w1 = v1[j], w2 = v2[j];
            const float xl = __builtin_bit_cast(float, w1 << 16) - lam * __builtin_bit_cast(float, w2 << 16), xh = __builtin_bit_cast(float, w1 & 0xffff0000u) - lam * __builtin_bit_cast(float, w2 & 0xffff0000u);
            dv[g][q][2 * j] = xl; dv[g][q][2 * j + 1] = xh; ssq[q] += xl * xl + xh * xh; } }
        asm volatile("s_waitcnt lgkmcnt(0)" ::: "memory"); }
#pragma unroll
      for (int q = 0; q < 4; ++q) { float t = ssq[q]; t += __shfl_xor(t, 1); t += __shfl_xor(t, 2); t += __shfl_xor(t, 4); ssq[q] = __builtin_amdgcn_rsqf(t * (1.f / 256.f) + 1e-6f); }
#pragma unroll
      for (int g = 0; g < 4; ++g)
#pragma unroll
        for (int q = 0; q < 4; ++q) { const int idx = q * 64 + lane, row = idx >> 3, ch = idx & 7; const float rs = ssq[q]; v4u w;
          w.x = cvt_pk_bf16(dv[g][q][0] * rs, dv[g][q][1] * rs); w.y = cvt_pk_bf16(dv[g][q][2] * rs, dv[g][q][3] * rs); w.z = cvt_pk_bf16(dv[g][q][4] * rs, dv[g][q][5] * rs); w.w = cvt_pk_bf16(dv[g][q][6] * rs, dv[g][q][7] * rs);
          *(GAS v4u*)(Ow + (long)row * d.ldo + g * 64 + ch * 8) = w; }
    }
    BAR();
#ifdef PROBE_W
    if (blockIdx.x == 0 && wid == 4 && lane == 0) { GAS unsigned long long* tw = (GAS unsigned long long*)d.probe; tw[4] += wacc; }
#endif
#undef GETP
  }
#undef KOFF
#undef VKK
#undef VOFF
#undef TROW
#undef TROT
#undef GLDS
#undef KDMA
#undef VDMA
#undef VPIECE
#undef WAITV
#undef BAR
#undef KBUF
#undef VOFS
}
}
constexpr int NWAVES = 8;
constexpr size_t MiB = 1u << 20;
constexpr size_t WS_CTL = 0, CTL_ZERO_BYTES = 1 * MiB;
constexpr size_t WS_MODP = 1 * MiB;
constexpr size_t WS_MODS = 9 * MiB;
constexpr size_t WS_TAB = 10 * MiB;
constexpr size_t WS_SSQ = 11 * MiB;
constexpr size_t WS_W = 13 * MiB;
constexpr size_t W_SWA_QKV = WS_W, W_SWA_O = W_SWA_QKV + 12 * MiB, W_DIFF_QKV = W_SWA_O + 8 * MiB, W_DIFF_O = W_DIFF_QKV + 24 * MiB;
constexpr size_t W_MLA_DOWN = W_DIFF_O + 8 * MiB, W_MLA_UQ = W_MLA_DOWN + 5 * MiB, W_MLA_UKV = W_MLA_UQ + 3 * MiB, W_MLA_O = W_MLA_UKV + 4 * MiB;
constexpr size_t W_NA_QKV = W_MLA_O + 8 * MiB, W_NA_O = W_NA_QKV + 24 * MiB, W_GU = W_NA_O + 8 * MiB, W_DOWN = W_GU + 4 * 44 * MiB, W_END = W_DOWN + 4 * 22 * MiB;
constexpr size_t WS_H = W_END;
constexpr size_t WS_U = WS_H + 136 * MiB;
constexpr size_t WS_Y = WS_U + 68 * MiB;
constexpr size_t WS_O = WS_Y + 136 * MiB;
constexpr size_t WS_O12 = WS_O + 68 * MiB;
constexpr size_t WS_R1 = WS_O12 + 136 * MiB;
constexpr size_t R1_MLA_Q = WS_R1, R1_MLA_KV = WS_R1 + 102 * MiB, R1_MLA_C = R1_MLA_KV + 136 * MiB, R1_MLA_KPE = R1_MLA_C + 34 * MiB;
constexpr size_t R1_KH = WS_R1 + 68 * MiB, R1_VH = WS_R1 + 136 * MiB;
constexpr size_t WS_YP = WS_R1 + 276 * MiB;
constexpr size_t WS_END = WS_YP + 64 * MiB;
static_assert(W_END == (13 + 368) * MiB && (size_t)MROWS * 6144 * 2 <= 276 * MiB && (size_t)MROWS * FF * 2 <= 276 * MiB && R1_MLA_KPE + (size_t)MROWS * 64 * 2 <= WS_END, "ws map");
constexpr int CW_BAR = 4096;
constexpr int RING_BYTES = 133120, MISC_OFF = 135168, LDS_BYTES = 147456;
static_assert(attn::L_END <= RING_BYTES && attn::X_END <= RING_BYTES && pg8::STAGE_BYTES <= RING_BYTES && 8 * 16640 <= RING_BYTES && MISC_OFF + 128 <= LDS_BYTES, "LDS map");

#define RLX_AGENT __ATOMIC_RELAXED, __HIP_MEMORY_SCOPE_AGENT
#define LDS_WAIT() asm volatile("s_waitcnt lgkmcnt(0)" ::: "memory")

#define XB_TMO      128
#define XB_XCNT(j)  (256  + 64 * (j))
#define XB_XSUB(j)  (1280 + 64 * (j))
#define XB_XGEN(j)  (2304 + 64 * (j))
#define XB_TOP      3328
#define XB_TOPGEN   3392
#define XCD_BAR_WORDS 3456
#define XB_SPIN_CAP (1u << 18)
__device__ __forceinline__ unsigned xb_ld(unsigned* p)              { return __hip_atomic_load(p, __ATOMIC_RELAXED, __HIP_MEMORY_SCOPE_AGENT); }
__device__ __forceinline__ unsigned xb_add(unsigned* p, unsigned v) { return __hip_atomic_fetch_add(p, v, __ATOMIC_RELAXED, __HIP_MEMORY_SCOPE_AGENT); }
__device__ __forceinline__ unsigned xb_xcc_id() { return (unsigned)__builtin_amdgcn_s_getreg((3 << 11) | 20) & 0xFu; }
#define XB_SPIN(cond, bar) do { unsigned _sp = 0; while (cond) { __builtin_amdgcn_s_sleep(1); \
    if ((++_sp & 255u) == 0u) { if (xb_ld(&(bar)[XB_TMO])) break; if (_sp > XB_SPIN_CAP) { atomicAdd(&(bar)[XB_TMO], 1u); break; } } } } while (0)
struct XcdBarrier { unsigned* bar; unsigned x; volatile LAS unsigned* st; };
__device__ __forceinline__ XcdBarrier xcd_barrier_post(unsigned* bar, volatile LAS unsigned* st) {
    XcdBarrier b; b.bar = bar; b.x = xb_xcc_id(); b.st = st;
    if (threadIdx.x == 0) (void)xb_add(&bar[XB_XCNT(b.x)], 1u);
    return b;
}
__device__ __forceinline__ void xcd_barrier_complete(unsigned* bar, unsigned x, unsigned& nloc, unsigned& nx) {
    const unsigned G = gridDim.x * gridDim.y * gridDim.z;
    unsigned sum, cnt, mine, sp = 0u;
    for (;;) {
        sum = 0u; cnt = 0u; mine = 0u;
#pragma unroll
        for (unsigned j = 0; j < 16; ++j) { const unsigned c = xb_ld(&bar[XB_XCNT(j)]); sum += c; cnt += (c > 0u) ? 1u : 0u; mine = (j == x) ? c : mine; }
        if (sum == G) break;
        __builtin_amdgcn_s_sleep(1);
        if ((++sp & 255u) == 0u) { if (xb_ld(&bar[XB_TMO])) break; if (sp > XB_SPIN_CAP) { atomicAdd(&bar[XB_TMO], 1u); break; } }
    }
    nloc = mine > 0u ? mine : 1u; nx = cnt > 0u ? cnt : 1u;
}
__device__ __forceinline__ void xcd_barrier(const XcdBarrier& b) {
    asm volatile("s_waitcnt vmcnt(0)" ::: "memory");
    __syncthreads();
    if (threadIdx.x == 0) {
        unsigned* bar = b.bar;
        __builtin_amdgcn_s_waitcnt(0);
        unsigned nloc = b.st[0], nx = b.st[1];
        if (nloc == 0u) { xcd_barrier_complete(bar, b.x, nloc, nx); b.st[0] = nloc; b.st[1] = nx; }
        const unsigned old = xb_add(&bar[XB_XSUB(b.x)], 1u);
        const unsigned gen = old / nloc;
        if (old + 1u == (gen + 1u) * nloc) {
            __builtin_amdgcn_fence(__ATOMIC_RELEASE, "agent");
            asm volatile("s_waitcnt vmcnt(0)" ::: "memory");
            const unsigned og = xb_add(&bar[XB_TOP], 1u);
            const unsigned tg = og / nx;
            if (og + 1u == (tg + 1u) * nx) xb_add(&bar[XB_TOPGEN], 1u);
            else XB_SPIN(xb_ld(&bar[XB_TOPGEN]) == tg, bar);
            __builtin_amdgcn_fence(__ATOMIC_ACQUIRE, "agent");
            xb_add(&bar[XB_XGEN(b.x)], 1u);
            asm volatile("s_waitcnt vmcnt(0)" ::: "memory");
        } else {
            XB_SPIN(xb_ld(&bar[XB_XGEN(b.x)]) == gen, bar);
            __builtin_amdgcn_fence(__ATOMIC_ACQUIRE, "agent");
            asm volatile("s_waitcnt vmcnt(0)" ::: "memory");
        }
    }
    __syncthreads();
}

enum { I_X = 0, I_C, I_CTX, I_CCTX, I_MODW, I_MODB, I_NORMG, I_WGU, I_WDOWN, I_SWA_QKV, I_SWA_O, I_SWA_SINK, I_DIFF_QKV, I_DIFF_O, I_DIFF_LAM, I_DIFF_SUBLN,
       I_MLA_DOWN, I_MLA_QN, I_MLA_KVN, I_MLA_UQ, I_MLA_UKV, I_MLA_O, I_NA_QKV, I_NA_O, I_NA_RPB, N_IN };
struct Args { const float* in[N_IN]; float* out; unsigned char* ws; int ph_lo, ph_hi, li, pad; };

struct Frame {
    LAS unsigned char* lds;
    int tid, lane, wave, vcu, G;
    unsigned char* ws;
};
__device__ __forceinline__ float wave_sum(float v) {
#pragma unroll
    for (int o = 1; o < 64; o <<= 1) v += __shfl_xor(v, o);
    return v;
}
__device__ __forceinline__ float ssq4(const f32x4 v) { return (v[0] * v[0] + v[1] * v[1]) + (v[2] * v[2] + v[3] * v[3]); }

constexpr float DIFF_LAM_INIT = 0.35550906759096926f;
struct CJob { const float* W; bf16* WT; int K, Nsrc, Ng, gu, rmod, rlo, rmax, pt; const float* kg; int kmask; float ks; };
constexpr int CJ_ITEMS[18] = {1536, 1024, 3072, 1024, 640, 384, 512, 1024, 3072, 1024, 5632, 5632, 5632, 5632, 2816, 2816, 2816, 2816};
constexpr int CJ_TOTAL = 47104;
#define CJ_IN(I_) cj_opaque(a.in[I_])
__device__ __forceinline__ const float* cj_opaque(const float* p) { unsigned long long v = (unsigned long long)p; asm volatile("" : "+s"(v)); return (const float*)v; }
__device__ __forceinline__ CJob cjob(const Args& a, int j) {
    unsigned char* ws = a.ws; CJob c; c.gu = 0; c.rmod = 1 << 30; c.rlo = 0; c.rmax = 0; c.pt = 0; c.kg = nullptr; c.kmask = -1; c.ks = 1.f;
    switch (j) {
    case 0: c.W = CJ_IN(I_SWA_QKV); c.WT = (bf16*)(ws + W_SWA_QKV); c.K = 2048; c.Nsrc = 3072; c.Ng = 3072; c.rmax = 2560; c.pt = 1; break;
    case 1: c.W = CJ_IN(I_SWA_O); c.WT = (bf16*)(ws + W_SWA_O); c.K = 2048; c.Nsrc = 2048; c.Ng = 2048; break;
    case 2: c.W = CJ_IN(I_DIFF_QKV); c.WT = (bf16*)(ws + W_DIFF_QKV); c.K = 2048; c.Nsrc = 6144; c.Ng = 6144; c.rmax = 4096; c.pt = 1; break;
    case 3: c.W = CJ_IN(I_DIFF_O); c.WT = (bf16*)(ws + W_DIFF_O); c.K = 2048; c.Nsrc = 2048; c.Ng = 2048; c.kg = CJ_IN(I_DIFF_SUBLN); c.kmask = 255; c.ks = 1.f - DIFF_LAM_INIT; break;
    case 4: c.W = CJ_IN(I_MLA_DOWN); c.WT = (bf16*)(ws + W_MLA_DOWN); c.K = 2048; c.Nsrc = 1088; c.Ng = 1280; c.rlo = 1024; c.rmax = 1088; c.pt = 2; break;
    case 5: c.W = CJ_IN(I_MLA_UQ); c.WT = (bf16*)(ws + W_MLA_UQ); c.K = 512; c.Nsrc = 3072; c.Ng = 3072; c.rmod = 192; c.rlo = 128; c.rmax = 3072; c.pt = 2; c.kg = CJ_IN(I_MLA_QN); break;
    case 6: c.W = CJ_IN(I_MLA_UKV); c.WT = (bf16*)(ws + W_MLA_UKV); c.K = 512; c.Nsrc = 4096; c.Ng = 4096; c.kg = CJ_IN(I_MLA_KVN); break;
    case 7: c.W = CJ_IN(I_MLA_O); c.WT = (bf16*)(ws + W_MLA_O); c.K = 2048; c.Nsrc = 2048; c.Ng = 2048; break;
    case 8: c.W = CJ_IN(I_NA_QKV); c.WT = (bf16*)(ws + W_NA_QKV); c.K = 2048; c.Nsrc = 6144; c.Ng = 6144; break;
    case 9: c.W = CJ_IN(I_NA_O); c.WT = (bf16*)(ws + W_NA_O); c.K = 2048; c.Nsrc = 2048; c.Ng = 2048; break;
    case 10: case 11: case 12: case 13: c.W = CJ_IN(I_WGU) + (size_t)(j - 10) * DM * 2 * FF; c.WT = (bf16*)(ws + W_GU + (size_t)(j - 10) * 44 * MiB); c.K = 2048; c.Nsrc = 2 * FF; c.Ng = 2 * FF; c.gu = 1; break;
    default: c.W = CJ_IN(I_WDOWN) + (size_t)(j - 14) * FF * DM; c.WT = (bf16*)(ws + W_DOWN + (size_t)(j - 14) * 22 * MiB); c.K = FF; c.Nsrc = 2048; c.Ng = 2048; break;
    }
    return c;
}
__device__ __forceinline__ void convert_item(const CJob& c, int it, LAS float* scr, int lane) {
    const int ngr = c.Ng >> 6, kb = it / ngr, gi = it - kb * ngr, k0 = kb * 64, n0 = gi * 64;
    int sb = n0; if (c.gu) { const int pn = n0 >> 8, bj = (n0 >> 7) & 1, j = n0 & 127; sb = bj * FF + pn * 128 + j; }
    const bool zero = sb >= c.Nsrc, rope = ((n0 % c.rmod) >= c.rlo) && (n0 < c.rmax);
    if (!zero) {
        const GAS f32x4* wp = (const GAS f32x4*)(c.W + (size_t)(k0 + (lane >> 4)) * c.Nsrc + sb + (lane & 15) * 4);
        f32x4 v[16];
#pragma unroll
        for (int i = 0; i < 16; ++i) v[i] = wp[(size_t)i * c.Nsrc];
#pragma unroll
        for (int i = 0; i < 16; ++i) { LAS float* s = scr + (4 * i + (lane >> 4)) * 65 + (lane & 15) * 4; s[0] = v[i][0]; s[1] = v[i][1]; s[2] = v[i][2]; s[3] = v[i][3]; }
    }
    LDS_WAIT(); asm volatile("" ::: "memory");
    const int cch = lane & 7;
    float g[8];
#pragma unroll
    for (int t = 0; t < 8; ++t) g[t] = c.kg ? ((const GAS float*)c.kg)[(k0 + 8 * cch + t) & c.kmask] * c.ks : 1.f;
#pragma unroll
    for (int j8 = 0; j8 < 8; ++j8) { const int nn = (lane >> 3) + 8 * j8;
        int src = nn; if (rope) src = (c.pt == 1) ? ((nn & 1) * 32 + (nn >> 1)) : ((nn >> 5) * 32 + (nn & 1) * 16 + ((nn & 31) >> 1));
        const LAS float* s = scr + (8 * cch) * 65 + src; v4u o;
        if (zero) o = (v4u){0u, 0u, 0u, 0u};
        else { o.x = cvt_pk_bf16(s[0 * 65] * g[0], s[1 * 65] * g[1]); o.y = cvt_pk_bf16(s[2 * 65] * g[2], s[3 * 65] * g[3]); o.z = cvt_pk_bf16(s[4 * 65] * g[4], s[5 * 65] * g[5]); o.w = cvt_pk_bf16(s[6 * 65] * g[6], s[7 * 65] * g[7]); }
        *(GAS v4u*)(c.WT + (size_t)(n0 + nn) * c.K + k0 + 8 * cch) = o; }
    LDS_WAIT(); asm volatile("" ::: "memory");
}
constexpr int cj_total(unsigned mask) { int t = 0; for (int q = 0; q < 18; ++q) if ((mask >> q) & 1u) t += CJ_ITEMS[q]; return t; }
template <unsigned MASK>
__device__ __forceinline__ void convert_jobs(Frame& F, const Args& a, int ic, int nidle) {
    if (ic < 0) return;
    constexpr int TOTAL = cj_total(MASK);
    LAS float* scr = (LAS float*)(F.lds + F.wave * 16640);
    for (int gidx = ic * NWAVES + F.wave; gidx < TOTAL; gidx += nidle * NWAVES) {
        int j = 0, it = gidx; bool found = false;
#pragma unroll
        for (int q = 0; q < 18; ++q) { if (((MASK >> q) & 1u) && !found) { if (it < CJ_ITEMS[q]) { j = q; found = true; } else it -= CJ_ITEMS[q]; } }
        const CJob c = cjob(a, j);
        convert_item(c, it, scr, F.lane);
    }
}
constexpr unsigned CJM_L0 = (1u << 0) | (1u << 1);
constexpr unsigned cvm_ffn1(int l) { return l == 0 ? (1u << 2) : 0u; }
constexpr unsigned cvm_ffn2(int l) { return l == 0 ? ((1u << 3) | (1u << 15)) : l == 1 ? ((1u << 7) | (1u << 16)) : (1u << 8); }
constexpr int MOD_KS = 16;
template <int L0, int LN, int KS = MOD_KS, bool REV = false>
__device__ __forceinline__ void mod_partials(Frame& F, const Args& a, int ic, int nidle) {
    if (ic < 0 || LN <= 0) return;
    constexpr int RPT = DM / KS;
    LAS float* scr = (LAS float*)(F.lds + F.wave * 16640);
    const int lane = F.lane;
    const int w0 = ic * NWAVES + F.wave, nw = nidle * NWAVES;
    for (int t = REV ? nw - 1 - w0 : w0; t < LN * 48 * KS; t += nw) {
        const int li = t / (48 * KS), l = L0 + li, rem = t - li * (48 * KS), cg = rem / KS, ks = rem - cg * KS;
#pragma unroll
        for (int r = 0; r < 5; ++r)
#pragma unroll
            for (int q = 0; q < RPT / 64; ++q) { const int k = ks * RPT + lane + 64 * q; const float v = (r < 4) ? ((const GAS float*)a.in[I_C])[r * DM + k] : ((const GAS float*)a.in[I_CCTX])[k];
                scr[r * RPT + lane + 64 * q] = v / (1.f + __expf(-v)); }
        LDS_WAIT(); asm volatile("" ::: "memory");
        f32x4 acc[5];
#pragma unroll
        for (int r = 0; r < 5; ++r) acc[r] = (f32x4){0.f, 0.f, 0.f, 0.f};
        const GAS f32x4* wp = (const GAS f32x4*)(a.in[I_MODW] + ((size_t)l * DM + ks * RPT) * MODW + cg * 256 + lane * 4);
        for (int kk = 0; kk < RPT; kk += 16) { f32x4 w[16];
#pragma unroll
            for (int i = 0; i < 16; ++i) w[i] = wp[(size_t)(kk + i) * (MODW / 4)];
#pragma unroll
            for (int i = 0; i < 16; ++i)
#pragma unroll
                for (int r = 0; r < 5; ++r) acc[r] += w[i] * scr[r * RPT + kk + i]; }
#pragma unroll
        for (int r = 0; r < 5; ++r) *(GAS f32x4*)((float*)(F.ws + WS_MODP) + ((size_t)((l & 1) * MOD_KS + ks) * 5 + r) * MODW + cg * 256 + lane * 4) = acc[r];
        LDS_WAIT(); asm volatile("" ::: "memory");
    }
}
template <int L0, int LN, int KS = MOD_KS>
__device__ __forceinline__ void mod_reduce(Frame& F, const Args& a, int ic, int nidle) {
    if (ic < 0 || LN <= 0) return;
    for (int gid = ic * 512 + F.tid; gid < LN * 5 * (MODW / 4); gid += nidle * 512) {
        const int li = gid / (5 * (MODW / 4)), l = L0 + li, rem = gid - li * (5 * (MODW / 4)), r = rem / (MODW / 4), j4 = rem - r * (MODW / 4);
        f32x4 s = *(const GAS f32x4*)(a.in[I_MODB] + (size_t)l * MODW + 4 * j4);
#pragma unroll
        for (int ks = 0; ks < KS; ++ks) s += *(const GAS f32x4*)((const float*)(F.ws + WS_MODP) + ((size_t)((l & 1) * MOD_KS + ks) * 5 + r) * MODW + 4 * j4);
        *(GAS f32x4*)((float*)(F.ws + WS_MODS) + ((size_t)l * 5 + r) * MODW + 4 * j4) = s;
    }
}
__device__ __forceinline__ void p0a(Frame& F, const Args& a) {
    LAS float* scr = (LAS float*)(F.lds + F.wave * 16640);
    const int gw = F.vcu * NWAVES + F.wave, NGW = F.G * NWAVES, lane = F.lane;
    mod_partials<0, 1, 32, true>(F, a, F.vcu, F.G);
    convert_jobs<CJM_L0>(F, a, F.vcu, F.G);
    if (blockIdx.x == 0) {
        const float L2T = 13.287712379549449f;
        GAS f32x4* T128 = (GAS f32x4*)(F.ws + WS_TAB); GAS f32x4* T64 = (GAS f32x4*)(F.ws + WS_TAB + 16384);
        for (int e = F.tid; e < 1024 + 512; e += 512) {
            int pos, k, n; if (e < 1024) { pos = e >> 4; k = e & 15; n = 32; } else { pos = (e - 1024) >> 3; k = (e - 1024) & 7; n = 16; }
            f32x4 o;
#pragma unroll
            for (int q = 0; q < 2; ++q) { const float inv = exp2f(-(float)(2 * k + q) / (float)n * L2T); const float ang = (float)pos * inv; float rev = ang * 0.15915494309189535f; rev -= floorf(rev);
                o[2 * q] = __builtin_amdgcn_cosf(rev); o[2 * q + 1] = __builtin_amdgcn_sinf(rev); }
            if (e < 1024) T128[e] = o; else T64[e - 1024] = o;
        }
    }
    if (blockIdx.x == 1 && F.wave == 0) {
        const GAS float* lv = (const GAS float*)a.in[I_DIFF_LAM];
        const float s1 = wave_sum(lv[lane] * lv[128 + lane] + lv[64 + lane] * lv[192 + lane]), s2 = wave_sum(lv[256 + lane] * lv[384 + lane] + lv[320 + lane] * lv[448 + lane]);
        if (lane == 0) *(GAS float*)(F.ws + WS_TAB + 32768) = expf(s1) - expf(s2) + DIFF_LAM_INIT;
    }
}
__device__ __forceinline__ void p0b(Frame& F, const Args& a) { mod_reduce<0, 1, 32>(F, a, (int)blockIdx.x, F.G); }
template <int KIND>
__device__ __forceinline__ void thin_phase(Frame& F, const Args& a, int lg, int sub, bool latent_only, int ysplit, bool dry = false) {
    const int gw = F.vcu * NWAVES + F.wave, NGW = F.G * NWAVES, lane = F.lane;
    const int lu = (KIND == 0) ? 0 : (sub == 0 ? lg : lg + 1), subu = (KIND == 0) ? 0 : 1 - sub;
    const GAS float* MODS = (const GAS float*)(F.ws + WS_MODS); const GAS float* NG = (const GAS float*)a.in[I_NORMG];
    LAS f32x4* PT = (LAS f32x4*)F.lds;
    { const int t = F.tid;
#pragma unroll
      for (int r = 0; r < 5; ++r) {
        if (KIND != 0) { const f32x4 g = ((const GAS f32x4*)(MODS + ((size_t)lg * 5 + r) * MODW + (sub ? 5 : 2) * DM))[t], p = ((const GAS f32x4*)(NG + ((size_t)lg * 4 + (sub ? 3 : 1)) * DM))[t]; PT[(r * 3 + 0) * 512 + t] = g * p; }
        if (KIND != 2) { const GAS float* mv = MODS + ((size_t)lu * 5 + r) * MODW;
          const f32x4 sc = ((const GAS f32x4*)(mv + (subu ? 4 : 1) * DM))[t], sh = ((const GAS f32x4*)(mv + (subu ? 3 : 0) * DM))[t], p = ((const GAS f32x4*)(NG + ((size_t)lu * 4 + (subu ? 2 : 0)) * DM))[t];
          PT[(r * 3 + 1) * 512 + t] = p * (sc + 1.f); PT[(r * 3 + 2) * 512 + t] = sh; } }
      __syncthreads(); }
    for (int m = gw; m < MROWS; m += NGW) {
        const int b = m / TPB, rr = m - b * TPB; const bool isctx = rr < CTXL; const int mr = isctx ? 4 : b;
        if ((latent_only || KIND == 2) && isctx) continue;
        f32x4 h[8];
        if (KIND == 0) { const GAS f32x4* hp = (const GAS f32x4*)(isctx ? a.in[I_CTX] + ((size_t)b * CTXL + rr) * DM : a.in[I_X] + ((size_t)b * SEQ + (rr - CTXL)) * DM);
#pragma unroll
          for (int j = 0; j < 8; ++j) h[j] = hp[64 * j + lane]; }
        else { const GAS unsigned long long* hp = (const GAS unsigned long long*)((const bf16*)(F.ws + WS_H) + (size_t)m * DM);
#pragma unroll
          for (int j = 0; j < 8; ++j) { const unsigned long long w = hp[64 * j + lane]; const unsigned lo = (unsigned)w, hi = (unsigned)(w >> 32);
            h[j] = (f32x4){__builtin_bit_cast(float, lo << 16), __builtin_bit_cast(float, lo & 0xffff0000u), __builtin_bit_cast(float, hi << 16), __builtin_bit_cast(float, hi & 0xffff0000u)}; } }
        if (KIND != 0) {
            f32x4 y[8]; float ss = 0.f;
            if (!(isctx && ysplit)) { const GAS unsigned long long* yp = (const GAS unsigned long long*)((const bf16*)(F.ws + WS_Y) + (size_t)m * DM);
#pragma unroll
                for (int j = 0; j < 8; ++j) { const unsigned long long w = yp[64 * j + lane]; const unsigned lo = (unsigned)w, hi = (unsigned)(w >> 32);
                    y[j] = (f32x4){__builtin_bit_cast(float, lo << 16), __builtin_bit_cast(float, lo & 0xffff0000u), __builtin_bit_cast(float, hi << 16), __builtin_bit_cast(float, hi & 0xffff0000u)}; }
            } else {
                const GAS f32x4* sp = (const GAS f32x4*)((const float*)(F.ws + WS_YP) + ((size_t)b * CTXL + rr) * DM);
#pragma unroll
                for (int j = 0; j < 8; ++j) y[j] = sp[64 * j + lane];
#pragma unroll 1
                for (int ks = 1; ks < ysplit; ++ks) { sp += (size_t)1024 * DM / 4;
#pragma unroll
                    for (int j = 0; j < 8; ++j) y[j] += sp[64 * j + lane]; } }
#pragma unroll
            for (int j = 0; j < 8; ++j) ss += ssq4(y[j]);
            const float rstd = __builtin_amdgcn_rsqf(wave_sum(ss) * (1.f / DM) + EPS);
            const LAS f32x4* pa = PT + (mr * 3 + 0) * 512;
#pragma unroll
            for (int j = 0; j < 8; ++j) h[j] += pa[64 * j + lane] * (y[j] * rstd);
        }
        if (KIND == 2) { GAS f32x4* op = (GAS f32x4*)(a.out + ((size_t)b * SEQ + (rr - CTXL)) * DM);
#pragma unroll
            for (int j = 0; j < 8; ++j) op[64 * j + lane] = h[j];
        } else {
            GAS unsigned long long* hp = (GAS unsigned long long*)((bf16*)(F.ws + (dry ? WS_O12 : WS_H)) + (size_t)m * DM); float ss = 0.f;
#pragma unroll
            for (int j = 0; j < 8; ++j) { hp[64 * j + lane] = (unsigned long long)cvt_pk_bf16(h[j][0], h[j][1]) | ((unsigned long long)cvt_pk_bf16(h[j][2], h[j][3]) << 32); ss += ssq4(h[j]); }
            const float rstd = __builtin_amdgcn_rsqf(wave_sum(ss) * (1.f / DM) + EPS);
            const LAS f32x4* pc = PT + (mr * 3 + 1) * 512; const LAS f32x4* ps = PT + (mr * 3 + 2) * 512;
            GAS unsigned long long* up = (GAS unsigned long long*)((bf16*)(F.ws + (dry ? WS_O : WS_U)) + (size_t)m * DM);
#pragma unroll
            for (int j = 0; j < 8; ++j) { const f32x4 u = (h[j] * rstd) * pc[64 * j + lane] + ps[64 * j + lane];
                up[64 * j + lane] = (unsigned long long)cvt_pk_bf16(u[0], u[1]) | ((unsigned long long)cvt_pk_bf16(u[2], u[3]) << 32); }
        }
    }
    __syncthreads();
}
__device__ __forceinline__ void diff_combine(Frame& F) {
    const int gw = F.vcu * NWAVES + F.wave, NGW = F.G * NWAVES, lane = F.lane;
    const float lam = *(const GAS float*)(F.ws + WS_TAB + 32768);
    for (int m = gw; m < MROWS; m += NGW) {
        const GAS v4u* p1 = (const GAS v4u*)((const bf16*)(F.ws + WS_O12) + (size_t)m * 4096); GAS v4u* po = (GAS v4u*)((bf16*)(F.ws + WS_O) + (size_t)m * DM);
#pragma unroll
        for (int s = 0; s < 4; ++s) { const v4u a1 = p1[64 * s + lane], a2 = p1[256 + 64 * s + lane]; float x[8]; float ss = 0.f;
#pragma unroll
            for (int q = 0; q < 4; ++q) { const unsigned w1 = a1[q], w2 = a2[q];
                x[2 * q] = __builtin_bit_cast(float, w1 << 16) - lam * __builtin_bit_cast(float, w2 << 16); x[2 * q + 1] = __builtin_bit_cast(float, w1 & 0xffff0000u) - lam * __builtin_bit_cast(float, w2 & 0xffff0000u);
                ss += x[2 * q] * x[2 * q] + x[2 * q + 1] * x[2 * q + 1]; }
#pragma unroll
            for (int o = 1; o < 32; o <<= 1) ss += __shfl_xor(ss, o);
            const float rstd = __builtin_amdgcn_rsqf(ss * (1.f / 256.f) + EPS);
            v4u w; w.x = cvt_pk_bf16(x[0] * rstd, x[1] * rstd); w.y = cvt_pk_bf16(x[2] * rstd, x[3] * rstd); w.z = cvt_pk_bf16(x[4] * rstd, x[5] * rstd); w.w = cvt_pk_bf16(x[6] * rstd, x[7] * rstd);
            po[64 * s + lane] = w; }
    }
}
__device__ __forceinline__ void attn_swa_phase(Frame& F, const Args& a) {
    const bf16* QKV = (const bf16*)(F.ws + WS_R1); bf16* O = (bf16*)(F.ws + WS_O);
    for (int it = 0; ; ++it) {
        int u = F.vcu + it * F.G;
        if (u >= 1024) {
            if (F.G == 256) { const int q = F.vcu & 15, e = it - 4; if ((q != 0 && q != 15) || e < 0 || e > 1) break; u = 1024 + ((F.vcu >> 4) * 2 + (q == 15 ? 1 : 0)) * 2 + e; }
            else if (u >= 1024 + 64) break;
        }
        attn::Desc d; int b, hq; long qrow;
        if (u < 1024) { const int bh = u >> 4, qb = u & 15; b = bh >> 4; hq = bh & 15; qrow = (long)b * TPB + CTXL + 256 * qb;
            const int t0 = 256 * qb, tlo = t0 - 128 < 0 ? 0 : t0 - 128, thi = t0 + 384 > SEQ ? SEQ : t0 + 384;
            d.NT = 4 + (thi - tlo) / 64; d.row_lat = b * TPB + CTXL + tlo; d.a0 = tlo - t0;
        } else { const int bh = u - 1024; b = bh >> 4; hq = bh & 15; qrow = (long)b * TPB; d.NT = 4; d.row_lat = b * TPB + CTXL; d.a0 = 0; }
        const int hk = hq >> 2;
        d.NTreal = d.NT; d.row_ctx = b * TPB; d.a1 = 0; d.rpb = nullptr; d.K2 = nullptr; d.rot = 0;
        d.Q = QKV + qrow * 3072 + 128 * hq; d.K = QKV + 2048 + 128 * hk; d.V = QKV + 2560 + 128 * hk; d.O = O + qrow * DM + 128 * hq;
        d.ldq = 3072; d.ldk = 3072; d.ldv = 3072; d.ldo = DM;
        d.m0 = ((const GAS float*)a.in[I_SWA_SINK])[hq]; d.l0 = 1.f;
        attn::unit<1, false, 2, 8>(d, (LAS char*)F.lds);
    }
}
__device__ __forceinline__ void attn_diff_phase(Frame& F) {
    const bf16* Q = (const bf16*)(F.ws + WS_R1); const bf16* KH = (const bf16*)(F.ws + R1_KH); const bf16* VH = (const bf16*)(F.ws + R1_VH); bf16* O12 = (bf16*)(F.ws + WS_O12); bf16* O = (bf16*)(F.ws + WS_O);
    const float lam = *(const GAS float*)(F.ws + WS_TAB + 32768);
    for (int u = F.vcu; u < 1024 + 64; u += F.G) {
        attn::Desc d; int bh; long qrow;
        if (u < 1024) { bh = u >> 5; qrow = (long)(bh >> 3) * TPB + CTXL + 128 * (u & 31); d.NT = 68; }
        else { bh = (u - 1024) >> 1; qrow = (long)(bh >> 3) * TPB + 128 * (u & 1); d.NT = 4; }
        const int b = bh >> 3, h = bh & 7;
        d.NTreal = d.NT; d.row_ctx = b * TPB; d.row_lat = b * TPB + CTXL; d.a0 = 0; d.a1 = 0; d.rpb = nullptr; d.K2 = nullptr; d.m0 = -1e30f; d.l0 = 0.f; d.rot = 0; d.probe = F.ws + 65536;
        d.V = VH + (size_t)h * MROWS * 256; d.ldq = 2048; d.ldk = 128; d.ldv = 256; d.O1 = O12 + qrow * 4096 + 256 * h; d.lam = lam;
        d.Q = Q + qrow * 2048 + 256 * h; d.K = KH + (size_t)(2 * h) * MROWS * 128; d.O = O12 + qrow * 4096 + 256 * h; d.ldo = 4096;
        attn::unit_split<false>(d, (LAS char*)F.lds);
        d.Q = Q + qrow * 2048 + 256 * h + 128; d.K = KH + (size_t)(2 * h + 1) * MROWS * 128; d.O = O + qrow * DM + 256 * h; d.ldo = DM;
        attn::unit_split<true>(d, (LAS char*)F.lds);
    }
}
__device__ __forceinline__ void attn_mla_phase(Frame& F) {
    const bf16* Qp = (const bf16*)(F.ws + R1_MLA_Q); const bf16* KV = (const bf16*)(F.ws + R1_MLA_KV); const bf16* KPE = (const bf16*)(F.ws + R1_MLA_KPE); bf16* O = (bf16*)(F.ws + WS_O);
    for (int u = F.vcu; u < 1024 + 64; u += F.G) {
        attn::Desc d; int bh; long qrow;
        if (u < 1024) { bh = u >> 4; const int qb = u & 15; qrow = (long)(bh >> 4) * TPB + CTXL + 256 * qb; d.NT = 68; }
        else { bh = u - 1024; qrow = (long)(bh >> 4) * TPB; d.NT = 4; }
        const int b = bh >> 4, h = bh & 15;
        d.NTreal = d.NT; d.row_ctx = b * TPB; d.row_lat = b * TPB + CTXL; d.a0 = 0; d.a1 = 0; d.rpb = nullptr; d.m0 = -1e30f; d.l0 = 0.f; d.rot = 0;
        d.Q = Qp + qrow * 3072 + 192 * h; d.K = KV + 256 * h; d.V = KV + 256 * h + 128; d.K2 = KPE; d.O = O + qrow * DM + 128 * h;
        d.ldq = 3072; d.ldk = 4096; d.ldv = 4096; d.ldo = DM;
        attn::unit<0, true, 1, 8>(d, (LAS char*)F.lds);
    }
}
__device__ __forceinline__ void attn_na_phase(Frame& F, const Args& a) {
    const bf16* QKV = (const bf16*)(F.ws + WS_R1); bf16* O = (bf16*)(F.ws + WS_O);
    for (int u = F.vcu; u < 1024; u += F.G) {
        attn::Desc d; const int bh = u >> 4, R = u & 15, b = bh >> 4, h = bh & 15; const long qrow = (long)b * TPB + CTXL + 256 * R;
        const int krlo = 4 * R - 4 < 0 ? 0 : 4 * R - 4; int krhi = 4 * R - 1; krhi = (krhi < 0 ? 0 : (krhi > 56 ? 56 : krhi)) + 8;
        d.NTreal = 4 + (krhi - krlo); d.NT = (d.NTreal + 1) & ~1; d.row_ctx = b * TPB; d.row_lat = b * TPB + CTXL + 64 * krlo; d.a0 = krlo; d.a1 = 4 * R;
        d.rpb = a.in[I_NA_RPB] + h * 465; d.K2 = nullptr; d.m0 = -1e30f; d.l0 = 0.f; d.rot = 0;
        d.Q = QKV + qrow * 6144 + 128 * h; d.K = QKV + 2048 + 128 * h; d.V = QKV + 4096 + 128 * h; d.O = O + qrow * DM + 128 * h;
        d.ldq = 6144; d.ldk = 6144; d.ldv = 6144; d.ldo = DM;
        attn::unit<2, false, 1, 4>(d, (LAS char*)F.lds);
    }
}

constexpr int NPH = 33;
#ifdef PROBE_EPI
#define GPROBE (args.ws + 65536)
#else
#define GPROBE nullptr
#endif
#ifndef TS_BLOCK
#define TS_BLOCK 0
#endif
#ifndef TS_BASE
#define TS_BASE 0.f
#endif
#ifndef TS_KIND
#define TS_KIND 0
#endif
#ifndef PROBE_TSMASK
#define PROBE_TSMASK 0ull
#endif
#ifndef TS_SCALE
#define TS_SCALE 1.f
#endif
#ifndef PROBE_DUP
#define PROBE_DUP (-1)
#endif
constexpr int WO_SPLIT = 8, DN_SPLIT = 4;
__global__ void __launch_bounds__(NWAVES * 64, 2) fwd_kernel(Args args) {
    extern __shared__ __attribute__((aligned(16))) unsigned char lds_raw[];
    Frame F; F.lds = (LAS unsigned char*)lds_raw; F.tid = threadIdx.x; F.lane = F.tid & 63; F.wave = __builtin_amdgcn_readfirstlane(F.tid >> 6);
    F.G = gridDim.x; { const int bx = blockIdx.x; F.vcu = (F.G % 8 == 0) ? (bx % 8) * (F.G / 8) + bx / 8 : bx; }
    F.ws = args.ws;
    volatile LAS unsigned* MISC = (volatile LAS unsigned*)(F.lds + MISC_OFF);
    if (F.tid < 32) MISC[F.tid] = 0u;
    __syncthreads();
    XcdBarrier bar = xcd_barrier_post((unsigned*)(args.ws + WS_CTL) + CW_BAR + args.li * XCD_BAR_WORDS, MISC + 8);
    const int lo = args.ph_lo, hi = args.ph_hi;

#define IN(k) (lo <= (k) && (k) < hi)
#ifdef PROBE_BW
#define SEAM(k) do { if ((k) + 1 < hi) { unsigned long long t0_ = 0; const bool hit_ = ((((PROBE_BW) >> (k)) & 1ull) != 0ull) && blockIdx.x == TS_BLOCK && F.tid == 0; if (hit_) t0_ = __builtin_amdgcn_s_memrealtime(); \
    xcd_barrier(bar); if (hit_) { GAS unsigned long long* tw = (GAS unsigned long long*)(args.ws + 65536); tw[5] += __builtin_amdgcn_s_memrealtime() - t0_; } } } while (0)
#else
#define SEAM(k) do { if ((k) + 1 < hi) xcd_barrier(bar); } while (0)
#endif
    unsigned char* ws = args.ws;
    const float* T128 = (const float*)(ws + WS_TAB); const float* T64 = (const float*)(ws + WS_TAB + 16384);
    bf16* U = (bf16*)(ws + WS_U); bf16* Y = (bf16*)(ws + WS_Y); float* YP = (float*)(ws + WS_YP); bf16* O = (bf16*)(ws + WS_O); bf16* R1 = (bf16*)(ws + WS_R1);
    const int bx = (int)blockIdx.x;
#define GEMM_ALL(Abuf, lda_, Wt, N_, K_, EpiT, ...) do { pg8::Gemm g{(const bf16*)(Abuf), (const bf16*)(Wt), MROWS, (N_), (K_), (lda_)}; pg8::StaticOrder S; S.init(MROWS, (N_), (K_), F.G, bx); \
        EpiT E{__VA_ARGS__}; pg8::gemm_phase<EpiT, pg8::StaticOrder>(F.lds, g, S, E, GPROBE); } while (0)
#define GEMM_REV(Abuf, lda_, Wt, N_, K_, EpiT, ...) do { pg8::Gemm g{(const bf16*)(Abuf), (const bf16*)(Wt), MROWS, (N_), (K_), (lda_)}; pg8::StaticOrder S; S.init(MROWS, (N_), (K_), F.G, F.G - 1 - bx); \
        EpiT E{__VA_ARGS__}; pg8::gemm_phase<EpiT, pg8::StaticOrder>(F.lds, g, S, E, GPROBE); } while (0)
#define GEMM_LAT(Abuf, lda_, Wt, N_, K_, EpiT, ...) do { pg8::Gemm g{(const bf16*)(Abuf), (const bf16*)(Wt), MROWS, (N_), (K_), (lda_)}; pg8::LatentOrder S; S.init(NBATCH * SEQ, (N_), (K_), F.G, bx); \
        EpiT E{__VA_ARGS__}; pg8::gemm_phase<EpiT, pg8::LatentOrder>(F.lds, g, S, E); } while (0)
#define GEMM_CSP(Abuf, lda_, Wt, N_, K_, S_, EpiT, ...) do { pg8::Gemm g{(const bf16*)(Abuf), (const bf16*)(Wt), MROWS, (N_), (K_), (lda_)}; pg8::CtxSplitOrder S; S.init(NBATCH * SEQ, (N_), (K_), F.G, bx); S.S = (S_); S.ntA = ((K_) / 64 / ((S_) / 2) / 2 + 1) & ~1; S.ntB = (K_) / 64 / ((S_) / 2) - S.ntA; \
        EpiT E{__VA_ARGS__}; pg8::gemm_phase<EpiT, pg8::CtxSplitOrder>(F.lds, g, S, E); } while (0)
#define TAILCVT(MASK_, nunits_) do { const int rem_ = (nunits_) % F.G; convert_jobs<(MASK_)>(F, args, rem_ ? bx - rem_ : bx, rem_ ? F.G - rem_ : F.G); } while (0)
#define TAIL3() do { const int rem_ = (68 * 12) % F.G, ic_ = rem_ ? bx - rem_ : bx, ni_ = rem_ ? F.G - rem_ : F.G, nA_ = (ni_ * 109 + 104) / 208; \
        if (ni_ < 2 || nA_ < 1 || nA_ >= ni_) { convert_jobs<(1u << 10) | (1u << 14)>(F, args, ic_, ni_); mod_partials<1, 1>(F, args, ic_, ni_); } \
        else { convert_jobs<(1u << 10)>(F, args, (ic_ >= 0 && ic_ < nA_) ? ic_ : -1, nA_); \
               convert_jobs<(1u << 14)>(F, args, ic_ >= nA_ ? ic_ - nA_ : -1, ni_ - nA_); mod_partials<1, 1>(F, args, ic_ >= nA_ ? ic_ - nA_ : -1, ni_ - nA_); } } while (0)
#define TAILV_CVT(MASK_, nunits_) do { const int rem_ = (nunits_) % F.G; convert_jobs<(MASK_)>(F, args, rem_ ? F.vcu - rem_ : F.vcu, rem_ ? F.G - rem_ : F.G); } while (0)
#define TAILV_MODP(L_, nunits_) do { const int rem_ = (nunits_) % F.G; mod_partials<(L_), 1>(F, args, rem_ ? F.vcu - rem_ : F.vcu, rem_ ? F.G - rem_ : F.G); } while (0)
#define TAILMODP(L_, nunits_) do { const int rem_ = (nunits_) % F.G; mod_partials<((L_) < 0 ? 0 : (L_)), ((L_) < 0 ? 0 : 1)>(F, args, rem_ ? bx - rem_ : bx, rem_ ? F.G - rem_ : F.G); } while (0)
#define TAILMODR(L_, nunits_) do { const int rem_ = (nunits_) % F.G; mod_reduce<((L_) < 0 ? 0 : (L_)), ((L_) < 0 ? 0 : 1)>(F, args, rem_ ? bx - rem_ : bx, rem_ ? F.G - rem_ : F.G); } while (0)
#ifdef PROBE_THIN
#define THIN_DRY(x) do { x; xcd_barrier(bar); } while (0)
#else
#define THIN_DRY(x) do { } while (0)
#endif
#ifdef PROBE_COLD
#define COLD_DUP(l, x) do { if ((l) == PROBE_COLD) { x; xcd_barrier(bar); } } while (0)
#else
#define COLD_DUP(l, x) do { } while (0)
#endif
#ifdef PROBE_TS
#define TS_HIT(k) ((PROBE_TS >= 0) ? ((k) == PROBE_TS) : (((PROBE_TSMASK) >> (k)) & 1ull) != 0ull)
#define TS_A(k) do { if (TS_HIT(k) && blockIdx.x == TS_BLOCK && F.tid == 0) { GAS unsigned long long* tw = (GAS unsigned long long*)(args.ws + 65536); tw[0] = __builtin_amdgcn_s_memrealtime(); tw[1] = __builtin_readcyclecounter(); } } while (0)
#define TS_B(k) do { if (TS_HIT(k) && blockIdx.x == TS_BLOCK && F.tid == 0) { GAS unsigned long long* tw = (GAS unsigned long long*)(args.ws + 65536); const unsigned long long r_ = __builtin_amdgcn_s_memrealtime(), c_ = __builtin_readcyclecounter(); \
    tw[2] = r_; tw[3] = c_; tw[5] += r_ - tw[0]; tw[6] += c_ - tw[1]; } } while (0)
#else
#define TS_A(k) do { } while (0)
#define TS_B(k) do { } while (0)
#endif
#define PHASE(k, ...) do { if (IN(k)) { TS_A(k); __VA_ARGS__; TS_B(k); if (PROBE_DUP == (k)) { xcd_barrier(bar); __VA_ARGS__; } SEAM(k); } } while (0)
#define FFN_PART(l, p0) do { \
        PHASE((p0) + 0, THIN_DRY(thin_phase<1>(F, args, (l), 0, false, WO_SPLIT, true)); thin_phase<1>(F, args, (l), 0, false, WO_SPLIT)); \
        PHASE((p0) + 1, COLD_DUP(l, GEMM_ALL(U, DM, ws + W_GU + (size_t)(((l) + 1) & 3) * 44 * MiB, 2 * FF, DM, pg8::EpiSwiGLU, R1, FF)); GEMM_ALL(U, DM, ws + W_GU + (size_t)(l) * 44 * MiB, 2 * FF, DM, pg8::EpiSwiGLU, R1, FF); TAILCVT(cvm_ffn1(l), 68 * 44); TAILMODP(((l) == 2) ? 3 : -1, 68 * 44); TAILMODR(((l) == 0) ? 1 : -1, 68 * 44)); \
        PHASE((p0) + 2, GEMM_CSP(R1, FF, ws + W_DOWN + (size_t)(l) * 22 * MiB, DM, FF, DN_SPLIT, pg8::EpiF32, Y, DM, YP); TAILCVT(cvm_ffn2(l), 64 * 8 + 4 * 8 * DN_SPLIT); TAILMODR(((l) >= 1) ? (l) + 1 : -1, 64 * 8 + 4 * 8 * DN_SPLIT)); \
        PHASE((p0) + 3, THIN_DRY(thin_phase<1>(F, args, (l), 1, false, DN_SPLIT, true)); thin_phase<1>(F, args, (l), 1, false, DN_SPLIT)); } while (0)

    PHASE(0, p0a(F, args));
    PHASE(1, p0b(F, args));
    PHASE(2, thin_phase<0>(F, args, 0, 0, false, 0));
#ifdef PROBE_XBAR
#define XB4 xcd_barrier(bar); xcd_barrier(bar); xcd_barrier(bar); xcd_barrier(bar);
    XB4 XB4 XB4 XB4 XB4 XB4 XB4 XB4 XB4 XB4
#endif
    PHASE(3, GEMM_ALL(U, DM, ws + W_SWA_QKV, 3072, DM, pg8::EpiQKV, R1, 3072, 8, 10, 0.08838834764831845f, T128, nullptr, nullptr, 0, 1);
             TAIL3());
    PHASE(4, attn_swa_phase(F, args));
    PHASE(5, GEMM_CSP(O, DM, ws + W_SWA_O, DM, DM, WO_SPLIT, pg8::EpiF32, Y, DM, YP));
    FFN_PART(0, 6);
    PHASE(10, GEMM_ALL(U, DM, ws + W_DIFF_QKV, 6144, DM, pg8::EpiQKV, R1, 2048, 8, 16, 0.08838834764831845f, T128, (bf16*)(ws + R1_KH), (bf16*)(ws + R1_VH), 16, 2);
              TAILCVT(1u << 11, 68 * 24));
    PHASE(11, attn_diff_phase(F); TAILV_CVT((1u << 4) | (1u << 5) | (1u << 6), 1024 + 64); TAILV_MODP(2, 1024 + 64));
    PHASE(13, GEMM_CSP(O, DM, ws + W_DIFF_O, DM, DM, WO_SPLIT, pg8::EpiF32, Y, DM, YP));
    FFN_PART(1, 14);
    PHASE(18, GEMM_ALL(U, DM, ws + W_MLA_DOWN, 1280, DM, pg8::EpiMlaDown, (bf16*)(ws + R1_MLA_C), (bf16*)(ws + R1_MLA_KPE), (float*)(ws + WS_SSQ), T64);
              TAILCVT(1u << 12, 68 * 5));
    PHASE(19, GEMM_ALL(ws + R1_MLA_C, 1024, ws + W_MLA_UQ, 3072, 512, pg8::EpiMlaUp<true>, (bf16*)(ws + R1_MLA_Q), 3072, (const float*)(ws + WS_SSQ), 0, 0.07216878364870323f, T64);
              GEMM_REV(ws + R1_MLA_C + 1024, 1024, ws + W_MLA_UKV, 4096, 512, pg8::EpiMlaUp<false>, (bf16*)(ws + R1_MLA_KV), 4096, (const float*)(ws + WS_SSQ), 1, 1.f, T64));
    PHASE(20, attn_mla_phase(F); TAILV_CVT(1u << 17, 1024 + 64));
    PHASE(21, GEMM_CSP(O, DM, ws + W_MLA_O, DM, DM, WO_SPLIT, pg8::EpiF32, Y, DM, YP));
    FFN_PART(2, 22);
    PHASE(26, GEMM_ALL(U, DM, ws + W_NA_QKV, 6144, DM, pg8::EpiQKV, R1, 6144, 8, 0, 0.08838834764831845f, T128, nullptr, nullptr, 0, 1);
              TAILCVT((1u << 13) | (1u << 9), 68 * 24));
    PHASE(27, attn_na_phase(F, args));
    PHASE(28, GEMM_LAT(O, DM, ws + W_NA_O, DM, DM, pg8::EpiF32, Y, DM, YP));
    PHASE(29, thin_phase<1>(F, args, 3, 0, true, 0));
    PHASE(30, GEMM_LAT(U, DM, ws + W_GU + (size_t)3 * 44 * MiB, 2 * FF, DM, pg8::EpiSwiGLU, R1, FF));
    PHASE(31, GEMM_LAT(R1, FF, ws + W_DOWN + (size_t)3 * 22 * MiB, DM, FF, pg8::EpiF32, Y, DM, YP));
    PHASE(32, thin_phase<2>(F, args, 3, 1, true, 0));
#ifdef PROBE_TS
    xcd_barrier(bar);
    if (blockIdx.x == TS_BLOCK && F.tid == 0) { const GAS unsigned long long* tw = (const GAS unsigned long long*)(args.ws + 65536); const float dr = (float)tw[5], dc = (float)tw[6];
        float v = 0.f;
        if (TS_KIND == 0) v = dr * 0.01f;
        if (TS_KIND == 1) v = dc / dr * 100.f;
        if (TS_KIND == 3) v = (float)tw[4] * 0.01f;
        const unsigned long long t0 = __builtin_amdgcn_s_memrealtime(), dt = (unsigned long long)(v * TS_SCALE * 100.f);
        while (__builtin_amdgcn_s_memrealtime() - t0 < dt && dt < 2000000ull) __builtin_amdgcn_s_sleep(8); }
#endif
#undef IN
#undef SEAM
}

#ifndef MK_PER_PHASE
#define MK_PER_PHASE 0
#endif
extern "C" void kernel_launch(void* const* d_in, const int* in_sizes, int n_in, void* d_out, int out_size, void* d_ws, size_t ws_size, hipStream_t stream) {
    static int grid = 0;
    if (grid == 0) {
        if (n_in != N_IN || in_sizes[0] != NBATCH * SEQ * DM || out_size != NBATCH * SEQ * DM || ws_size < WS_END) {
            fprintf(stderr, "kernel_launch: shape mismatch (n_in %d, in0 %d, out %d, ws %zu, need %zu)\n", n_in, n_in > 0 ? in_sizes[0] : -1, out_size, ws_size, (size_t)WS_END); grid = -1; return; }
        int dev = 0, cus = 0, per_cu = 0;
        if (hipGetDevice(&dev) != hipSuccess || hipDeviceGetAttribute(&cus, hipDeviceAttributeMultiprocessorCount, dev) != hipSuccess) { grid = -1; return; }
        if (hipFuncSetAttribute((const void*)fwd_kernel, hipFuncAttributeMaxDynamicSharedMemorySize, LDS_BYTES) != hipSuccess) { fprintf(stderr, "kernel_launch: hipFuncSetAttribute failed\n"); grid = -1; return; }
        if (hipOccupancyMaxActiveBlocksPerMultiprocessor(&per_cu, (const void*)fwd_kernel, NWAVES * 64, LDS_BYTES) != hipSuccess || per_cu < 1) { fprintf(stderr, "kernel_launch: occupancy query says %d\n", per_cu); }
        (void)hipGetLastError();
        grid = cus;
    }
    if (grid < 0) return;
    if (hipMemsetAsync((char*)d_ws + WS_CTL, 0, CTL_ZERO_BYTES, stream) != hipSuccess) return;
    Args a{};
    for (int i = 0; i < N_IN; ++i) a.in[i] = (const float*)d_in[i];
    a.out = (float*)d_out; a.ws = (unsigned char*)d_ws;
#if MK_PER_PHASE
    for (int p = 0; p < NPH; ++p) { a.ph_lo = p; a.ph_hi = p + 1; a.li = 0; hipLaunchKernelGGL(fwd_kernel, dim3(grid), dim3(NWAVES * 64), LDS_BYTES, stream, a); }
#else
    a.ph_lo = 0; a.ph_hi = NPH; a.li = 0;
    hipLaunchKernelGGL(fwd_kernel, dim3(grid), dim3(NWAVES * 64), LDS_BYTES, stream, a);
#endif
    const hipError_t le = hipPeekAtLastError();
    if (le != hipSuccess) fprintf(stderr, "kernel_launch: launch failed: %s\n", hipGetErrorName(le));
}
```

```cpp
#include <hip/hip_runtime.h>
#include <cstdio>
#include <cstdint>

#define GAS __attribute__((address_space(1)))
#define LAS __attribute__((address_space(3)))
typedef unsigned short bf16;
typedef unsigned v4u __attribute__((ext_vector_type(4)));
typedef float f32x4 __attribute__((ext_vector_type(4)));
typedef float f32x2 __attribute__((ext_vector_type(2)));
typedef float f32x16 __attribute__((ext_vector_type(16)));
typedef short bf16x8 __attribute__((ext_vector_type(8)));
typedef short s16x4 __attribute__((ext_vector_type(4)));
typedef GAS unsigned gu32;

constexpr int DM = 2048, NBATCH = 4, SEQ = 4096, CTXL = 256, TPB = SEQ + CTXL  ;
constexpr int MROWS = NBATCH * TPB  , FF = 5632, NLAYER = 4, MODW = 6 * DM  ;
constexpr float EPS = 1e-6f;
constexpr float LOG2E = 1.4426950408889634f;

__device__ __forceinline__ unsigned cvt_pk_bf16(float lo, float hi) { unsigned r; asm volatile("v_cvt_pk_bf16_f32 %0, %1, %2" : "=v"(r) : "v"(lo), "v"(hi)); return r; }
__device__ __forceinline__ float bf2f(unsigned short h) { return __builtin_bit_cast(float, (unsigned)h << 16); }

namespace pg8 {
typedef unsigned short bf16_t;
constexpr int BM = 256, BK = 64, HALF = 128, HTB = HALF * BK * 2, STAGE_BYTES = 8 * HTB, NXCD = 8, WGM = 8;
__host__ __device__ __forceinline__ int lds_byte(int r, int c) { const int st = (r >> 4) * 2 + (c >> 5), rr = r & 15, cc = c & 31, ob = rr * 64 + cc * 2; return st * 1024 + (ob ^ (((ob >> 9) & 1) << 5)); }
__host__ __device__ __forceinline__ void stage_rc(int b, int& R, int& C) { const int st = b / 1024, sb = b % 1024, swz = sb ^ (((sb >> 9) & 1) << 5); R = (st >> 1) * 16 + swz / 64; C = (st & 1) * 32 + (swz % 64) / 2; }
__host__ __device__ __forceinline__ int perm32(int rho) { const int n = rho >> 4, i = rho & 15; return 8 * (i >> 2) + 4 * n + (i & 3); }

struct Unit { int pm, pn, ks, koff, nt; };
struct Gemm { const bf16_t* A; const bf16_t* Bt; int M, N, K, lda; };

struct StaticOrder {
    int nM, nN, nwg, G, c, ntK;
    __host__ __device__ void init(int M, int N, int K, int G_, int c_) { nM = M / BM; nN = N / BM; nwg = nM * nN; G = G_; c = c_; ntK = K / BK; }
    __host__ __device__ bool next(int i, Unit& u) const {
        const long L = (long)i * G + c; if (L >= nwg) return false;
        u.ks = -1; u.koff = 0; u.nt = ntK;
        int wgid = (int)L; { const int q = nwg / NXCD, r = nwg % NXCD, xcd = wgid % NXCD, off = wgid / NXCD; wgid = (xcd < r ? xcd * (q + 1) : r * (q + 1) + (xcd - r) * q) + off; }
        const int nig = WGM * nN, gid = wgid / nig, fm = gid * WGM, gsz = (nM - fm) < WGM ? (nM - fm) : WGM;
        u.pm = fm + ((wgid % nig) % gsz); u.pn = (wgid % nig) / gsz; return true;
    }
};
struct LatentOrder : StaticOrder {
    __host__ __device__ bool next(int i, Unit& u) const { if (!StaticOrder::next(i, u)) return false; u.pm = u.pm + (u.pm >> 4) + 1; return true; }
};
struct CtxSplitOrder : LatentOrder {
    int S, ntA, ntB;
    __host__ __device__ bool next(int i, Unit& u) const {
        if (LatentOrder::next(i, u)) return true;
        const long s = (long)i * G + c - nwg; if (s < 0 || s >= (long)4 * nN * S) return false;
        const int ks = (int)(s % S), t = (int)(s / S); u.pn = t % nN; u.pm = (t / nN) * 17; u.ks = ks;
        u.koff = ((ks >> 1) * (ntA + ntB) + (ks & 1) * ntA) * BK * 2; u.nt = (ks & 1) ? ntB : ntA; return true;
    }
};

__device__ __forceinline__ void rope2(f32x4& v, const f32x4 t) {
    const float a0 = v[0] * t[0] - v[1] * t[1], a1 = v[0] * t[1] + v[1] * t[0], a2 = v[2] * t[2] - v[3] * t[3], a3 = v[2] * t[3] + v[3] * t[2];
    v = (f32x4){a0, a1, a2, a3};
}
__device__ __forceinline__ v4u pack8(const f32x4 v0, const f32x4 v1) { v4u w; w.x = cvt_pk_bf16(v0[0], v0[1]); w.y = cvt_pk_bf16(v0[2], v0[3]); w.z = cvt_pk_bf16(v1[0], v1[1]); w.w = cvt_pk_bf16(v1[2], v1[3]); return w; }
struct EpiF32 {
    static constexpr bool PERM = true;
    bf16_t* O; int ldc; float* YP;
    __device__ __forceinline__ void operator()(const f32x4 (&acc)[2][2][4][2], const Unit& u, int wr, int wc, int fr, int fq) const {
        const int col0 = u.pn * BM + wc * 32 + 8 * fq;
        if (u.ks >= 0) { const int row0 = u.ks * 1024 + (u.pm / 17) * BM + wr * 64 + fr;
#pragma unroll
            for (int ai = 0; ai < 2; ++ai)
#pragma unroll
                for (int m = 0; m < 4; ++m) { GAS float* rowp = (GAS float*)YP + (size_t)(row0 + ai * HALF + m * 16) * ldc + col0;
#pragma unroll
                    for (int bj = 0; bj < 2; ++bj)
#pragma unroll
                        for (int n = 0; n < 2; ++n) *(GAS f32x4*)(rowp + bj * HALF + n * 4) = acc[ai][bj][m][n]; }
        } else { const int row0 = u.pm * BM + wr * 64 + fr;
#pragma unroll
            for (int ai = 0; ai < 2; ++ai)
#pragma unroll
                for (int m = 0; m < 4; ++m) { GAS bf16_t* rowp = (GAS bf16_t*)O + (size_t)(row0 + ai * HALF + m * 16) * ldc + col0;
#pragma unroll
                    for (int bj = 0; bj < 2; ++bj) *(GAS v4u*)(rowp + bj * HALF) = pack8(acc[ai][bj][m][0], acc[ai][bj][m][1]); }
        }
    }
};
struct EpiQKV {
    static constexpr bool PERM = true;
    bf16_t* O; int ldc, nq, nrope; float qscale; const float* tab;
    bf16_t* KH; bf16_t* VH; int nk, gv;
    __device__ __forceinline__ void operator()(const f32x4 (&acc)[2][2][4][2], const Unit& u, int wr, int wc, int fr, int fq) const {
        const int row0 = u.pm * BM + wr * 64 + fr, col0 = u.pn * BM + wc * 32 + 8 * fq;
        const float sc = (u.pn < nq) ? qscale : 1.f;
        const int pb = u.pm % 17; const bool rope = (u.pn < nrope) && (pb != 0);
        const GAS f32x4* T = (const GAS f32x4*)tab;
        const bool hm = (KH != nullptr) && (u.pn >= nq);
#pragma unroll
        for (int ai = 0; ai < 2; ++ai)
#pragma unroll
            for (int m = 0; m < 4; ++m) { const int row = row0 + ai * HALF + m * 16;
                const int pos = (wc < 2) ? (4 * (pb - 1) + 2 * ai + wr) : (16 * m + fr);
#pragma unroll
                for (int bj = 0; bj < 2; ++bj) { f32x4 v0 = acc[ai][bj][m][0] * sc, v1 = acc[ai][bj][m][1] * sc;
                    if (rope) { const int k0 = 8 * (wc & 1) + 2 * fq; rope2(v0, T[pos * 16 + k0]); rope2(v1, T[pos * 16 + k0 + 1]); }
                    GAS bf16_t* dst;
                    if (!hm) dst = (GAS bf16_t*)O + (size_t)row * ldc + col0 + bj * HALF;
                    else { const int ci = (u.pn - nq) * 2 + bj, cc = wc * 32 + 8 * fq;
                        if (ci < nk) dst = (GAS bf16_t*)KH + ((size_t)ci * MROWS + row) * 128 + cc;
                        else { const int cv = ci - nk, hd = cv / gv, part = cv - hd * gv; dst = (GAS bf16_t*)VH + ((size_t)hd * MROWS + row) * (128 * gv) + part * 128 + cc; } }
                    *(GAS v4u*)dst = pack8(v0, v1); } }
    }
};
struct EpiSwiGLU {
    static constexpr bool PERM = true;
    bf16_t* O; int ldc;
    __device__ __forceinline__ void operator()(const f32x4 (&acc)[2][2][4][2], const Unit& u, int wr, int wc, int fr, int fq) const {
        const int row0 = u.pm * BM + wr * 64 + fr, col0 = u.pn * HALF + wc * 32 + 8 * fq;
#pragma unroll
        for (int ai = 0; ai < 2; ++ai)
#pragma unroll
            for (int m = 0; m < 4; ++m) { GAS bf16_t* rowp = (GAS bf16_t*)O + (size_t)(row0 + ai * HALF + m * 16) * ldc + col0;
                f32x4 o[2];
#pragma unroll
                for (int n = 0; n < 2; ++n) { const f32x4 g = acc[ai][0][m][n], up = acc[ai][1][m][n];
#pragma unroll
                    for (int e = 0; e < 4; ++e) { const float s = __builtin_amdgcn_rcpf(1.f + __builtin_amdgcn_exp2f(-g[e] * LOG2E)); o[n][e] = g[e] * s * up[e]; } }
                *(GAS v4u*)rowp = pack8(o[0], o[1]); }
    }
};
struct EpiMlaDown {
    static constexpr bool PERM = true;
    bf16_t* C; bf16_t* KPE; float* SSQ; const float* tab64;
    __device__ __forceinline__ void operator()(const f32x4 (&acc)[2][2][4][2], const Unit& u, int wr, int wc, int fr, int fq) const {
        const int row0 = u.pm * BM + wr * 64 + fr; const int pb = u.pm % 17;
        if (u.pn < 4) {
            const int col0 = u.pn * BM + wc * 32 + 8 * fq;
#pragma unroll
            for (int ai = 0; ai < 2; ++ai)
#pragma unroll
                for (int m = 0; m < 4; ++m) { const int row = row0 + ai * HALF + m * 16; GAS bf16_t* rowp = (GAS bf16_t*)C + (size_t)row * 1024 + col0; float ss = 0.f;
#pragma unroll
                    for (int bj = 0; bj < 2; ++bj) { const f32x4 v0 = acc[ai][bj][m][0], v1 = acc[ai][bj][m][1];
                        ss += (v0[0] * v0[0] + v0[1] * v0[1]) + (v0[2] * v0[2] + v0[3] * v0[3]) + (v1[0] * v1[0] + v1[1] * v1[1]) + (v1[2] * v1[2] + v1[3] * v1[3]);
                        *(GAS v4u*)(rowp + bj * HALF) = pack8(v0, v1); }
                    ss += __shfl_xor(ss, 16); ss += __shfl_xor(ss, 32);
                    if (fq == 0) ((GAS float*)SSQ)[(size_t)row * 16 + u.pn * 4 + wc] = ss; }
        } else if (wc < 2) {
            const GAS f32x4* T = (const GAS f32x4*)tab64;
#pragma unroll
            for (int ai = 0; ai < 2; ++ai)
#pragma unroll
                for (int m = 0; m < 4; ++m) { const int row = row0 + ai * HALF + m * 16; f32x4 v0 = acc[ai][0][m][0], v1 = acc[ai][0][m][1];
                    if (pb != 0) { const int pos = (wc == 0) ? (4 * (pb - 1) + 2 * ai + wr) : (16 * m + fr); rope2(v0, T[pos * 8 + 2 * fq]); rope2(v1, T[pos * 8 + 2 * fq + 1]); }
                    *(GAS v4u*)((GAS bf16_t*)KPE + (size_t)row * 64 + wc * 32 + 8 * fq) = pack8(v0, v1); }
        }
    }
};
template <bool ROPE> struct EpiMlaUp {
    static constexpr bool PERM = true;
    bf16_t* O; int ldc; const float* SSQ; int which; float scale; const float* tab64;
    __device__ __forceinline__ void operator()(const f32x4 (&acc)[2][2][4][2], const Unit& u, int wr, int wc, int fr, int fq) const {
        const int row0 = u.pm * BM + wr * 64 + fr, col0 = u.pn * BM + wc * 32 + 8 * fq; const int pb = u.pm % 17;
        const GAS f32x4* T = (const GAS f32x4*)tab64;
#pragma unroll
        for (int ai = 0; ai < 2; ++ai)
#pragma unroll
            for (int m = 0; m < 4; ++m) { const int row = row0 + ai * HALF + m * 16; GAS bf16_t* rowp = (GAS bf16_t*)O + (size_t)row * ldc + col0;
                const GAS f32x4* sp = (const GAS f32x4*)((const GAS float*)SSQ + (size_t)row * 16 + which * 8); const f32x4 s0 = sp[0], s1 = sp[1];
                const float ss = ((s0[0] + s0[1]) + (s0[2] + s0[3])) + ((s1[0] + s1[1]) + (s1[2] + s1[3]));
                const float rs = __builtin_amdgcn_rsqf(ss * (1.f / 512.f) + EPS) * scale;
#pragma unroll
                for (int bj = 0; bj < 2; ++bj) { f32x4 v0 = acc[ai][bj][m][0] * rs, v1 = acc[ai][bj][m][1] * rs;
                    if (ROPE) { const int g = (u.pn * BM + bj * HALF + wc * 32) % 192;
                        if (g >= 128 && pb != 0) { const int pos = (g == 128) ? (4 * (pb - 1) + 2 * ai + wr) : (16 * m + fr); rope2(v0, T[pos * 8 + 2 * fq]); rope2(v1, T[pos * 8 + 2 * fq + 1]); } }
                    *(GAS v4u*)(rowp + bj * HALF) = pack8(v0, v1); } }
    }
};

template <class Epi, class Sched>
__device__ __forceinline__ void gemm_phase(LAS unsigned char* lds, const Gemm g, const Sched& S, const Epi& E, unsigned char* g_probe = nullptr) {
    const int tid = threadIdx.x, wid = __builtin_amdgcn_readfirstlane(tid >> 6), lane = tid & 63, wr = wid >> 2, wc = wid & 3, fr = lane & 15, fq = lane >> 4;
    const int K = g.K, lda = g.lda;
    unsigned voffA[2], voffB[2];
#pragma unroll
    for (int i = 0; i < 2; ++i) { int R, C; stage_rc(tid * 16 + i * 8192, R, C); const int Rb = Epi::PERM ? ((R & ~31) + perm32(R & 31)) : R;
        voffA[i] = (unsigned)(R * lda + C) * 2u; voffB[i] = (unsigned)(Rb * K + C) * 2u; }
    const size_t kstep = (size_t)(BK * 2);
    const size_t hsA = (size_t)HALF * lda * 2, hsB = (size_t)HALF * K * 2;
    const size_t tsA = 2 * hsA, tsB = 2 * hsB;
    const unsigned ldsw = (unsigned)wid * 1024u;
    const int aoff = lds_byte(wr * 64 + fr, fq * 8), boff = lds_byte(wc * 32 + fr, fq * 8);
#define PG8_SA(b, h) (((b) * 2 + (h)) * HTB)
#define PG8_SB(b, h) ((4 + (b) * 2 + (h)) * HTB)
#define PG8_STAGE(bufoff, gbase, voff) do { _Pragma("unroll") for (int _i = 0; _i < 2; ++_i) \
        __builtin_amdgcn_global_load_lds((const unsigned*)((const char*)(gbase) + (voff)[_i]), (LAS unsigned*)(lds + (bufoff) + ldsw + _i * 8192), 16, 0, 0); } while (0)
#define PG8_LDA(dst, b, h) do { _Pragma("unroll") for (int m = 0; m < 4; ++m) _Pragma("unroll") for (int k = 0; k < 2; ++k) dst[m][k] = *(const LAS bf16x8*)(lds + PG8_SA(b, h) + aoff + m * 2048 + k * 1024); } while (0)
#define PG8_LDB(dst, b, h) do { _Pragma("unroll") for (int n = 0; n < 2; ++n) _Pragma("unroll") for (int k = 0; k < 2; ++k) dst[n][k] = *(const LAS bf16x8*)(lds + PG8_SB(b, h) + boff + n * 2048 + k * 1024); } while (0)
#define PG8_MMA(ai, bj, At, Bt) do { __builtin_amdgcn_s_setprio(1); _Pragma("unroll") for (int m = 0; m < 4; ++m) _Pragma("unroll") for (int n = 0; n < 2; ++n) _Pragma("unroll") for (int k = 0; k < 2; ++k) \
        acc[ai][bj][m][n] = __builtin_amdgcn_mfma_f32_16x16x32_bf16(Bt[n][k], At[m][k], acc[ai][bj][m][n], 0, 0, 0); __builtin_amdgcn_s_setprio(0); } while (0)
#define PG8_WAIT_V(n) asm volatile("s_waitcnt vmcnt(" #n ")" ::: "memory")
#define PG8_WAIT_L(n) asm volatile("s_waitcnt lgkmcnt(" #n ")" ::: "memory")
#define PG8_BAR __builtin_amdgcn_s_barrier()
#define PG8_SCHED __builtin_amdgcn_sched_barrier(0)
    Unit cur, nxt; int ui = 0;
    if (!S.next(0, cur)) return;
    f32x4 acc[2][2][4][2];
#pragma unroll
    for (int a = 0; a < 2; ++a)
#pragma unroll
        for (int b = 0; b < 2; ++b)
#pragma unroll
            for (int m = 0; m < 4; ++m)
#pragma unroll
                for (int n = 0; n < 2; ++n) acc[a][b][m][n] = (f32x4){0.f, 0.f, 0.f, 0.f};
    bf16x8 At[4][2], B0[2][2], B1[2][2];
    const char* cA = (const char*)g.A + (size_t)cur.pm * tsA + cur.koff; const char* cB = (const char*)g.Bt + (size_t)cur.pn * tsB + cur.koff;
    PG8_STAGE(PG8_SB(0, 0), cB, voffB); PG8_STAGE(PG8_SB(0, 1), cB + hsB, voffB); PG8_STAGE(PG8_SA(0, 0), cA, voffA); PG8_STAGE(PG8_SA(0, 1), cA + hsA, voffA);
    if (wr == 1) PG8_BAR;
    PG8_WAIT_V(2); PG8_BAR;
    PG8_STAGE(PG8_SB(1, 0), cB + kstep, voffB); PG8_STAGE(PG8_SA(1, 0), cA + kstep, voffA); PG8_STAGE(PG8_SB(1, 1), cB + hsB + kstep, voffB);
    PG8_WAIT_V(6); PG8_BAR;
    for (;;) {
        const bool has_next = S.next(ui + 1, nxt);
        const char* nA = has_next ? (const char*)g.A + (size_t)nxt.pm * tsA + nxt.koff : cA; const char* nB = has_next ? (const char*)g.Bt + (size_t)nxt.pn * tsB + nxt.koff : cB;
        const int nt = cur.nt;
        for (int t = 0; t < nt; t += 2) {
            const bool last = (t == nt - 2);
            const char* a1 = cA + (size_t)(t + 1) * kstep;
            const char* a2 = last ? nA : cA + (size_t)(t + 2) * kstep; const char* b2 = last ? nB : cB + (size_t)(t + 2) * kstep;
            const char* a3 = a2 + kstep; const char* b3 = b2 + kstep;
            PG8_LDB(B0, 0, 0); PG8_LDB(B1, 0, 1); PG8_SCHED; PG8_LDA(At, 0, 0); PG8_STAGE(PG8_SA(1, 1), a1 + hsA, voffA);
            PG8_WAIT_V(8); PG8_WAIT_L(0); PG8_BAR; PG8_MMA(0, 0, At, B0); PG8_MMA(0, 1, At, B1); PG8_BAR; PG8_SCHED;
            PG8_LDA(At, 0, 1); PG8_STAGE(PG8_SB(0, 0), b2, voffB); PG8_STAGE(PG8_SB(0, 1), b2 + hsB, voffB); PG8_STAGE(PG8_SA(0, 0), a2, voffA);
            PG8_WAIT_V(8); PG8_WAIT_L(0); PG8_BAR; PG8_MMA(1, 0, At, B0); PG8_MMA(1, 1, At, B1); PG8_BAR; PG8_SCHED;
            PG8_LDB(B0, 1, 0); PG8_LDB(B1, 1, 1); PG8_SCHED; PG8_LDA(At, 1, 0); PG8_STAGE(PG8_SA(0, 1), a2 + hsA, voffA);
            PG8_WAIT_V(8); PG8_WAIT_L(0); PG8_BAR; PG8_MMA(0, 0, At, B0); PG8_MMA(0, 1, At, B1); PG8_BAR; PG8_SCHED;
            PG8_LDA(At, 1, 1); PG8_STAGE(PG8_SB(1, 0), b3, voffB); PG8_STAGE(PG8_SB(1, 1), b3 + hsB, voffB); PG8_STAGE(PG8_SA(1, 0), a3, voffA);
            PG8_WAIT_V(8); PG8_WAIT_L(0); PG8_BAR; PG8_MMA(1, 0, At, B0); PG8_MMA(1, 1, At, B1); PG8_BAR; PG8_SCHED;
        }
#ifdef PROBE_EPI
        unsigned long long te0_ = __builtin_amdgcn_s_memrealtime();
#endif
        if (wr == 0) PG8_BAR;
        E(acc, cur, wr, wc, fr, fq);
#ifdef PROBE_EPI
        if (PROBE_EPI == 1) asm volatile("s_waitcnt vmcnt(0)" ::: "memory");
        if (blockIdx.x == 0 && tid == 0 && g_probe) { GAS unsigned long long* tw = (GAS unsigned long long*)g_probe; tw[5] += __builtin_amdgcn_s_memrealtime() - te0_; }
#endif
        if (!has_next) break;
#pragma unroll
        for (int a = 0; a < 2; ++a)
#pragma unroll
            for (int b = 0; b < 2; ++b)
#pragma unroll
                for (int m = 0; m < 4; ++m)
#pragma unroll
                    for (int n = 0; n < 2; ++n) acc[a][b][m][n] = (f32x4){0.f, 0.f, 0.f, 0.f};
        cur = nxt; cA = nA; cB = nB; ++ui;
        if (wr == 1) PG8_BAR;
    }
    PG8_WAIT_V(0);
    PG8_BAR;
#undef PG8_SA
#undef PG8_SB
#undef PG8_STAGE
#undef PG8_LDA
#undef PG8_LDB
#undef PG8_MMA
#undef PG8_WAIT_V
#undef PG8_WAIT_L
#undef PG8_BAR
#undef PG8_SCHED
}
}
namespace attn {
constexpr int NW = 8, QBLK = 32, KVBLK = 64;
constexpr int SHM_V = KVBLK * 128 * 2, SHM_K = KVBLK * 128 * 2, SHM_K2 = KVBLK * 64 * 2;
constexpr int L_V = 0, L_K = 2 * SHM_V, L_K2 = L_K + 2 * SHM_K, L_WS = L_K2 + 2 * SHM_K2, L_RPB = L_WS + NW * 64 * 4, L_Q2 = L_RPB + 2048, L_END = L_Q2 + NW * 4096;
constexpr float THR = 8.f;
#define KSWF(row) ((((row) & 7) | ((((row) >> 4) & 1) << 3)))
#define KSWZ(row, colB) ((row) * 256 + ((colB) ^ (KSWF(row) << 4)))
#define K2SWF(row) (((((row) >> 1) & 3) | ((((row) >> 4) & 1) << 2)))
#define K2SWZ(row, colB) ((row) * 128 + ((colB) ^ (K2SWF(row) << 4)))
#define SBAR() __builtin_amdgcn_sched_barrier(0)
__device__ __forceinline__ int crow(int r, int hi) { return (r & 3) + 8 * (r >> 2) + 4 * hi; }

struct Desc {
    const bf16* Q; const bf16* K; const bf16* V; const bf16* K2; bf16* O;
    int ldq, ldk, ldv, ldo;
    int row_ctx, row_lat;
    int NT, NTreal;
    float m0, l0;
    int a0, a1;
    const float* rpb;
    unsigned char* probe;
    const bf16* O1; float lam;
    int rot;
};

__device__ __forceinline__ void partialSM(f32x16& p0, f32x16& p1, float& m_reg, float& mn, float& alpha) {
  constexpr float C = LOG2E;
  float pmax = p0[0];
#pragma unroll
  for (int r = 1; r < 16; ++r) pmax = fmaxf(pmax, p0[r]);
#pragma unroll
  for (int r = 0; r < 16; ++r) pmax = fmaxf(pmax, p1[r]);
  { auto rr = __builtin_amdgcn_permlane32_swap(__float_as_uint(pmax), __float_as_uint(pmax), false, false);
    pmax = fmaxf(__uint_as_float(rr[0]), __uint_as_float(rr[1])); }
  if (__builtin_expect(__all(pmax - m_reg <= THR), 1)) { mn = m_reg; alpha = 1.f; }
  else { mn = fmaxf(m_reg, pmax); alpha = __builtin_amdgcn_exp2f((m_reg - mn) * C); m_reg = mn; }
  float mnC = -mn * C;
#pragma unroll
  for (int r = 0; r < 16; ++r) p0[r] = fmaf(p0[r], C, mnC);
#pragma unroll
  for (int r = 0; r < 16; ++r) p1[r] = fmaf(p1[r], C, mnC);
#pragma unroll
  for (int r = 0; r < 16; ++r) p0[r] = __builtin_amdgcn_exp2f(p0[r]);
}
__device__ __forceinline__ void finishSM(f32x16& p0, f32x16& p1, float alpha, float& l_reg, bf16x8& pa0, bf16x8& pa1, bf16x8& pa2, bf16x8& pa3) {
#pragma unroll
  for (int r = 0; r < 16; ++r) p1[r] = __builtin_amdgcn_exp2f(p1[r]);
  float ps = 0;
#pragma unroll
  for (int r = 0; r < 16; ++r) ps += p0[r];
#pragma unroll
  for (int r = 0; r < 16; ++r) ps += p1[r];
  { auto rr = __builtin_amdgcn_permlane32_swap(__float_as_uint(ps), __float_as_uint(ps), false, false);
    ps = __uint_as_float(rr[0]) + __uint_as_float(rr[1]); }
  l_reg = l_reg * alpha + ps;
#define PK4(P, BASE, OUT) do { unsigned a0 = cvt_pk_bf16(P[BASE + 0], P[BASE + 1]), a1 = cvt_pk_bf16(P[BASE + 2], P[BASE + 3]);   \
    unsigned b0 = cvt_pk_bf16(P[BASE + 4], P[BASE + 5]), b1 = cvt_pk_bf16(P[BASE + 6], P[BASE + 7]);                              \
    auto r0 = __builtin_amdgcn_permlane32_swap(a0, b0, false, false); auto r1 = __builtin_amdgcn_permlane32_swap(a1, b1, false, false); \
    v4u w = {r0[0], r1[0], r0[1], r1[1]}; OUT = __builtin_bit_cast(bf16x8, w); } while (0)
  PK4(p0, 0, pa0); PK4(p0, 8, pa1); PK4(p1, 0, pa2); PK4(p1, 8, pa3);
#undef PK4
}
template <bool K2, int NQR>
__device__ __forceinline__ void qkt(f32x16& p0, f32x16& p1, const LAS char* Ks, const LAS char* K2s, const bf16x8* qr, const LAS char* q2l, int r32, int hi) {
  p0 = f32x16{}; p1 = f32x16{};
#pragma unroll
  for (int d0 = 0; d0 < 8; ++d0) { int cb = (d0 * 16 + hi * 8) * 2;
    bf16x8 b0 = *(const LAS bf16x8*)(Ks + KSWZ(r32, cb));
    bf16x8 b1 = *(const LAS bf16x8*)(Ks + KSWZ(32 + r32, cb));
    bf16x8 q; if constexpr (true) { if (d0 < NQR) q = qr[d0 < NQR ? d0 : 0]; else q = *(const LAS bf16x8*)(q2l + (d0 - NQR) * 1024); }
    p0 = __builtin_amdgcn_mfma_f32_32x32x16_bf16(b0, q, p0, 0, 0, 0);
    p1 = __builtin_amdgcn_mfma_f32_32x32x16_bf16(b1, q, p1, 0, 0, 0); }
  if constexpr (K2) {
#pragma unroll
    for (int d0 = 0; d0 < 4; ++d0) { int cb = (d0 * 16 + hi * 8) * 2;
      bf16x8 b0 = *(const LAS bf16x8*)(K2s + K2SWZ(r32, cb));
      bf16x8 b1 = *(const LAS bf16x8*)(K2s + K2SWZ(32 + r32, cb));
      const bf16x8 q2 = *(const LAS bf16x8*)(q2l + (8 - NQR + d0) * 1024);
      p0 = __builtin_amdgcn_mfma_f32_32x32x16_bf16(b0, q2, p0, 0, 0, 0);
      p1 = __builtin_amdgcn_mfma_f32_32x32x16_bf16(b1, q2, p1, 0, 0, 0); }
  }
}
__device__ __forceinline__ int v_st(int k, int c) { const int kk = (k & ~0xC) | ((k & 4) << 1) | ((k & 8) >> 1); return ((kk >> 3) * 4 + (c >> 5)) * 512 + ((kk & 7) * 32 + (c & 31)) * 2; }
__device__ __forceinline__ int v_rd_base(int lane) { return ((lane & 3) << 3) | (((lane >> 2) & 3) << 6) | (((lane >> 4) & 1) << 5) | (((lane >> 5) & 1) << 8); }
constexpr int v_rd_off(int d0, int ks, int half) { return d0 * 512 + ks * 4096 + half * 2048; }
template <int OFF> __device__ __forceinline__ s16x4 tr_read(int vb) {
  s16x4 r; asm volatile("ds_read_b64_tr_b16 %0, %1 offset:%2" : "=&v"(r) : "v"(vb), "i"(OFF) : "memory"); return r;
}
template <int D0> __device__ __forceinline__ void pv_one(f32x16& od, int vb, bf16x8 pa0, bf16x8 pa1, bf16x8 pa2, bf16x8 pa3) {
  const s16x4 l0 = tr_read<v_rd_off(D0, 0, 0)>(vb), h0 = tr_read<v_rd_off(D0, 0, 1)>(vb), l1 = tr_read<v_rd_off(D0, 1, 0)>(vb), h1 = tr_read<v_rd_off(D0, 1, 1)>(vb);
  const s16x4 l2 = tr_read<v_rd_off(D0, 2, 0)>(vb), h2 = tr_read<v_rd_off(D0, 2, 1)>(vb), l3 = tr_read<v_rd_off(D0, 3, 0)>(vb), h3 = tr_read<v_rd_off(D0, 3, 1)>(vb);
  asm volatile("s_waitcnt lgkmcnt(0)" ::: "memory"); SBAR();
#define PK(L, H) (bf16x8){L[0], L[1], L[2], L[3], H[0], H[1], H[2], H[3]}
  od = __builtin_amdgcn_mfma_f32_32x32x16_bf16(pa0, PK(l0, h0), od, 0, 0, 0);
  od = __builtin_amdgcn_mfma_f32_32x32x16_bf16(pa1, PK(l1, h1), od, 0, 0, 0);
  od = __builtin_amdgcn_mfma_f32_32x32x16_bf16(pa2, PK(l2, h2), od, 0, 0, 0);
  od = __builtin_amdgcn_mfma_f32_32x32x16_bf16(pa3, PK(l3, h3), od, 0, 0, 0);
#undef PK
}
__device__ __forceinline__ void pv_d0(f32x16* o, int vb, bf16x8 pa0, bf16x8 pa1, bf16x8 pa2, bf16x8 pa3) {
  pv_one<0>(o[0], vb, pa0, pa1, pa2, pa3); pv_one<1>(o[1], vb, pa0, pa1, pa2, pa3); pv_one<2>(o[2], vb, pa0, pa1, pa2, pa3); pv_one<3>(o[3], vb, pa0, pa1, pa2, pa3);
}
__device__ __forceinline__ void qkt_pf(f32x16& p0, f32x16& p1, const LAS char* Ks, const bf16x8* qr, int r32, int hi) {
  bf16x8 kf[16];
#pragma unroll
  for (int d0 = 0; d0 < 8; ++d0) { const int cb = (d0 * 16 + hi * 8) * 2; kf[2 * d0] = *(const LAS bf16x8*)(Ks + KSWZ(r32, cb)); kf[2 * d0 + 1] = *(const LAS bf16x8*)(Ks + KSWZ(32 + r32, cb)); }
  SBAR();
  p0 = f32x16{}; p1 = f32x16{};
#pragma unroll
  for (int d0 = 0; d0 < 8; ++d0) { p0 = __builtin_amdgcn_mfma_f32_32x32x16_bf16(kf[2 * d0], qr[d0], p0, 0, 0, 0); p1 = __builtin_amdgcn_mfma_f32_32x32x16_bf16(kf[2 * d0 + 1], qr[d0], p1, 0, 0, 0); }
}
template <int D0> __device__ __forceinline__ void vfrag(s16x4 (&f)[8], int vb) {
  f[0] = tr_read<v_rd_off(D0, 0, 0)>(vb); f[1] = tr_read<v_rd_off(D0, 0, 1)>(vb); f[2] = tr_read<v_rd_off(D0, 1, 0)>(vb); f[3] = tr_read<v_rd_off(D0, 1, 1)>(vb);
  f[4] = tr_read<v_rd_off(D0, 2, 0)>(vb); f[5] = tr_read<v_rd_off(D0, 2, 1)>(vb); f[6] = tr_read<v_rd_off(D0, 3, 0)>(vb); f[7] = tr_read<v_rd_off(D0, 3, 1)>(vb);
}
__device__ __forceinline__ void pv4(f32x16& od, const s16x4 (&f)[8], bf16x8 pa0, bf16x8 pa1, bf16x8 pa2, bf16x8 pa3) {
#define PK(L, H) (bf16x8){L[0], L[1], L[2], L[3], H[0], H[1], H[2], H[3]}
  od = __builtin_amdgcn_mfma_f32_32x32x16_bf16(pa0, PK(f[0], f[1]), od, 0, 0, 0);
  od = __builtin_amdgcn_mfma_f32_32x32x16_bf16(pa1, PK(f[2], f[3]), od, 0, 0, 0);
  od = __builtin_amdgcn_mfma_f32_32x32x16_bf16(pa2, PK(f[4], f[5]), od, 0, 0, 0);
  od = __builtin_amdgcn_mfma_f32_32x32x16_bf16(pa3, PK(f[6], f[7]), od, 0, 0, 0);
#undef PK
}
__device__ __forceinline__ void pv_pipe(f32x16* o, int vb, bf16x8 pa0, bf16x8 pa1, bf16x8 pa2, bf16x8 pa3) {
  s16x4 fa[8], fb[8];
  vfrag<0>(fa, vb); SBAR();
  vfrag<1>(fb, vb); asm volatile("s_waitcnt lgkmcnt(8)" ::: "memory"); SBAR(); pv4(o[0], fa, pa0, pa1, pa2, pa3); SBAR();
  vfrag<2>(fa, vb); asm volatile("s_waitcnt lgkmcnt(8)" ::: "memory"); SBAR(); pv4(o[1], fb, pa0, pa1, pa2, pa3); SBAR();
  vfrag<3>(fb, vb); asm volatile("s_waitcnt lgkmcnt(8)" ::: "memory"); SBAR(); pv4(o[2], fa, pa0, pa1, pa2, pa3); SBAR();
  asm volatile("s_waitcnt lgkmcnt(0)" ::: "memory"); SBAR(); pv4(o[3], fb, pa0, pa1, pa2, pa3);
}
#define PV_PIPE_HOOKS(o_, vb_, pa0, pa1, pa2, pa3, H0, H1, H2, H3) do { s16x4 fa_[8], fb_[8]; \
  vfrag<0>(fa_, vb_); SBAR(); \
  vfrag<1>(fb_, vb_); asm volatile("s_waitcnt lgkmcnt(8)" ::: "memory"); SBAR(); pv4((o_)[0], fa_, pa0, pa1, pa2, pa3); H0; SBAR(); \
  vfrag<2>(fa_, vb_); asm volatile("s_waitcnt lgkmcnt(8)" ::: "memory"); SBAR(); pv4((o_)[1], fb_, pa0, pa1, pa2, pa3); H1; SBAR(); \
  vfrag<3>(fb_, vb_); asm volatile("s_waitcnt lgkmcnt(8)" ::: "memory"); SBAR(); pv4((o_)[2], fa_, pa0, pa1, pa2, pa3); H2; SBAR(); \
  asm volatile("s_waitcnt lgkmcnt(0)" ::: "memory"); SBAR(); pv4((o_)[3], fb_, pa0, pa1, pa2, pa3); H3; SBAR(); } while (0)
template <int MODE>
__device__ __forceinline__ void mask_tile(f32x16& p0, f32x16& p1, const Desc& d, int j, int wid, int r32, int hi, const LAS float* rpbL) {
  if constexpr (MODE == 1) {
    if (j >= 4) { const int base = d.a0 + 64 * (j - 4) - (wid * 32 + r32);
#pragma unroll
      for (int r = 0; r < 16; ++r) { const int dd = base + crow(r, hi); if (dd > 128 || dd < -128) p0[r] = -1e30f; if (dd + 32 > 128 || dd + 32 < -128) p1[r] = -1e30f; } }
  } else if constexpr (MODE == 2) {
    if (j >= 4) {
      const int kr = d.a0 + (j - 4), qr_ = d.a1 + (wid >> 1), c = 32 * (wid & 1) + r32;
      int r0 = qr_ - 4; r0 = r0 < 0 ? 0 : (r0 > 56 ? 56 : r0); int c0 = c - 8; c0 = c0 < 0 ? 0 : (c0 > 48 ? 48 : c0);
      asm volatile("" : "+v"(c0));
      const bool rv = (j < d.NTreal) && (kr >= r0) && (kr < r0 + 8);
      if (!rv) {
#pragma unroll
        for (int r = 0; r < 16; ++r) { p0[r] = -1e30f; p1[r] = -1e30f; }
      } else { const LAS float* brow = rpbL + (kr - qr_ + 7) * 31 + (15 - c);
#pragma unroll
        for (int rc = 0; rc < 16; rc += 4) {
#pragma unroll
          for (int r = rc; r < rc + 4; ++r) { const int k0 = crow(r, hi), k1 = k0 + 32; const bool ok0 = (unsigned)(k0 - c0) < 16u, ok1 = (unsigned)(k1 - c0) < 16u;
            const float b0 = brow[ok0 ? k0 : c], b1 = brow[ok1 ? k1 : c];
            p0[r] = ok0 ? p0[r] + b0 : -1e30f; p1[r] = ok1 ? p1[r] + b1 : -1e30f; }
          SBAR(); } }
    }
  }
}

template <int MODE, bool K2, int SDEPTH, int NQR>
__device__ __forceinline__ void unit(const Desc& d, LAS char* lds) {
  static_assert((K2 ? 12 : 8) - NQR <= 4, "at most four Q fragments live in LDS");
  const int tid = threadIdx.x, wid = __builtin_amdgcn_readfirstlane(tid >> 6), lane = tid & 63, r32 = lane & 31, hi = lane >> 5;
  LAS char* V_lds = lds + L_V; LAS char* K_lds = lds + L_K; LAS char* K2_lds = lds + L_K2;
  LAS float* ws = (LAS float*)(lds + L_WS) + wid * 64; LAS float* li_l = ws; LAS float* al_l = ws + 32;
  LAS float* rpbL = (LAS float*)(lds + L_RPB);
  if constexpr (MODE == 2) { if (tid < 465) rpbL[tid] = ((const GAS float*)d.rpb)[tid]; }
  float m_reg = d.m0, l_reg = d.l0; f32x16 o[4] = {}; bf16x8 qr[NQR];
  LAS char* q2l = lds + L_Q2 + wid * 4096 + lane * 16;
  { const GAS bf16* Qw = (const GAS bf16*)d.Q + (long)(wid * QBLK + r32) * d.ldq + hi * 8;
#pragma unroll
    for (int d0 = 0; d0 < NQR; ++d0) qr[d0] = *(const GAS bf16x8*)(Qw + d0 * 16);
#pragma unroll
    for (int d0 = NQR; d0 < (K2 ? 12 : 8); ++d0) *(LAS bf16x8*)(q2l + (d0 - NQR) * 1024) = *(const GAS bf16x8*)(Qw + d0 * 16); }
  const int sr = tid >> 4, sc = (tid & 15) * 8, vst0 = v_st(sr, sc), vst1 = v_st(32 + sr, sc);
  const int vb0 = (int)(unsigned)(uintptr_t)V_lds + v_rd_base(lane);
  const GAS bf16* Kp = (const GAS bf16*)d.K + (long)sr * d.ldk + sc; const GAS bf16* Vp = (const GAS bf16*)d.V + (long)sr * d.ldv + sc;
  const GAS bf16* K2p = K2 ? (const GAS bf16*)d.K2 + (long)(tid >> 3) * 64 + (tid & 7) * 8 : nullptr;
  const int k2st = K2SWZ(tid >> 3, (tid & 7) * 16);
  struct { bf16x8 vs0, vs1, ks0, ks1, k2; } sr_[SDEPTH];
  const int NT = d.NT, NTr = d.NTreal;
#define TROW(j) ((j) < 4 ? d.row_ctx + 64 * (j) : d.row_lat + 64 * (((j) < NTr ? (j) : NTr - 1) - 4))
#define SLOAD(i, j) do { const long kr_ = TROW(j); sr_[i].vs0 = *(const GAS bf16x8*)(Vp + kr_ * d.ldv); sr_[i].vs1 = *(const GAS bf16x8*)(Vp + (kr_ + 32) * d.ldv); \
    sr_[i].ks0 = *(const GAS bf16x8*)(Kp + kr_ * d.ldk); sr_[i].ks1 = *(const GAS bf16x8*)(Kp + (kr_ + 32) * d.ldk); \
    if constexpr (K2) sr_[i].k2 = *(const GAS bf16x8*)(K2p + kr_ * 64); } while (0)
#define SWRITE(b, i) do { *(LAS bf16x8*)(V_lds + (b) * SHM_V + vst0) = sr_[i].vs0; *(LAS bf16x8*)(V_lds + (b) * SHM_V + vst1) = sr_[i].vs1; const int kc = sc * 2; \
    *(LAS bf16x8*)(K_lds + (b) * SHM_K + KSWZ(sr, kc)) = sr_[i].ks0; *(LAS bf16x8*)(K_lds + (b) * SHM_K + KSWZ(32 + sr, kc)) = sr_[i].ks1; \
    if constexpr (K2) *(LAS bf16x8*)(K2_lds + (b) * SHM_K2 + k2st) = sr_[i].k2; } while (0)
#define SWAIT() do { if constexpr (SDEPTH == 2) asm volatile("s_waitcnt vmcnt(4)" ::: "memory"); else asm volatile("s_waitcnt vmcnt(0)" ::: "memory"); } while (0)
#define RESC(a) do { if (__any((a) < 1.f)) { if (hi == 0) al_l[r32] = (a); asm volatile("s_waitcnt lgkmcnt(0)" ::: "memory"); \
    _Pragma("unroll") for (int dd = 0; dd < 4; ++dd) _Pragma("unroll") for (int r = 0; r < 16; ++r) o[dd][r] *= al_l[crow(r, hi)]; } } while (0)
  f32x16 pA0, pA1, pB0, pB1; float mnA, mnB, alA, alB; bf16x8 pa0, pa1, pa2, pa3;
  constexpr int SE = 0, SO = SDEPTH - 1;
  SLOAD(SE, 0); asm volatile("s_waitcnt vmcnt(0)" ::: "memory"); SWRITE(0, SE); __syncthreads();
  qkt<K2, NQR>(pA0, pA1, K_lds, K2_lds, qr, q2l, r32, hi); partialSM(pA0, pA1, m_reg, mnA, alA);
  SLOAD(SO, 1); if constexpr (SDEPTH == 2) { if (2 < NT) SLOAD(SE, 2); }
  SWAIT(); SWRITE(1, SO); __syncthreads();
  for (int j = 1; j + 1 < NT; j += 2) {
    SBAR(); qkt<K2, NQR>(pB0, pB1, K_lds + SHM_K, K2_lds + SHM_K2, qr, q2l, r32, hi);
    finishSM(pA0, pA1, alA, l_reg, pa0, pa1, pa2, pa3); SBAR();
    SLOAD(SO, j + SDEPTH); SBAR();
    pv_d0(o, vb0, pa0, pa1, pa2, pa3); if constexpr (MODE != 0) { SBAR(); mask_tile<MODE>(pB0, pB1, d, j, wid, r32, hi, rpbL); SBAR(); } partialSM(pB0, pB1, m_reg, mnB, alB);
    __syncthreads(); SWAIT(); SWRITE(0, SE);
    RESC(alB); __syncthreads();
    SBAR(); qkt<K2, NQR>(pA0, pA1, K_lds, K2_lds, qr, q2l, r32, hi);
    finishSM(pB0, pB1, alB, l_reg, pa0, pa1, pa2, pa3); SBAR();
    if (SDEPTH == 1 || j + 3 < NT) SLOAD(SE, j + 1 + SDEPTH); SBAR();
    pv_d0(o, vb0 + SHM_V, pa0, pa1, pa2, pa3); if constexpr (MODE != 0) { SBAR(); mask_tile<MODE>(pA0, pA1, d, j + 1, wid, r32, hi, rpbL); SBAR(); } partialSM(pA0, pA1, m_reg, mnA, alA);
    __syncthreads(); SWAIT(); SWRITE(1, SO);
    RESC(alA); __syncthreads();
  }
  SBAR(); qkt<K2, NQR>(pB0, pB1, K_lds + SHM_K, K2_lds + SHM_K2, qr, q2l, r32, hi);
  finishSM(pA0, pA1, alA, l_reg, pa0, pa1, pa2, pa3); SBAR();
  pv_d0(o, vb0, pa0, pa1, pa2, pa3); if constexpr (MODE != 0) { SBAR(); mask_tile<MODE>(pB0, pB1, d, NT - 1, wid, r32, hi, rpbL); SBAR(); } partialSM(pB0, pB1, m_reg, mnB, alB);
  __syncthreads(); RESC(alB);
  finishSM(pB0, pB1, alB, l_reg, pa0, pa1, pa2, pa3); SBAR();
  pv_d0(o, vb0 + SHM_V, pa0, pa1, pa2, pa3);
  if (hi == 0) li_l[r32] = l_reg; asm volatile("s_waitcnt lgkmcnt(0)" ::: "memory");
  float rli[16];
#pragma unroll
  for (int r = 0; r < 16; ++r) rli[r] = __builtin_amdgcn_rcpf(li_l[crow(r, hi)]);
#pragma unroll
  for (int d0 = 0; d0 < 4; ++d0)
#pragma unroll
    for (int r = 0; r < 16; ++r) o[d0][r] *= rli[r];
  SBAR();
  GAS bf16* Ow = (GAS bf16*)d.O + (long)(wid * QBLK) * d.ldo;
  { int lo_ = lane; asm volatile("" : "+v"(lo_));
    LAS bf16* stg = (LAS bf16*)(K_lds + wid * 4096);
#pragma unroll
    for (int g = 0; g < 2; ++g) { SBAR();
#pragma unroll
      for (int r = 0; r < 16; ++r) { const int orow = crow(r, hi); const float x0 = o[2 * g][r], x1 = o[2 * g + 1][r];
        stg[orow * 64 + r32] = (bf16)(cvt_pk_bf16(x0, x0) & 0xffffu); stg[orow * 64 + 32 + r32] = (bf16)(cvt_pk_bf16(x1, x1) & 0xffffu); }
      asm volatile("s_waitcnt lgkmcnt(0)" ::: "memory");
#pragma unroll
      for (int q = 0; q < 4; ++q) { const int idx = q * 64 + lo_, row = idx >> 3, ch = idx & 7; const v4u v = *(const LAS v4u*)(stg + row * 64 + ch * 8);
        *(GAS v4u*)(Ow + (long)row * d.ldo + g * 64 + ch * 8) = v; }
      asm volatile("s_waitcnt lgkmcnt(0)" ::: "memory"); } }
  __syncthreads();
#undef TROW
#undef SLOAD
#undef SWRITE
#undef SWAIT
#undef RESC
}
constexpr int X_V = 0, X_K = 4 * SHM_V, X_P = X_K + 3 * SHM_K, X_WS = X_P + 4 * 4096, X_END = X_WS + NW * 64 * 4;
template <bool COMB>
__device__ __forceinline__ void unit_split(const Desc& d, LAS char* lds) {
  const int tid = threadIdx.x, wid = __builtin_amdgcn_readfirstlane(tid >> 6), lane = tid & 63, r32 = lane & 31, hi = lane >> 5;
  const bool isS = wid < 4; const int w4 = wid & 3;
  LAS char* V_lds = lds + X_V; LAS char* K_lds = lds + X_K; LAS char* P_l = lds + X_P + w4 * 4096 + lane * 16;
  LAS float* wsS = (LAS float*)(lds + X_WS) + w4 * 64; LAS float* al_l = wsS; LAS float* li_l = wsS + 32;
  volatile LAS unsigned* flag = (volatile LAS unsigned*)((LAS float*)(lds + X_WS) + (w4 + 4) * 64);
  const int NT = d.NT;
#define KOFF(i, L) ((4 * (w4 + 4 * (i)) + ((L) >> 4)) * d.ldk + ((((L) & 15) ^ KSWF(4 * (w4 + 4 * (i)) + ((L) >> 4))) * 8))
#define VKK(i, L) (((w4 + 4 * (i)) >> 1) * 8 + (((L) & 31) >> 2))
#define VOFF(i, L) (((VKK(i, L) & ~0xC) | ((VKK(i, L) & 4) << 1) | ((VKK(i, L) & 8) >> 1)) * d.ldv + ((w4 + 4 * (i)) & 1) * 64 + ((L) >> 5) * 32 + ((L) & 3) * 8)
#define TROT(j) (((j) + d.rot) >= NT ? ((j) + d.rot) - NT : ((j) + d.rot))
#define TROW(j) (TROT(j) < 4 ? d.row_ctx + 64 * TROT(j) : d.row_lat + 64 * (TROT(j) - 4))
#define GLDS(src, dst) __builtin_amdgcn_global_load_lds((const unsigned*)(src), (LAS unsigned*)(dst), 16, 0, 0)
#define KDMA(j) do { int L_ = lane; asm volatile("" : "+v"(L_)); const GAS bf16* kp_ = (const GAS bf16*)d.K + (long)TROW(j) * d.ldk; LAS char* kb_ = K_lds + ((j) % 3) * SHM_K + w4 * 1024; \
    GLDS(kp_ + KOFF(0, L_), kb_); GLDS(kp_ + KOFF(1, L_), kb_ + 4096); GLDS(kp_ + KOFF(2, L_), kb_ + 8192); GLDS(kp_ + KOFF(3, L_), kb_ + 12288); } while (0)
#define VDMA(j) do { int L_ = lane; asm volatile("" : "+v"(L_)); const GAS bf16* vp_ = (const GAS bf16*)d.V + (long)TROW(j) * d.ldv; LAS char* vb_ = V_lds + ((j) & 1) * 2 * SHM_V + w4 * 1024; \
    _Pragma("unroll") for (int i_ = 0; i_ < 4; ++i_) { const int v_ = VOFF(i_, L_); GLDS(vp_ + v_, vb_ + i_ * 4096); GLDS(vp_ + 128 + v_, vb_ + SHM_V + i_ * 4096); } } while (0)
#define VPIECE(j, i) do { int L_ = lane; asm volatile("" : "+v"(L_)); const GAS bf16* vp_ = (const GAS bf16*)d.V + (long)TROW(j) * d.ldv + ((i) & 1) * 128; \
    GLDS(vp_ + VOFF((i) >> 1, L_), V_lds + ((j) & 1) * 2 * SHM_V + ((i) & 1) * SHM_V + w4 * 1024 + ((i) >> 1) * 4096); } while (0)
#define WAITV(n) asm volatile("s_waitcnt vmcnt(" #n ")" ::: "memory")
#define BAR() asm volatile("s_waitcnt lgkmcnt(0)\n\ts_barrier" ::: "memory")
#define KBUF(j) (K_lds + ((j) % 3) * SHM_K)
#define VOFS(j) (((j) & 1) * 2 * SHM_V)
  if (isS) {
    float m_reg = d.m0, l_reg = d.l0; bf16x8 qr[8];
    { const GAS bf16* Qw = (const GAS bf16*)d.Q + (long)(w4 * QBLK + r32) * d.ldq + hi * 8;
#pragma unroll
      for (int d0 = 0; d0 < 8; ++d0) qr[d0] = *(const GAS bf16x8*)(Qw + d0 * 16); }
    asm volatile("" ::: "memory");
    KDMA(0); KDMA(1); if (2 < NT) KDMA(2);
    f32x16 pA0, pA1, pB0, pB1; float mnA, mnB, alA, alB; bf16x8 pa0, pa1, pa2, pa3;
    if (2 < NT) WAITV(8); else WAITV(4);
    BAR();
    qkt_pf(pA0, pA1, KBUF(0), qr, r32, hi);
    if (2 < NT) WAITV(4); else WAITV(0);
    BAR();
#define PUBP() do { *(LAS bf16x8*)(P_l) = pa0; *(LAS bf16x8*)(P_l + 1024) = pa1; *(LAS bf16x8*)(P_l + 2048) = pa2; *(LAS bf16x8*)(P_l + 3072) = pa3; } while (0)
#define SSTEP(J, PC0, PC1, MNC, ALC, PN0, PN1) do { \
      partialSM(PC0, PC1, m_reg, MNC, ALC); PROBE_SVALU(); { const bool rs_ = __any((ALC) < 1.f); if (rs_ && hi == 0) al_l[r32] = (ALC); if (lane == 0) *flag = rs_ ? 1u : 0u; } \
      if ((J) + 1 < NT) { SBAR(); qkt_pf(PN0, PN1, KBUF((J) + 1), qr, r32, hi); SBAR(); } \
      BAR();                                                                             \
      finishSM(PC0, PC1, ALC, l_reg, pa0, pa1, pa2, pa3); PUBP(); \
      if ((J) + 1 == NT && hi == 0) li_l[r32] = l_reg; \
      if ((J) + 3 < NT) KDMA((J) + 3); \
      if ((J) + 3 < NT) WAITV(4); else WAITV(0); \
      BAR();                                                                             \
    } while (0)
#ifdef PROBE_S
#define PROBE_SVALU() do { float dm_ = 1.0f; _Pragma("unroll") for (int q_ = 0; q_ < 32; ++q_) asm volatile("v_exp_f32 %0, %0" : "+v"(dm_)); asm volatile("" :: "v"(dm_)); } while (0)
#else
#define PROBE_SVALU() do { } while (0)
#endif
    for (int j = 0; j < NT; j += 2) {
      SSTEP(j, pA0, pA1, mnA, alA, pB0, pB1);
      SSTEP(j + 1, pB0, pB1, mnB, alB, pA0, pA1);
    }
    BAR();
#undef PUBP
#undef SSTEP
  } else {
    f32x16 o[8] = {}; bf16x8 pa0, pa1, pa2, pa3;
    const int vb0 = (int)(unsigned)(uintptr_t)V_lds + v_rd_base(lane);
    BAR();
    BAR();
#define GETP() do { pa0 = *(const LAS bf16x8*)(P_l); pa1 = *(const LAS bf16x8*)(P_l + 1024); pa2 = *(const LAS bf16x8*)(P_l + 2048); pa3 = *(const LAS bf16x8*)(P_l + 3072); } while (0)
#ifdef PROBE_W
    unsigned long long wacc = 0, wprev = __builtin_amdgcn_s_memrealtime();
#define WST(k) do { const unsigned long long t_ = __builtin_amdgcn_s_memrealtime(); if ((k) == PROBE_W) wacc += t_ - wprev; wprev = t_; } while (0)
#else
#define WST(k) do { } while (0)
#endif
    VDMA(0);
    BAR();
    WAITV(0); BAR();
    for (int J = 1; J < NT; ++J) {
      WST(3);
      VDMA(J);
      GETP(); asm volatile("s_waitcnt lgkmcnt(0)" ::: "memory"); pv_pipe(o, vb0 + VOFS(J - 1), pa0, pa1, pa2, pa3);
      WST(0); BAR();
      WST(1);
      pv_pipe(o + 4, vb0 + VOFS(J - 1) + SHM_V, pa0, pa1, pa2, pa3);
      if (__builtin_amdgcn_readfirstlane(*flag)) {
#pragma unroll
        for (int dd = 0; dd < 8; ++dd)
#pragma unroll
          for (int r = 0; r < 16; ++r) o[dd][r] *= al_l[crow(r, hi)]; }
      WST(2); WAITV(0); BAR();
    }
    GETP(); asm volatile("s_waitcnt lgkmcnt(0)" ::: "memory"); pv_pipe(o, vb0 + VOFS(NT - 1), pa0, pa1, pa2, pa3); pv_pipe(o + 4, vb0 + VOFS(NT - 1) + SHM_V, pa0, pa1, pa2, pa3);
    float rli[16];
#pragma unroll
    for (int r = 0; r < 16; ++r) rli[r] = __builtin_amdgcn_rcpf(li_l[crow(r, hi)]);
    GAS bf16* Ow = (GAS bf16*)d.O + (long)(w4 * QBLK) * d.ldo;
    if constexpr (!COMB) {
    { LAS bf16* stg = (LAS bf16*)(lds + X_P + w4 * 4096);
#pragma unroll
      for (int g = 0; g < 4; ++g) {
#pragma unroll
        for (int r = 0; r < 16; ++r) { const int orow = crow(r, hi); const float x0 = o[2 * g][r] * rli[r], x1 = o[2 * g + 1][r] * rli[r];
          stg[orow * 64 + r32] = (bf16)(cvt_pk_bf16(x0, x0) & 0xffffu); stg[orow * 64 + 32 + r32] = (bf16)(cvt_pk_bf16(x1, x1) & 0xffffu); }
        asm volatile("s_waitcnt lgkmcnt(0)" ::: "memory");
#pragma unroll
        for (int q = 0; q < 4; ++q) { const int idx = q * 64 + lane, row = idx >> 3, ch = idx & 7; const v4u v = *(const LAS v4u*)(stg + row * 64 + ch * 8);
          *(GAS v4u*)(Ow + (long)row * d.ldo + g * 64 + ch * 8) = v; }
        asm volatile("s_waitcnt lgkmcnt(0)" ::: "memory"); } }
    } else {
      const GAS bf16* O1w = (const GAS bf16*)d.O1 + (long)(w4 * QBLK) * 4096; const float lam = d.lam;
      asm volatile("s_waitcnt vmcnt(0)" ::: "memory");
      LAS bf16* stg = (LAS bf16*)(lds + X_P + w4 * 4096);
      float dv[4][4][8]; float ssq[4] = {0.f, 0.f, 0.f, 0.f};
#pragma unroll
      for (int g = 0; g < 4; ++g) {
#pragma unroll
        for (int r = 0; r < 16; ++r) { const int orow = crow(r, hi); const float x0 = o[2 * g][r] * rli[r], x1 = o[2 * g + 1][r] * rli[r];
          stg[orow * 64 + r32] = (bf16)(cvt_pk_bf16(x0, x0) & 0xffffu); stg[orow * 64 + 32 + r32] = (bf16)(cvt_pk_bf16(x1, x1) & 0xffffu); }
        asm volatile("s_waitcnt lgkmcnt(0)" ::: "memory");
#pragma unroll
        for (int q = 0; q < 4; ++q) { const int idx = q * 64 + lane, row = idx >> 3, ch = idx & 7; const v4u v2 = *(const LAS v4u*)(stg + row * 64 + ch * 8);
          const v4u v1 = *(const GAS v4u*)(O1w + (long)row * 4096 + g * 64 + ch * 8);
#pragma unroll
          for (int j = 0; j < 4; ++j) { const unsigned w1 = v1[j], w2 = v2[j];
            const float xl = __builtin_bit_cast(float, w1 << 16) - lam * __builtin_bit_cast(float, w2 << 16), xh = __builtin_bit_cast(float, w1 & 0xffff0000u) - lam * __builtin_bit_cast(float, w2 & 0xffff0000u);
            dv[g][q][2 * j] = xl; dv[g][q][2 * j + 1] = xh; ssq[q] += xl * xl + xh * xh; } }
        asm volatile("s_waitcnt lgkmcnt(0)" ::: "memory"); }
#pragma unroll
      for (int q = 0; q < 4; ++q) { float t = ssq[q]; t += __shfl_xor(t, 1); t += __shfl_xor(t, 2); t += __shfl_xor(t, 4); ssq[q] = __builtin_amdgcn_rsqf(t * (1.f / 256.f) + 1e-6f); }
#pragma unroll
      for (int g = 0; g < 4; ++g)
#pragma unroll
        for (int q = 0; q < 4; ++q) { const int idx = q * 64 + lane, row = idx >> 3, ch = idx & 7; const float rs = ssq[q]; v4u w;
          w.x = cvt_pk_bf16(dv[g][q][0] * rs, dv[g][q][1] * rs); w.y = cvt_pk_bf16(dv[g][q][2] * rs, dv[g][q][3] * rs); w.z = cvt_pk_bf16(dv[g][q][4] * rs, dv[g][q][5] * rs); w.w = cvt_pk_bf16(dv[g][q][6] * rs, dv[g][q][7] * rs);
          *(GAS v4u*)(Ow + (long)row * d.ldo + g * 64 + ch * 8) = w; }
    }
    BAR();
#ifdef PROBE_W
    if (blockIdx.x == 0 && wid == 4 && lane == 0) { GAS unsigned long long* tw = (GAS unsigned long long*)d.probe; tw[4] += wacc; }
#endif
#undef GETP
  }
#undef KOFF
#undef VKK
#undef VOFF
#undef TROW
#undef TROT
#undef GLDS
#undef KDMA
#undef VDMA
#undef VPIECE
#undef WAITV
#undef BAR
#undef KBUF
#undef VOFS
}
}
constexpr int NWAVES = 8;
constexpr size_t MiB = 1u << 20;
constexpr size_t WS_CTL = 0, CTL_ZERO_BYTES = 1 * MiB;
constexpr size_t WS_MODP = 1 * MiB;
constexpr size_t WS_MODS = 9 * MiB;
constexpr size_t WS_TAB = 10 * MiB;
constexpr size_t WS_SSQ = 11 * MiB;
constexpr size_t WS_W = 13 * MiB;
constexpr size_t W_SWA_QKV = WS_W, W_SWA_O = W_SWA_QKV + 12 * MiB, W_DIFF_QKV = W_SWA_O + 8 * MiB, W_DIFF_O = W_DIFF_QKV + 24 * MiB;
constexpr size_t W_MLA_DOWN = W_DIFF_O + 8 * MiB, W_MLA_UQ = W_MLA_DOWN + 5 * MiB, W_MLA_UKV = W_MLA_UQ + 3 * MiB, W_MLA_O = W_MLA_UKV + 4 * MiB;
constexpr size_t W_NA_QKV = W_MLA_O + 8 * MiB, W_NA_O = W_NA_QKV + 24 * MiB, W_GU = W_NA_O + 8 * MiB, W_DOWN = W_GU + 4 * 44 * MiB, W_END = W_DOWN + 4 * 22 * MiB;
constexpr size_t WS_H = W_END;
constexpr size_t WS_U = WS_H + 136 * MiB;
constexpr size_t WS_Y = WS_U + 68 * MiB;
constexpr size_t WS_O = WS_Y + 136 * MiB;
constexpr size_t WS_O12 = WS_O + 68 * MiB;
constexpr size_t WS_R1 = WS_O12 + 136 * MiB;
constexpr size_t R1_MLA_Q = WS_R1, R1_MLA_KV = WS_R1 + 102 * MiB, R1_MLA_C = R1_MLA_KV + 136 * MiB, R1_MLA_KPE = R1_MLA_C + 34 * MiB;
constexpr size_t R1_KH = WS_R1 + 68 * MiB, R1_VH = WS_R1 + 136 * MiB;
constexpr size_t WS_YP = WS_R1 + 276 * MiB;
constexpr size_t WS_END = WS_YP + 64 * MiB;
static_assert(W_END == (13 + 368) * MiB && (size_t)MROWS * 6144 * 2 <= 276 * MiB && (size_t)MROWS * FF * 2 <= 276 * MiB && R1_MLA_KPE + (size_t)MROWS * 64 * 2 <= WS_END, "ws map");
constexpr int CW_BAR = 4096;
constexpr int RING_BYTES = 133120, MISC_OFF = 135168, LDS_BYTES = 147456;
static_assert(attn::L_END <= RING_BYTES && attn::X_END <= RING_BYTES && pg8::STAGE_BYTES <= RING_BYTES && 8 * 16640 <= RING_BYTES && MISC_OFF + 128 <= LDS_BYTES, "LDS map");

#define RLX_AGENT __ATOMIC_RELAXED, __HIP_MEMORY_SCOPE_AGENT
#define LDS_WAIT() asm volatile("s_waitcnt lgkmcnt(0)" ::: "memory")

#define XB_TMO      128
#define XB_XCNT(j)  (256  + 64 * (j))
#define XB_XSUB(j)  (1280 + 64 * (j))
#define XB_XGEN(j)  (2304 + 64 * (j))
#define XB_TOP      3328
#define XB_TOPGEN   3392
#define XCD_BAR_WORDS 3456
#define XB_SPIN_CAP (1u << 18)
__device__ __forceinline__ unsigned xb_ld(unsigned* p)              { return __hip_atomic_load(p, __ATOMIC_RELAXED, __HIP_MEMORY_SCOPE_AGENT); }
__device__ __forceinline__ unsigned xb_add(unsigned* p, unsigned v) { return __hip_atomic_fetch_add(p, v, __ATOMIC_RELAXED, __HIP_MEMORY_SCOPE_AGENT); }
__device__ __forceinline__ unsigned xb_xcc_id() { return (unsigned)__builtin_amdgcn_s_getreg((3 << 11) | 20) & 0xFu; }
#define XB_SPIN(cond, bar) do { unsigned _sp = 0; while (cond) { __builtin_amdgcn_s_sleep(1); \
    if ((++_sp & 255u) == 0u) { if (xb_ld(&(bar)[XB_TMO])) break; if (_sp > XB_SPIN_CAP) { atomicAdd(&(bar)[XB_TMO], 1u); break; } } } } while (0)
struct XcdBarrier { unsigned* bar; unsigned x; volatile LAS unsigned* st; };
__device__ __forceinline__ XcdBarrier xcd_barrier_post(unsigned* bar, volatile LAS unsigned* st) {
    XcdBarrier b; b.bar = bar; b.x = xb_xcc_id(); b.st = st;
    if (threadIdx.x == 0) (void)xb_add(&bar[XB_XCNT(b.x)], 1u);
    return b;
}
__device__ __forceinline__ void xcd_barrier_complete(unsigned* bar, unsigned x, unsigned& nloc, unsigned& nx) {
    const unsigned G = gridDim.x * gridDim.y * gridDim.z;
    unsigned sum, cnt, mine, sp = 0u;
    for (;;) {
        sum = 0u; cnt = 0u; mine = 0u;
#pragma unroll
        for (unsigned j = 0; j < 16; ++j) { const unsigned c = xb_ld(&bar[XB_XCNT(j)]); sum += c; cnt += (c > 0u) ? 1u : 0u; mine = (j == x) ? c : mine; }
        if (sum == G) break;
        __builtin_amdgcn_s_sleep(1);
        if ((++sp & 255u) == 0u) { if (xb_ld(&bar[XB_TMO])) break; if (sp > XB_SPIN_CAP) { atomicAdd(&bar[XB_TMO], 1u); break; } }
    }
    nloc = mine > 0u ? mine : 1u; nx = cnt > 0u ? cnt : 1u;
}
__device__ __forceinline__ void xcd_barrier(const XcdBarrier& b) {
    asm volatile("s_waitcnt vmcnt(0)" ::: "memory");
    __syncthreads();
    if (threadIdx.x == 0) {
        unsigned* bar = b.bar;
        __builtin_amdgcn_s_waitcnt(0);
        unsigned nloc = b.st[0], nx = b.st[1];
        if (nloc == 0u) { xcd_barrier_complete(bar, b.x, nloc, nx); b.st[0] = nloc; b.st[1] = nx; }
        const unsigned old = xb_add(&bar[XB_XSUB(b.x)], 1u);
        const unsigned gen = old / nloc;
        if (old + 1u == (gen + 1u) * nloc) {
            __builtin_amdgcn_fence(__ATOMIC_RELEASE, "agent");
            asm volatile("s_waitcnt vmcnt(0)" ::: "memory");
            const unsigned og = xb_add(&bar[XB_TOP], 1u);
            const unsigned tg = og / nx;
            if (og + 1u == (tg + 1u) * nx) xb_add(&bar[XB_TOPGEN], 1u);
            else XB_SPIN(xb_ld(&bar[XB_TOPGEN]) == tg, bar);
            __builtin_amdgcn_fence(__ATOMIC_ACQUIRE, "agent");
            xb_add(&bar[XB_XGEN(b.x)], 1u);
            asm volatile("s_waitcnt vmcnt(0)" ::: "memory");
        } else {
            XB_SPIN(xb_ld(&bar[XB_XGEN(b.x)]) == gen, bar);
            __builtin_amdgcn_fence(__ATOMIC_ACQUIRE, "agent");
            asm volatile("s_waitcnt vmcnt(0)" ::: "memory");
        }
    }
    __syncthreads();
}

enum { I_X = 0, I_C, I_CTX, I_CCTX, I_MODW, I_MODB, I_NORMG, I_WGU, I_WDOWN, I_SWA_QKV, I_SWA_O, I_SWA_SINK, I_DIFF_QKV, I_DIFF_O, I_DIFF_LAM, I_DIFF_SUBLN,
       I_MLA_DOWN, I_MLA_QN, I_MLA_KVN, I_MLA_UQ, I_MLA_UKV, I_MLA_O, I_NA_QKV, I_NA_O, I_NA_RPB, N_IN };
struct Args { const float* in[N_IN]; float* out; unsigned char* ws; int ph_lo, ph_hi, li, pad; };

struct Frame {
    LAS unsigned char* lds;
    int tid, lane, wave, vcu, G;
    unsigned char* ws;
};
__device__ __forceinline__ float wave_sum(float v) {
#pragma unroll
    for (int o = 1; o < 64; o <<= 1) v += __shfl_xor(v, o);
    return v;
}
__device__ __forceinline__ float ssq4(const f32x4 v) { return (v[0] * v[0] + v[1] * v[1]) + (v[2] * v[2] + v[3] * v[3]); }

constexpr float DIFF_LAM_INIT = 0.35550906759096926f;
struct CJob { const float* W; bf16* WT; int K, Nsrc, Ng, gu, rmod, rlo, rmax, pt; const float* kg; int kmask; float ks; };
constexpr int CJ_ITEMS[18] = {1536, 1024, 3072, 1024, 640, 384, 512, 1024, 3072, 1024, 5632, 5632, 5632, 5632, 2816, 2816, 2816, 2816};
constexpr int CJ_TOTAL = 47104;
#define CJ_IN(I_) cj_opaque(a.in[I_])
__device__ __forceinline__ const float* cj_opaque(const float* p) { unsigned long long v = (unsigned long long)p; asm volatile("" : "+s"(v)); return (const float*)v; }
__device__ __forceinline__ CJob cjob(const Args& a, int j) {
    unsigned char* ws = a.ws; CJob c; c.gu = 0; c.rmod = 1 << 30; c.rlo = 0; c.rmax = 0; c.pt = 0; c.kg = nullptr; c.kmask = -1; c.ks = 1.f;
    switch (j) {
    case 0: c.W = CJ_IN(I_SWA_QKV); c.WT = (bf16*)(ws + W_SWA_QKV); c.K = 2048; c.Nsrc = 3072; c.Ng = 3072; c.rmax = 2560; c.pt = 1; break;
    case 1: c.W = CJ_IN(I_SWA_O); c.WT = (bf16*)(ws + W_SWA_O); c.K = 2048; c.Nsrc = 2048; c.Ng = 2048; break;
    case 2: c.W = CJ_IN(I_DIFF_QKV); c.WT = (bf16*)(ws + W_DIFF_QKV); c.K = 2048; c.Nsrc = 6144; c.Ng = 6144; c.rmax = 4096; c.pt = 1; break;
    case 3: c.W = CJ_IN(I_DIFF_O); c.WT = (bf16*)(ws + W_DIFF_O); c.K = 2048; c.Nsrc = 2048; c.Ng = 2048; c.kg = CJ_IN(I_DIFF_SUBLN); c.kmask = 255; c.ks = 1.f - DIFF_LAM_INIT; break;
    case 4: c.W = CJ_IN(I_MLA_DOWN); c.WT = (bf16*)(ws + W_MLA_DOWN); c.K = 2048; c.Nsrc = 1088; c.Ng = 1280; c.rlo = 1024; c.rmax = 1088; c.pt = 2; break;
    case 5: c.W = CJ_IN(I_MLA_UQ); c.WT = (bf16*)(ws + W_MLA_UQ); c.K = 512; c.Nsrc = 3072; c.Ng = 3072; c.rmod = 192; c.rlo = 128; c.rmax = 3072; c.pt = 2; c.kg = CJ_IN(I_MLA_QN); break;
    case 6: c.W = CJ_IN(I_MLA_UKV); c.WT = (bf16*)(ws + W_MLA_UKV); c.K = 512; c.Nsrc = 4096; c.Ng = 4096; c.kg = CJ_IN(I_MLA_KVN); break;
    case 7: c.W = CJ_IN(I_MLA_O); c.WT = (bf16*)(ws + W_MLA_O); c.K = 2048; c.Nsrc = 2048; c.Ng = 2048; break;
    case 8: c.W = CJ_IN(I_NA_QKV); c.WT = (bf16*)(ws + W_NA_QKV); c.K = 2048; c.Nsrc = 6144; c.Ng = 6144; break;
    case 9: c.W = CJ_IN(I_NA_O); c.WT = (bf16*)(ws + W_NA_O); c.K = 2048; c.Nsrc = 2048; c.Ng = 2048; break;
    case 10: case 11: case 12: case 13: c.W = CJ_IN(I_WGU) + (size_t)(j - 10) * DM * 2 * FF; c.WT = (bf16*)(ws + W_GU + (size_t)(j - 10) * 44 * MiB); c.K = 2048; c.Nsrc = 2 * FF; c.Ng = 2 * FF; c.gu = 1; break;
    default: c.W = CJ_IN(I_WDOWN) + (size_t)(j - 14) * FF * DM; c.WT = (bf16*)(ws + W_DOWN + (size_t)(j - 14) * 22 * MiB); c.K = FF; c.Nsrc = 2048; c.Ng = 2048; break;
    }
    return c;
}
__device__ __forceinline__ void convert_item(const CJob& c, int it, LAS float* scr, int lane) {
    const int ngr = c.Ng >> 6, kb = it / ngr, gi = it - kb * ngr, k0 = kb * 64, n0 = gi * 64;
    int sb = n0; if (c.gu) { const int pn = n0 >> 8, bj = (n0 >> 7) & 1, j = n0 & 127; sb = bj * FF + pn * 128 + j; }
    const bool zero = sb >= c.Nsrc, rope = ((n0 % c.rmod) >= c.rlo) && (n0 < c.rmax);
    if (!zero) {
        const GAS f32x4* wp = (const GAS f32x4*)(c.W + (size_t)(k0 + (lane >> 4)) * c.Nsrc + sb + (lane & 15) * 4);
        f32x4 v[16];
#pragma unroll
        for (int i = 0; i < 16; ++i) v[i] = wp[(size_t)i * c.Nsrc];
#pragma unroll
        for (int i = 0; i < 16; ++i) { LAS float* s = scr + (4 * i + (lane >> 4)) * 65 + (lane & 15) * 4; s[0] = v[i][0]; s[1] = v[i][1]; s[2] = v[i][2]; s[3] = v[i][3]; }
    }
    LDS_WAIT(); asm volatile("" ::: "memory");
    const int cch = lane & 7;
    float g[8];
#pragma unroll
    for (int t = 0; t < 8; ++t) g[t] = c.kg ? ((const GAS float*)c.kg)[(k0 + 8 * cch + t) & c.kmask] * c.ks : 1.f;
#pragma unroll
    for (int j8 = 0; j8 < 8; ++j8) { const int nn = (lane >> 3) + 8 * j8;
        int src = nn; if (rope) src = (c.pt == 1) ? ((nn & 1) * 32 + (nn >> 1)) : ((nn >> 5) * 32 + (nn & 1) * 16 + ((nn & 31) >> 1));
        const LAS float* s = scr + (8 * cch) * 65 + src; v4u o;
        if (zero) o = (v4u){0u, 0u, 0u, 0u};
        else { o.x = cvt_pk_bf16(s[0 * 65] * g[0], s[1 * 65] * g[1]); o.y = cvt_pk_bf16(s[2 * 65] * g[2], s[3 * 65] * g[3]); o.z = cvt_pk_bf16(s[4 * 65] * g[4], s[5 * 65] * g[5]); o.w = cvt_pk_bf16(s[6 * 65] * g[6], s[7 * 65] * g[7]); }
        *(GAS v4u*)(c.WT + (size_t)(n0 + nn) * c.K + k0 + 8 * cch) = o; }
    LDS_WAIT(); asm volatile("" ::: "memory");
}
constexpr int cj_total(unsigned mask) { int t = 0; for (int q = 0; q < 18; ++q) if ((mask >> q) & 1u) t += CJ_ITEMS[q]; return t; }
template <unsigned MASK>
__device__ __forceinline__ void convert_jobs(Frame& F, const Args& a, int ic, int nidle) {
    if (ic < 0) return;
    constexpr int TOTAL = cj_total(MASK);
    LAS float* scr = (LAS float*)(F.lds + F.wave * 16640);
    for (int gidx = ic * NWAVES + F.wave; gidx < TOTAL; gidx += nidle * NWAVES) {
        int j = 0, it = gidx; bool found = false;
#pragma unroll
        for (int q = 0; q < 18; ++q) { if (((MASK >> q) & 1u) && !found) { if (it < CJ_ITEMS[q]) { j = q; found = true; } else it -= CJ_ITEMS[q]; } }
        const CJob c = cjob(a, j);
        convert_item(c, it, scr, F.lane);
    }
}
constexpr unsigned CJM_L0 = (1u << 0) | (1u << 1);
constexpr unsigned cvm_ffn1(int l) { return l == 0 ? (1u << 2) : 0u; }
constexpr unsigned cvm_ffn2(int l) { return l == 0 ? ((1u << 3) | (1u << 15)) : l == 1 ? ((1u << 7) | (1u << 16)) : (1u << 8); }
constexpr int MOD_KS = 16;
template <int L0, int LN, int KS = MOD_KS, bool REV = false>
__device__ __forceinline__ void mod_partials(Frame& F, const Args& a, int ic, int nidle) {
    if (ic < 0 || LN <= 0) return;
    constexpr int RPT = DM / KS;
    LAS float* scr = (LAS float*)(F.lds + F.wave * 16640);
    const int lane = F.lane;
    const int w0 = ic * NWAVES + F.wave, nw = nidle * NWAVES;
    for (int t = REV ? nw - 1 - w0 : w0; t < LN * 48 * KS; t += nw) {
        const int li = t / (48 * KS), l = L0 + li, rem = t - li * (48 * KS), cg = rem / KS, ks = rem - cg * KS;
#pragma unroll
        for (int r = 0; r < 5; ++r)
#pragma unroll
            for (int q = 0; q < RPT / 64; ++q) { const int k = ks * RPT + lane + 64 * q; const float v = (r < 4) ? ((const GAS float*)a.in[I_C])[r * DM + k] : ((const GAS float*)a.in[I_CCTX])[k];
                scr[r * RPT + lane + 64 * q] = v / (1.f + __expf(-v)); }
        LDS_WAIT(); asm volatile("" ::: "memory");
        f32x4 acc[5];
#pragma unroll
        for (int r = 0; r < 5; ++r) acc[r] = (f32x4){0.f, 0.f, 0.f, 0.f};
        const GAS f32x4* wp = (const GAS f32x4*)(a.in[I_MODW] + ((size_t)l * DM + ks * RPT) * MODW + cg * 256 + lane * 4);
        for (int kk = 0; kk < RPT; kk += 16) { f32x4 w[16];
#pragma unroll
            for (int i = 0; i < 16; ++i) w[i] = wp[(size_t)(kk + i) * (MODW / 4)];
#pragma unroll
            for (int i = 0; i < 16; ++i)
#pragma unroll
                for (int r = 0; r < 5; ++r) acc[r] += w[i] * scr[r * RPT + kk + i]; }
#pragma unroll
        for (int r = 0; r < 5; ++r) *(GAS f32x4*)((float*)(F.ws + WS_MODP) + ((size_t)((l & 1) * MOD_KS + ks) * 5 + r) * MODW + cg * 256 + lane * 4) = acc[r];
        LDS_WAIT(); asm volatile("" ::: "memory");
    }
}
template <int L0, int LN, int KS = MOD_KS>
__device__ __forceinline__ void mod_reduce(Frame& F, const Args& a, int ic, int nidle) {
    if (ic < 0 || LN <= 0) return;
    for (int gid = ic * 512 + F.tid; gid < LN * 5 * (MODW / 4); gid += nidle * 512) {
        const int li = gid / (5 * (MODW / 4)), l = L0 + li, rem = gid - li * (5 * (MODW / 4)), r = rem / (MODW / 4), j4 = rem - r * (MODW / 4);
        f32x4 s = *(const GAS f32x4*)(a.in[I_MODB] + (size_t)l * MODW + 4 * j4);
#pragma unroll
        for (int ks = 0; ks < KS; ++ks) s += *(const GAS f32x4*)((const float*)(F.ws + WS_MODP) + ((size_t)((l & 1) * MOD_KS + ks) * 5 + r) * MODW + 4 * j4);
        *(GAS f32x4*)((float*)(F.ws + WS_MODS) + ((size_t)l * 5 + r) * MODW + 4 * j4) = s;
    }
}
__device__ __forceinline__ void p0a(Frame& F, const Args& a) {
    LAS float* scr = (LAS float*)(F.lds + F.wave * 16640);
    const int gw = F.vcu * NWAVES + F.wave, NGW = F.G * NWAVES, lane = F.lane;
    mod_partials<0, 1, 32, true>(F, a, F.vcu, F.G);
    convert_jobs<CJM_L0>(F, a, F.vcu, F.G);
    if (blockIdx.x == 0) {
        const float L2T = 13.287712379549449f;
        GAS f32x4* T128 = (GAS f32x4*)(F.ws + WS_TAB); GAS f32x4* T64 = (GAS f32x4*)(F.ws + WS_TAB + 16384);
        for (int e = F.tid; e < 1024 + 512; e += 512) {
            int pos, k, n; if (e < 1024) { pos = e >> 4; k = e & 15; n = 32; } else { pos = (e - 1024) >> 3; k = (e - 1024) & 7; n = 16; }
            f32x4 o;
#pragma unroll
            for (int q = 0; q < 2; ++q) { const float inv = exp2f(-(float)(2 * k + q) / (float)n * L2T); const float ang = (float)pos * inv; float rev = ang * 0.15915494309189535f; rev -= floorf(rev);
                o[2 * q] = __builtin_amdgcn_cosf(rev); o[2 * q + 1] = __builtin_amdgcn_sinf(rev); }
            if (e < 1024) T128[e] = o; else T64[e - 1024] = o;
        }
    }
    if (blockIdx.x == 1 && F.wave == 0) {
        const GAS float* lv = (const GAS float*)a.in[I_DIFF_LAM];
        const float s1 = wave_sum(lv[lane] * lv[128 + lane] + lv[64 + lane] * lv[192 + lane]), s2 = wave_sum(lv[256 + lane] * lv[384 + lane] + lv[320 + lane] * lv[448 + lane]);
        if (lane == 0) *(GAS float*)(F.ws + WS_TAB + 32768) = expf(s1) - expf(s2) + DIFF_LAM_INIT;
    }
}
__device__ __forceinline__ void p0b(Frame& F, const Args& a) { mod_reduce<0, 1, 32>(F, a, (int)blockIdx.x, F.G); }
template <int KIND>
__device__ __forceinline__ void thin_phase(Frame& F, const Args& a, int lg, int sub, bool latent_only, int ysplit, bool dry = false) {
    const int gw = F.vcu * NWAVES + F.wave, NGW = F.G * NWAVES, lane = F.lane;
    const int lu = (KIND == 0) ? 0 : (sub == 0 ? lg : lg + 1), subu = (KIND == 0) ? 0 : 1 - sub;
    const GAS float* MODS = (const GAS float*)(F.ws + WS_MODS); const GAS float* NG = (const GAS float*)a.in[I_NORMG];
    LAS f32x4* PT = (LAS f32x4*)F.lds;
    { const int t = F.tid;
#pragma unroll
      for (int r = 0; r < 5; ++r) {
        if (KIND != 0) { const f32x4 g = ((const GAS f32x4*)(MODS + ((size_t)lg * 5 + r) * MODW + (sub ? 5 : 2) * DM))[t], p = ((const GAS f32x4*)(NG + ((size_t)lg * 4 + (sub ? 3 : 1)) * DM))[t]; PT[(r * 3 + 0) * 512 + t] = g * p; }
        if (KIND != 2) { const GAS float* mv = MODS + ((size_t)lu * 5 + r) * MODW;
          const f32x4 sc = ((const GAS f32x4*)(mv + (subu ? 4 : 1) * DM))[t], sh = ((const GAS f32x4*)(mv + (subu ? 3 : 0) * DM))[t], p = ((const GAS f32x4*)(NG + ((size_t)lu * 4 + (subu ? 2 : 0)) * DM))[t];
          PT[(r * 3 + 1) * 512 + t] = p * (sc + 1.f); PT[(r * 3 + 2) * 512 + t] = sh; } }
      __syncthreads(); }
    for (int m = gw; m < MROWS; m += NGW) {
        const int b = m / TPB, rr = m - b * TPB; const bool isctx = rr < CTXL; const int mr = isctx ? 4 : b;
        if ((latent_only || KIND == 2) && isctx) continue;
        f32x4 h[8];
        if (KIND == 0) { const GAS f32x4* hp = (const GAS f32x4*)(isctx ? a.in[I_CTX] + ((size_t)b * CTXL + rr) * DM : a.in[I_X] + ((size_t)b * SEQ + (rr - CTXL)) * DM);
#pragma unroll
          for (int j = 0; j < 8; ++j) h[j] = hp[64 * j + lane]; }
        else { const GAS unsigned long long* hp = (const GAS unsigned long long*)((const bf16*)(F.ws + WS_H) + (size_t)m * DM);
#pragma unroll
          for (int j = 0; j < 8; ++j) { const unsigned long long w = hp[64 * j + lane]; const unsigned lo = (unsigned)w, hi = (unsigned)(w >> 32);
            h[j] = (f32x4){__builtin_bit_cast(float, lo << 16), __builtin_bit_cast(float, lo & 0xffff0000u), __builtin_bit_cast(float, hi << 16), __builtin_bit_cast(float, hi & 0xffff0000u)}; } }
        if (KIND != 0) {
            f32x4 y[8]; float ss = 0.f;
            if (!(isctx && ysplit)) { const GAS unsigned long long* yp = (const GAS unsigned long long*)((const bf16*)(F.ws + WS_Y) + (size_t)m * DM);
#pragma unroll
                for (int j = 0; j < 8; ++j) { const unsigned long long w = yp[64 * j + lane]; const unsigned lo = (unsigned)w, hi = (unsigned)(w >> 32);
                    y[j] = (f32x4){__builtin_bit_cast(float, lo << 16), __builtin_bit_cast(float, lo & 0xffff0000u), __builtin_bit_cast(float, hi << 16), __builtin_bit_cast(float, hi & 0xffff0000u)}; }
            } else {
                const GAS f32x4* sp = (const GAS f32x4*)((const float*)(F.ws + WS_YP) + ((size_t)b * CTXL + rr) * DM);
#pragma unroll
                for (int j = 0; j < 8; ++j) y[j] = sp[64 * j + lane];
#pragma unroll 1
                for (int ks = 1; ks < ysplit; ++ks) { sp += (size_t)1024 * DM / 4;
#pragma unroll
                    for (int j = 0; j < 8; ++j) y[j] += sp[64 * j + lane]; } }
#pragma unroll
            for (int j = 0; j < 8; ++j) ss += ssq4(y[j]);
            const float rstd = __builtin_amdgcn_rsqf(wave_sum(ss) * (1.f / DM) + EPS);
            const LAS f32x4* pa = PT + (mr * 3 + 0) * 512;
#pragma unroll
            for (int j = 0; j < 8; ++j) h[j] += pa[64 * j + lane] * (y[j] * rstd);
        }
        if (KIND == 2) { GAS f32x4* op = (GAS f32x4*)(a.out + ((size_t)b * SEQ + (rr - CTXL)) * DM);
#pragma unroll
            for (int j = 0; j < 8; ++j) op[64 * j + lane] = h[j];
        } else {
            GAS unsigned long long* hp = (GAS unsigned long long*)((bf16*)(F.ws + (dry ? WS_O12 : WS_H)) + (size_t)m * DM); float ss = 0.f;
#pragma unroll
            for (int j = 0; j < 8; ++j) { hp[64 * j + lane] = (unsigned long long)cvt_pk_bf16(h[j][0], h[j][1]) | ((unsigned long long)cvt_pk_bf16(h[j][2], h[j][3]) << 32); ss += ssq4(h[j]); }
            const float rstd = __builtin_amdgcn_rsqf(wave_sum(ss) * (1.f / DM) + EPS);
            const LAS f32x4* pc = PT + (mr * 3 + 1) * 512; const LAS f32x4* ps = PT + (mr * 3 + 2) * 512;
            GAS unsigned long long* up = (GAS unsigned long long*)((bf16*)(F.ws + (dry ? WS_O : WS_U)) + (size_t)m * DM);
#pragma unroll
            for (int j = 0; j < 8; ++j) { const f32x4 u = (h[j] * rstd) * pc[64 * j + lane] + ps[64 * j + lane];
                up[64 * j + lane] = (unsigned long long)cvt_pk_bf16(u[0], u[1]) | ((unsigned long long)cvt_pk_bf16(u[2], u[3]) << 32); }
        }
    }
    __syncthreads();
}
__device__ __forceinline__ void diff_combine(Frame& F) {
    const int gw = F.vcu * NWAVES + F.wave, NGW = F.G * NWAVES, lane = F.lane;
    const float lam = *(const GAS float*)(F.ws + WS_TAB + 32768);
    for (int m = gw; m < MROWS; m += NGW) {
        const GAS v4u* p1 = (const GAS v4u*)((const bf16*)(F.ws + WS_O12) + (size_t)m * 4096); GAS v4u* po = (GAS v4u*)((bf16*)(F.ws + WS_O) + (size_t)m * DM);
#pragma unroll
        for (int s = 0; s < 4; ++s) { const v4u a1 = p1[64 * s + lane], a2 = p1[256 + 64 * s + lane]; float x[8]; float ss = 0.f;
#pragma unroll
            for (int q = 0; q < 4; ++q) { const unsigned w1 = a1[q], w2 = a2[q];
                x[2 * q] = __builtin_bit_cast(float, w1 << 16) - lam * __builtin_bit_cast(float, w2 << 16); x[2 * q + 1] = __builtin_bit_cast(float, w1 & 0xffff0000u) - lam * __builtin_bit_cast(float, w2 & 0xffff0000u);
                ss += x[2 * q] * x[2 * q] + x[2 * q + 1] * x[2 * q + 1]; }
#pragma unroll
            for (int o = 1; o < 32; o <<= 1) ss += __shfl_xor(ss, o);
            const float rstd = __builtin_amdgcn_rsqf(ss * (1.f / 256.f) + EPS);
            v4u w; w.x = cvt_pk_bf16(x[0] * rstd, x[1] * rstd); w.y = cvt_pk_bf16(x[2] * rstd, x[3] * rstd); w.z = cvt_pk_bf16(x[4] * rstd, x[5] * rstd); w.w = cvt_pk_bf16(x[6] * rstd, x[7] * rstd);
            po[64 * s + lane] = w; }
    }
}
#define CTX_TICKET_HEAD(CTRW) \
    unsigned* tkc_ = (unsigned*)(F.ws + WS_CTL) + (CTRW); volatile LAS unsigned* tkl_ = (volatile LAS unsigned*)(F.lds + MISC_OFF) + 4; \
    const bool dyn_ = F.G >= 64; bool fin_ = false; \
    for (int un_ = F.vcu;;) { int u; \
        if (un_ < (dyn_ ? 1024 : 1024 + 64)) { u = un_; un_ += F.G; } \
        else { if (!dyn_ || fin_) break; fin_ = true; \
               if (F.tid == 0) *tkl_ = __hip_atomic_fetch_add(tkc_, 1u, __ATOMIC_RELAXED, __HIP_MEMORY_SCOPE_AGENT); \
               __syncthreads(); const unsigned t_ = (unsigned)__builtin_amdgcn_readfirstlane((int)*tkl_); __syncthreads(); if (t_ >= 64u) break; u = 1024 + (int)t_; }
__device__ __forceinline__ void attn_swa_phase(Frame& F, const Args& a) {
    const bf16* QKV = (const bf16*)(F.ws + WS_R1); bf16* O = (bf16*)(F.ws + WS_O);
    for (int it = 0; ; ++it) {
        int u = F.vcu + it * F.G;
        if (u >= 1024) {
            if (F.G == 256) { const int q = F.vcu & 15, e = it - 4; if ((q != 0 && q != 15) || e < 0 || e > 1) break; u = 1024 + ((F.vcu >> 4) * 2 + (q == 15 ? 1 : 0)) * 2 + e; }
            else if (u >= 1024 + 64) break;
        }
        attn::Desc d; int b, hq; long qrow;
        if (u < 1024) { const int bh = u >> 4, qb = u & 15; b = bh >> 4; hq = bh & 15; qrow = (long)b * TPB + CTXL + 256 * qb;
            const int t0 = 256 * qb, tlo = t0 - 128 < 0 ? 0 : t0 - 128, thi = t0 + 384 > SEQ ? SEQ : t0 + 384;
            d.NT = 4 + (thi - tlo) / 64; d.row_lat = b * TPB + CTXL + tlo; d.a0 = tlo - t0;
        } else { const int bh = u - 1024; b = bh >> 4; hq = bh & 15; qrow = (long)b * TPB; d.NT = 4; d.row_lat = b * TPB + CTXL; d.a0 = 0; }
        const int hk = hq >> 2;
        d.NTreal = d.NT; d.row_ctx = b * TPB; d.a1 = 0; d.rpb = nullptr; d.K2 = nullptr; d.rot = 0;
        d.Q = QKV + qrow * 3072 + 128 * hq; d.K = QKV + 2048 + 128 * hk; d.V = QKV + 2560 + 128 * hk; d.O = O + qrow * DM + 128 * hq;
        d.ldq = 3072; d.ldk = 3072; d.ldv = 3072; d.ldo = DM;
        d.m0 = ((const GAS float*)a.in[I_SWA_SINK])[hq]; d.l0 = 1.f;
        attn::unit<1, false, 2, 8>(d, (LAS char*)F.lds);
    }
}
__device__ __forceinline__ void attn_diff_phase(Frame& F) {
    const bf16* Q = (const bf16*)(F.ws + WS_R1); const bf16* KH = (const bf16*)(F.ws + R1_KH); const bf16* VH = (const bf16*)(F.ws + R1_VH); bf16* O12 = (bf16*)(F.ws + WS_O12); bf16* O = (bf16*)(F.ws + WS_O);
    const float lam = *(const GAS float*)(F.ws + WS_TAB + 32768);
    CTX_TICKET_HEAD(64)
        attn::Desc d; int bh; long qrow;
        if (u < 1024) { bh = u >> 5; qrow = (long)(bh >> 3) * TPB + CTXL + 128 * (u & 31); d.NT = 68; }
        else { bh = (u - 1024) >> 1; qrow = (long)(bh >> 3) * TPB + 128 * (u & 1); d.NT = 4; }
        const int b = bh >> 3, h = bh & 7;
        d.NTreal = d.NT; d.row_ctx = b * TPB; d.row_lat = b * TPB + CTXL; d.a0 = 0; d.a1 = 0; d.rpb = nullptr; d.K2 = nullptr; d.m0 = -1e30f; d.l0 = 0.f; d.rot = 0; d.probe = F.ws + 65536;
        d.V = VH + (size_t)h * MROWS * 256; d.ldq = 2048; d.ldk = 128; d.ldv = 256; d.O1 = O12 + qrow * 4096 + 256 * h; d.lam = lam;
        d.Q = Q + qrow * 2048 + 256 * h; d.K = KH + (size_t)(2 * h) * MROWS * 128; d.O = O12 + qrow * 4096 + 256 * h; d.ldo = 4096;
        attn::unit_split<false>(d, (LAS char*)F.lds);
        d.Q = Q + qrow * 2048 + 256 * h + 128; d.K = KH + (size_t)(2 * h + 1) * MROWS * 128; d.O = O + qrow * DM + 256 * h; d.ldo = DM;
        attn::unit_split<true>(d, (LAS char*)F.lds);
    }
}
__device__ __forceinline__ void attn_mla_phase(Frame& F) {
    const bf16* Qp = (const bf16*)(F.ws + R1_MLA_Q); const bf16* KV = (const bf16*)(F.ws + R1_MLA_KV); const bf16* KPE = (const bf16*)(F.ws + R1_MLA_KPE); bf16* O = (bf16*)(F.ws + WS_O);
    CTX_TICKET_HEAD(128)
        attn::Desc d; int bh; long qrow;
        if (u < 1024) { bh = u >> 4; const int qb = u & 15; qrow = (long)(bh >> 4) * TPB + CTXL + 256 * qb; d.NT = 68; }
        else { bh = u - 1024; qrow = (long)(bh >> 4) * TPB; d.NT = 4; }
        const int b = bh >> 4, h = bh & 15;
        d.NTreal = d.NT; d.row_ctx = b * TPB; d.row_lat = b * TPB + CTXL; d.a0 = 0; d.a1 = 0; d.rpb = nullptr; d.m0 = -1e30f; d.l0 = 0.f; d.rot = 0;
        d.Q = Qp + qrow * 3072 + 192 * h; d.K = KV + 256 * h; d.V = KV + 256 * h + 128; d.K2 = KPE; d.O = O + qrow * DM + 128 * h;
        d.ldq = 3072; d.ldk = 4096; d.ldv = 4096; d.ldo = DM;
        attn::unit<0, true, 1, 8>(d, (LAS char*)F.lds);
    }
}
__device__ __forceinline__ void attn_na_phase(Frame& F, const Args& a) {
    const bf16* QKV = (const bf16*)(F.ws + WS_R1); bf16* O = (bf16*)(F.ws + WS_O);
    for (int u = F.vcu; u < 1024; u += F.G) {
        attn::Desc d; const int bh = u >> 4, R = u & 15, b = bh >> 4, h = bh & 15; const long qrow = (long)b * TPB + CTXL + 256 * R;
        const int krlo = 4 * R - 4 < 0 ? 0 : 4 * R - 4; int krhi = 4 * R - 1; krhi = (krhi < 0 ? 0 : (krhi > 56 ? 56 : krhi)) + 8;
        d.NTreal = 4 + (krhi - krlo); d.NT = (d.NTreal + 1) & ~1; d.row_ctx = b * TPB; d.row_lat = b * TPB + CTXL + 64 * krlo; d.a0 = krlo; d.a1 = 4 * R;
        d.rpb = a.in[I_NA_RPB] + h * 465; d.K2 = nullptr; d.m0 = -1e30f; d.l0 = 0.f; d.rot = 0;
        d.Q = QKV + qrow * 6144 + 128 * h; d.K = QKV + 2048 + 128 * h; d.V = QKV + 4096 + 128 * h; d.O = O + qrow * DM + 128 * h;
        d.ldq = 6144; d.ldk = 6144; d.ldv = 6144; d.ldo = DM;
        attn::unit<2, false, 1, 4>(d, (LAS char*)F.lds);
    }
}

constexpr int NPH = 33;
#ifdef PROBE_EPI
#define GPROBE (args.ws + 65536)
#else
#define GPROBE nullptr
#endif
#ifndef TS_BLOCK
#define TS_BLOCK 0
#endif
#ifndef TS_BASE
#define TS_BASE 0.f
#endif
#ifndef TS_KIND
#define TS_KIND 0
#endif
#ifndef PROBE_TSMASK
#define PROBE_TSMASK 0ull
#endif
#ifndef TS_SCALE
#define TS_SCALE 1.f
#endif
#ifndef PROBE_DUP
#define PROBE_DUP (-1)
#endif
constexpr int WO_SPLIT = 8, DN_SPLIT = 4;
__global__ void __launch_bounds__(NWAVES * 64, 2) fwd_kernel(Args args) {
    extern __shared__ __attribute__((aligned(16))) unsigned char lds_raw[];
    Frame F; F.lds = (LAS unsigned char*)lds_raw; F.tid = threadIdx.x; F.lane = F.tid & 63; F.wave = __builtin_amdgcn_readfirstlane(F.tid >> 6);
    F.G = gridDim.x; { const int bx = blockIdx.x; F.vcu = (F.G % 8 == 0) ? (bx % 8) * (F.G / 8) + bx / 8 : bx; }
    F.ws = args.ws;
    volatile LAS unsigned* MISC = (volatile LAS unsigned*)(F.lds + MISC_OFF);
    if (F.tid < 32) MISC[F.tid] = 0u;
    __syncthreads();
    XcdBarrier bar = xcd_barrier_post((unsigned*)(args.ws + WS_CTL) + CW_BAR + args.li * XCD_BAR_WORDS, MISC + 8);
    const int lo = args.ph_lo, hi = args.ph_hi;

#define IN(k) (lo <= (k) && (k) < hi)
#ifdef PROBE_BW
#define SEAM(k) do { if ((k) + 1 < hi) { unsigned long long t0_ = 0; const bool hit_ = ((((PROBE_BW) >> (k)) & 1ull) != 0ull) && blockIdx.x == TS_BLOCK && F.tid == 0; if (hit_) t0_ = __builtin_amdgcn_s_memrealtime(); \
    xcd_barrier(bar); if (hit_) { GAS unsigned long long* tw = (GAS unsigned long long*)(args.ws + 65536); tw[5] += __builtin_amdgcn_s_memrealtime() - t0_; } } } while (0)
#else
#define SEAM(k) do { if ((k) + 1 < hi) xcd_barrier(bar); } while (0)
#endif
    unsigned char* ws = args.ws;
    const float* T128 = (const float*)(ws + WS_TAB); const float* T64 = (const float*)(ws + WS_TAB + 16384);
    bf16* U = (bf16*)(ws + WS_U); bf16* Y = (bf16*)(ws + WS_Y); float* YP = (float*)(ws + WS_YP); bf16* O = (bf16*)(ws + WS_O); bf16* R1 = (bf16*)(ws + WS_R1);
    const int bx = (int)blockIdx.x;
#define GEMM_ALL(Abuf, lda_, Wt, N_, K_, EpiT, ...) do { pg8::Gemm g{(const bf16*)(Abuf), (const bf16*)(Wt), MROWS, (N_), (K_), (lda_)}; pg8::StaticOrder S; S.init(MROWS, (N_), (K_), F.G, bx); \
        EpiT E{__VA_ARGS__}; pg8::gemm_phase<EpiT, pg8::StaticOrder>(F.lds, g, S, E, GPROBE); } while (0)
#define GEMM_REV(Abuf, lda_, Wt, N_, K_, EpiT, ...) do { pg8::Gemm g{(const bf16*)(Abuf), (const bf16*)(Wt), MROWS, (N_), (K_), (lda_)}; pg8::StaticOrder S; S.init(MROWS, (N_), (K_), F.G, F.G - 1 - bx); \
        EpiT E{__VA_ARGS__}; pg8::gemm_phase<EpiT, pg8::StaticOrder>(F.lds, g, S, E, GPROBE); } while (0)
#define GEMM_LAT(Abuf, lda_, Wt, N_, K_, EpiT, ...) do { pg8::Gemm g{(const bf16*)(Abuf), (const bf16*)(Wt), MROWS, (N_), (K_), (lda_)}; pg8::LatentOrder S; S.init(NBATCH * SEQ, (N_), (K_), F.G, bx); \
        EpiT E{__VA_ARGS__}; pg8::gemm_phase<EpiT, pg8::LatentOrder>(F.lds, g, S, E); } while (0)
#define GEMM_CSP(Abuf, lda_, Wt, N_, K_, S_, EpiT, ...) do { pg8::Gemm g{(const bf16*)(Abuf), (const bf16*)(Wt), MROWS, (N_), (K_), (lda_)}; pg8::CtxSplitOrder S; S.init(NBATCH * SEQ, (N_), (K_), F.G, bx); S.S = (S_); S.ntA = ((K_) / 64 / ((S_) / 2) / 2 + 1) & ~1; S.ntB = (K_) / 64 / ((S_) / 2) - S.ntA; \
        EpiT E{__VA_ARGS__}; pg8::gemm_phase<EpiT, pg8::CtxSplitOrder>(F.lds, g, S, E); } while (0)
#define TAILCVT(MASK_, nunits_) do { const int rem_ = (nunits_) % F.G; convert_jobs<(MASK_)>(F, args, rem_ ? bx - rem_ : bx, rem_ ? F.G - rem_ : F.G); } while (0)
#define TAIL3() do { const int rem_ = (68 * 12) % F.G, ic_ = rem_ ? bx - rem_ : bx, ni_ = rem_ ? F.G - rem_ : F.G, nA_ = (ni_ * 109 + 104) / 208; \
        if (ni_ < 2 || nA_ < 1 || nA_ >= ni_) { convert_jobs<(1u << 10) | (1u << 14)>(F, args, ic_, ni_); mod_partials<1, 1>(F, args, ic_, ni_); } \
        else { convert_jobs<(1u << 10)>(F, args, (ic_ >= 0 && ic_ < nA_) ? ic_ : -1, nA_); \
               convert_jobs<(1u << 14)>(F, args, ic_ >= nA_ ? ic_ - nA_ : -1, ni_ - nA_); mod_partials<1, 1>(F, args, ic_ >= nA_ ? ic_ - nA_ : -1, ni_ - nA_); } } while (0)
#define TAILMODP(L_, nunits_) do { const int rem_ = (nunits_) % F.G; mod_partials<((L_) < 0 ? 0 : (L_)), ((L_) < 0 ? 0 : 1)>(F, args, rem_ ? bx - rem_ : bx, rem_ ? F.G - rem_ : F.G); } while (0)
#define TAILMODR(L_, nunits_) do { const int rem_ = (nunits_) % F.G; mod_reduce<((L_) < 0 ? 0 : (L_)), ((L_) < 0 ? 0 : 1)>(F, args, rem_ ? bx - rem_ : bx, rem_ ? F.G - rem_ : F.G); } while (0)
#ifdef PROBE_THIN
#define THIN_DRY(x) do { x; xcd_barrier(bar); } while (0)
#else
#define THIN_DRY(x) do { } while (0)
#endif
#ifdef PROBE_COLD
#define COLD_DUP(l, x) do { if ((l) == PROBE_COLD) { x; xcd_barrier(bar); } } while (0)
#else
#define COLD_DUP(l, x) do { } while (0)
#endif
#ifdef PROBE_TS
#define TS_HIT(k) ((PROBE_TS >= 0) ? ((k) == PROBE_TS) : (((PROBE_TSMASK) >> (k)) & 1ull) != 0ull)
#define TS_A(k) do { if (TS_HIT(k) && blockIdx.x == TS_BLOCK && F.tid == 0) { GAS unsigned long long* tw = (GAS unsigned long long*)(args.ws + 65536); tw[0] = __builtin_amdgcn_s_memrealtime(); tw[1] = __builtin_readcyclecounter(); } } while (0)
#define TS_B(k) do { if (TS_HIT(k) && blockIdx.x == TS_BLOCK && F.tid == 0) { GAS unsigned long long* tw = (GAS unsigned long long*)(args.ws + 65536); const unsigned long long r_ = __builtin_amdgcn_s_memrealtime(), c_ = __builtin_readcyclecounter(); \
    tw[2] = r_; tw[3] = c_; tw[5] += r_ - tw[0]; tw[6] += c_ - tw[1]; } } while (0)
#else
#define TS_A(k) do { } while (0)
#define TS_B(k) do { } while (0)
#endif
#define PHASE(k, ...) do { if (IN(k)) { TS_A(k); __VA_ARGS__; TS_B(k); if (PROBE_DUP == (k)) { xcd_barrier(bar); __VA_ARGS__; } SEAM(k); } } while (0)
#define FFN_PART(l, p0) do { \
        PHASE((p0) + 0, THIN_DRY(thin_phase<1>(F, args, (l), 0, false, WO_SPLIT, true)); thin_phase<1>(F, args, (l), 0, false, WO_SPLIT)); \
        PHASE((p0) + 1, COLD_DUP(l, GEMM_ALL(U, DM, ws + W_GU + (size_t)(((l) + 1) & 3) * 44 * MiB, 2 * FF, DM, pg8::EpiSwiGLU, R1, FF)); GEMM_ALL(U, DM, ws + W_GU + (size_t)(l) * 44 * MiB, 2 * FF, DM, pg8::EpiSwiGLU, R1, FF); TAILCVT(cvm_ffn1(l), 68 * 44); TAILMODP(((l) >= 1) ? (l) + 1 : -1, 68 * 44); TAILMODR(((l) == 0) ? 1 : -1, 68 * 44)); \
        PHASE((p0) + 2, GEMM_CSP(R1, FF, ws + W_DOWN + (size_t)(l) * 22 * MiB, DM, FF, DN_SPLIT, pg8::EpiF32, Y, DM, YP); TAILCVT(cvm_ffn2(l), 64 * 8 + 4 * 8 * DN_SPLIT); TAILMODR(((l) >= 1) ? (l) + 1 : -1, 64 * 8 + 4 * 8 * DN_SPLIT)); \
        PHASE((p0) + 3, THIN_DRY(thin_phase<1>(F, args, (l), 1, false, DN_SPLIT, true)); thin_phase<1>(F, args, (l), 1, false, DN_SPLIT)); } while (0)

    PHASE(0, p0a(F, args));
    PHASE(1, p0b(F, args));
    PHASE(2, thin_phase<0>(F, args, 0, 0, false, 0));
#ifdef PROBE_XBAR
#define XB4 xcd_barrier(bar); xcd_barrier(bar); xcd_barrier(bar); xcd_barrier(bar);
    XB4 XB4 XB4 XB4 XB4 XB4 XB4 XB4 XB4 XB4
#endif
    PHASE(3, GEMM_ALL(U, DM, ws + W_SWA_QKV, 3072, DM, pg8::EpiQKV, R1, 3072, 8, 10, 0.08838834764831845f, T128, nullptr, nullptr, 0, 1);
             TAIL3());
    PHASE(4, attn_swa_phase(F, args));
    PHASE(5, GEMM_CSP(O, DM, ws + W_SWA_O, DM, DM, WO_SPLIT, pg8::EpiF32, Y, DM, YP));
    FFN_PART(0, 6);
    PHASE(10, GEMM_ALL(U, DM, ws + W_DIFF_QKV, 6144, DM, pg8::EpiQKV, R1, 2048, 8, 16, 0.08838834764831845f, T128, (bf16*)(ws + R1_KH), (bf16*)(ws + R1_VH), 16, 2);
              TAILCVT((1u << 11) | (1u << 4) | (1u << 5) | (1u << 6), 68 * 24));
    PHASE(11, attn_diff_phase(F));
    PHASE(13, GEMM_CSP(O, DM, ws + W_DIFF_O, DM, DM, WO_SPLIT, pg8::EpiF32, Y, DM, YP));
    FFN_PART(1, 14);
    PHASE(18, GEMM_ALL(U, DM, ws + W_MLA_DOWN, 1280, DM, pg8::EpiMlaDown, (bf16*)(ws + R1_MLA_C), (bf16*)(ws + R1_MLA_KPE), (float*)(ws + WS_SSQ), T64);
              TAILCVT((1u << 12) | (1u << 17), 68 * 5));
    PHASE(19, GEMM_ALL(ws + R1_MLA_C, 1024, ws + W_MLA_UQ, 3072, 512, pg8::EpiMlaUp<true>, (bf16*)(ws + R1_MLA_Q), 3072, (const float*)(ws + WS_SSQ), 0, 0.07216878364870323f, T64);
              GEMM_REV(ws + R1_MLA_C + 1024, 1024, ws + W_MLA_UKV, 4096, 512, pg8::EpiMlaUp<false>, (bf16*)(ws + R1_MLA_KV), 4096, (const float*)(ws + WS_SSQ), 1, 1.f, T64));
    PHASE(20, attn_mla_phase(F));
    PHASE(21, GEMM_CSP(O, DM, ws + W_MLA_O, DM, DM, WO_SPLIT, pg8::EpiF32, Y, DM, YP));
    FFN_PART(2, 22);
    PHASE(26, GEMM_ALL(U, DM, ws + W_NA_QKV, 6144, DM, pg8::EpiQKV, R1, 6144, 8, 0, 0.08838834764831845f, T128, nullptr, nullptr, 0, 1);
              TAILCVT((1u << 13) | (1u << 9), 68 * 24));
    PHASE(27, attn_na_phase(F, args));
    PHASE(28, GEMM_LAT(O, DM, ws + W_NA_O, DM, DM, pg8::EpiF32, Y, DM, YP));
    PHASE(29, thin_phase<1>(F, args, 3, 0, true, 0));
    PHASE(30, GEMM_LAT(U, DM, ws + W_GU + (size_t)3 * 44 * MiB, 2 * FF, DM, pg8::EpiSwiGLU, R1, FF));
    PHASE(31, GEMM_LAT(R1, FF, ws + W_DOWN + (size_t)3 * 22 * MiB, DM, FF, pg8::EpiF32, Y, DM, YP));
    PHASE(32, thin_phase<2>(F, args, 3, 1, true, 0));
#ifdef PROBE_TS
    xcd_barrier(bar);
    if (blockIdx.x == TS_BLOCK && F.tid == 0) { const GAS unsigned long long* tw = (const GAS unsigned long long*)(args.ws + 65536); const float dr = (float)tw[5], dc = (float)tw[6];
        float v = 0.f;
        if (TS_KIND == 0) v = dr * 0.01f;
        if (TS_KIND == 1) v = dc / dr * 100.f;
        if (TS_KIND == 3) v = (float)tw[4] * 0.01f;
        const unsigned long long t0 = __builtin_amdgcn_s_memrealtime(), dt = (unsigned long long)(v * TS_SCALE * 100.f);
        while (__builtin_amdgcn_s_memrealtime() - t0 < dt && dt < 2000000ull) __builtin_amdgcn_s_sleep(8); }
#endif
#undef IN
#undef SEAM
}

#ifndef MK_PER_PHASE
#define MK_PER_PHASE 0
#endif
extern "C" void kernel_launch(void* const* d_in, const int* in_sizes, int n_in, void* d_out, int out_size, void* d_ws, size_t ws_size, hipStream_t stream) {
    static int grid = 0;
    if (grid == 0) {
        if (n_in != N_IN || in_sizes[0] != NBATCH * SEQ * DM || out_size != NBATCH * SEQ * DM || ws_size < WS_END) {
            fprintf(stderr, "kernel_launch: shape mismatch (n_in %d, in0 %d, out %d, ws %zu, need %zu)\n", n_in, n_in > 0 ? in_sizes[0] : -1, out_size, ws_size, (size_t)WS_END); grid = -1; return; }
        int dev = 0, cus = 0, per_cu = 0;
        if (hipGetDevice(&dev) != hipSuccess || hipDeviceGetAttribute(&cus, hipDeviceAttributeMultiprocessorCount, dev) != hipSuccess) { grid = -1; return; }
        if (hipFuncSetAttribute((const void*)fwd_kernel, hipFuncAttributeMaxDynamicSharedMemorySize, LDS_BYTES) != hipSuccess) { fprintf(stderr, "kernel_launch: hipFuncSetAttribute failed\n"); grid = -1; return; }
        if (hipOccupancyMaxActiveBlocksPerMultiprocessor(&per_cu, (const void*)fwd_kernel, NWAVES * 64, LDS_BYTES) != hipSuccess || per_cu < 1) { fprintf(stderr, "kernel_launch: occupancy query says %d\n", per_cu); }
        (void)hipGetLastError();
        grid = cus;
    }
    if (grid < 0) return;
    if (hipMemsetAsync((char*)d_ws + WS_CTL, 0, CTL_ZERO_BYTES, stream) != hipSuccess) return;
    Args a{};
    for (int i = 0; i < N_IN; ++i) a.in[i] = (const float*)d_in[i];
    a.out = (float*)d_out; a.ws = (unsigned char*)d_ws;
#if MK_PER_PHASE
    for (int p = 0; p < NPH; ++p) { a.ph_lo = p; a.ph_hi = p + 1; a.li = 0; hipLaunchKernelGGL(fwd_kernel, dim3(grid), dim3(NWAVES * 64), LDS_BYTES, stream, a); }
#else
    a.ph_lo = 0; a.ph_hi = NPH; a.li = 0;
    hipLaunchKernelGGL(fwd_kernel, dim3(grid), dim3(NWAVES * 64), LDS_BYTES, stream, a);
#endif
    const hipError_t le = hipPeekAtLastError();
    if (le != hipSuccess) fprintf(stderr, "kernel_launch: launch failed: %s\n", hipGetErrorName(le));
}
```

```cpp
#include <hip/hip_runtime.h>
#include <cstdio>
#include <cstdint>

#define GAS __attribute__((address_space(1)))
#define LAS __attribute__((address_space(3)))
typedef unsigned short bf16;
typedef unsigned v4u __attribute__((ext_vector_type(4)));
typedef float f32x4 __attribute__((ext_vector_type(4)));
typedef float f32x2 __attribute__((ext_vector_type(2)));
typedef float f32x16 __attribute__((ext_vector_type(16)));
typedef short bf16x8 __attribute__((ext_vector_type(8)));
typedef short s16x4 __attribute__((ext_vector_type(4)));
typedef GAS unsigned gu32;

constexpr int DM = 2048, NBATCH = 4, SEQ = 4096, CTXL = 256, TPB = SEQ + CTXL  ;
constexpr int MROWS = NBATCH * TPB  , FF = 5632, NLAYER = 4, MODW = 6 * DM  ;
constexpr float EPS = 1e-6f;
constexpr float LOG2E = 1.4426950408889634f;

__device__ __forceinline__ unsigned cvt_pk_bf16(float lo, float hi) { unsigned r; asm volatile("v_cvt_pk_bf16_f32 %0, %1, %2" : "=v"(r) : "v"(lo), "v"(hi)); return r; }
__device__ __forceinline__ float bf2f(unsigned short h) { return __builtin_bit_cast(float, (unsigned)h << 16); }

namespace pg8 {
typedef unsigned short bf16_t;
constexpr int BM = 256, BK = 64, HALF = 128, HTB = HALF * BK * 2, STAGE_BYTES = 8 * HTB, NXCD = 8, WGM = 8;
__host__ __device__ __forceinline__ int lds_byte(int r, int c) { const int st = (r >> 4) * 2 + (c >> 5), rr = r & 15, cc = c & 31, ob = rr * 64 + cc * 2; return st * 1024 + (ob ^ (((ob >> 9) & 1) << 5)); }
__host__ __device__ __forceinline__ void stage_rc(int b, int& R, int& C) { const int st = b / 1024, sb = b % 1024, swz = sb ^ (((sb >> 9) & 1) << 5); R = (st >> 1) * 16 + swz / 64; C = (st & 1) * 32 + (swz % 64) / 2; }
__host__ __device__ __forceinline__ int perm32(int rho) { const int n = rho >> 4, i = rho & 15; return 8 * (i >> 2) + 4 * n + (i & 3); }

struct Unit { int pm, pn, ks, koff, nt; };
struct Gemm { const bf16_t* A; const bf16_t* Bt; int M, N, K, lda; };

struct StaticOrder {
    int nM, nN, nwg, G, c, ntK;
    __host__ __device__ void init(int M, int N, int K, int G_, int c_) { nM = M / BM; nN = N / BM; nwg = nM * nN; G = G_; c = c_; ntK = K / BK; }
    static constexpr bool TICKET = false;
    __host__ __device__ bool next(int i, Unit& u) const { return at((long)i * G + c, u); }
    __host__ __device__ bool at(const long L, Unit& u) const {
        if (L >= nwg) return false;
        u.ks = -1; u.koff = 0; u.nt = ntK;
        int wgid = (int)L; { const int q = nwg / NXCD, r = nwg % NXCD, xcd = wgid % NXCD, off = wgid / NXCD; wgid = (xcd < r ? xcd * (q + 1) : r * (q + 1) + (xcd - r) * q) + off; }
        const int nig = WGM * nN, gid = wgid / nig, fm = gid * WGM, gsz = (nM - fm) < WGM ? (nM - fm) : WGM;
        u.pm = fm + ((wgid % nig) % gsz); u.pn = (wgid % nig) / gsz; return true;
    }
};
struct TicketOrder : StaticOrder {
    static constexpr bool TICKET = true;
    unsigned* ctr; volatile LAS unsigned* tkl; int nfull, rem, tdraw;
    __device__ bool next(int i, Unit& u) const {
        if (i < nfull) return StaticOrder::next(i, u);
        if (i > nfull) return false;
        const int t = __builtin_amdgcn_readfirstlane((int)*tkl); if (t >= rem) return false;
        return at((long)nfull * G + t, u);
    }
};
struct LatentOrder : StaticOrder {
    __host__ __device__ bool next(int i, Unit& u) const { if (!StaticOrder::next(i, u)) return false; u.pm = u.pm + (u.pm >> 4) + 1; return true; }
};
struct CtxSplitOrder : LatentOrder {
    int S, ntA, ntB;
    __host__ __device__ bool next(int i, Unit& u) const {
        if (LatentOrder::next(i, u)) return true;
        const long s = (long)i * G + c - nwg; if (s < 0 || s >= (long)4 * nN * S) return false;
        const int ks = (int)(s % S), t = (int)(s / S); u.pn = t % nN; u.pm = (t / nN) * 17; u.ks = ks;
        u.koff = ((ks >> 1) * (ntA + ntB) + (ks & 1) * ntA) * BK * 2; u.nt = (ks & 1) ? ntB : ntA; return true;
    }
};

__device__ __forceinline__ void rope2(f32x4& v, const f32x4 t) {
    const float a0 = v[0] * t[0] - v[1] * t[1], a1 = v[0] * t[1] + v[1] * t[0], a2 = v[2] * t[2] - v[3] * t[3], a3 = v[2] * t[3] + v[3] * t[2];
    v = (f32x4){a0, a1, a2, a3};
}
__device__ __forceinline__ v4u pack8(const f32x4 v0, const f32x4 v1) { v4u w; w.x = cvt_pk_bf16(v0[0], v0[1]); w.y = cvt_pk_bf16(v0[2], v0[3]); w.z = cvt_pk_bf16(v1[0], v1[1]); w.w = cvt_pk_bf16(v1[2], v1[3]); return w; }
struct EpiF32 {
    static constexpr bool PERM = true;
    bf16_t* O; int ldc; float* YP;
    __device__ __forceinline__ void operator()(const f32x4 (&acc)[2][2][4][2], const Unit& u, int wr, int wc, int fr, int fq) const {
        const int col0 = u.pn * BM + wc * 32 + 8 * fq;
        if (u.ks >= 0) { const int row0 = u.ks * 1024 + (u.pm / 17) * BM + wr * 64 + fr;
#pragma unroll
            for (int ai = 0; ai < 2; ++ai)
#pragma unroll
                for (int m = 0; m < 4; ++m) { GAS float* rowp = (GAS float*)YP + (size_t)(row0 + ai * HALF + m * 16) * ldc + col0;
#pragma unroll
                    for (int bj = 0; bj < 2; ++bj)
#pragma unroll
                        for (int n = 0; n < 2; ++n) *(GAS f32x4*)(rowp + bj * HALF + n * 4) = acc[ai][bj][m][n]; }
        } else { const int row0 = u.pm * BM + wr * 64 + fr;
#pragma unroll
            for (int ai = 0; ai < 2; ++ai)
#pragma unroll
                for (int m = 0; m < 4; ++m) { GAS bf16_t* rowp = (GAS bf16_t*)O + (size_t)(row0 + ai * HALF + m * 16) * ldc + col0;
#pragma unroll
                    for (int bj = 0; bj < 2; ++bj) *(GAS v4u*)(rowp + bj * HALF) = pack8(acc[ai][bj][m][0], acc[ai][bj][m][1]); }
        }
    }
};
struct EpiQKV {
    static constexpr bool PERM = true;
    bf16_t* O; int ldc, nq, nrope; float qscale; const float* tab;
    bf16_t* KH; bf16_t* VH; int nk, gv;
    __device__ __forceinline__ void operator()(const f32x4 (&acc)[2][2][4][2], const Unit& u, int wr, int wc, int fr, int fq) const {
        const int row0 = u.pm * BM + wr * 64 + fr, col0 = u.pn * BM + wc * 32 + 8 * fq;
        const float sc = (u.pn < nq) ? qscale : 1.f;
        const int pb = u.pm % 17; const bool rope = (u.pn < nrope) && (pb != 0);
        const GAS f32x4* T = (const GAS f32x4*)tab;
        const bool hm = (KH != nullptr) && (u.pn >= nq);
#pragma unroll
        for (int ai = 0; ai < 2; ++ai)
#pragma unroll
            for (int m = 0; m < 4; ++m) { const int row = row0 + ai * HALF + m * 16;
                const int pos = (wc < 2) ? (4 * (pb - 1) + 2 * ai + wr) : (16 * m + fr);
#pragma unroll
                for (int bj = 0; bj < 2; ++bj) { f32x4 v0 = acc[ai][bj][m][0] * sc, v1 = acc[ai][bj][m][1] * sc;
                    if (rope) { const int k0 = 8 * (wc & 1) + 2 * fq; rope2(v0, T[pos * 16 + k0]); rope2(v1, T[pos * 16 + k0 + 1]); }
                    GAS bf16_t* dst;
                    if (!hm) dst = (GAS bf16_t*)O + (size_t)row * ldc + col0 + bj * HALF;
                    else { const int ci = (u.pn - nq) * 2 + bj, cc = wc * 32 + 8 * fq;
                        if (ci < nk) dst = (GAS bf16_t*)KH + ((size_t)ci * MROWS + row) * 128 + cc;
                        else { const int cv = ci - nk, hd = cv / gv, part = cv - hd * gv; dst = (GAS bf16_t*)VH + ((size_t)hd * MROWS + row) * (128 * gv) + part * 128 + cc; } }
                    *(GAS v4u*)dst = pack8(v0, v1); } }
    }
};
struct EpiSwiGLU {
    static constexpr bool PERM = true;
    bf16_t* O; int ldc;
    __device__ __forceinline__ void operator()(const f32x4 (&acc)[2][2][4][2], const Unit& u, int wr, int wc, int fr, int fq) const {
        const int row0 = u.pm * BM + wr * 64 + fr, col0 = u.pn * HALF + wc * 32 + 8 * fq;
#pragma unroll
        for (int ai = 0; ai < 2; ++ai)
#pragma unroll
            for (int m = 0; m < 4; ++m) { GAS bf16_t* rowp = (GAS bf16_t*)O + (size_t)(row0 + ai * HALF + m * 16) * ldc + col0;
                f32x4 o[2];
#pragma unroll
                for (int n = 0; n < 2; ++n) { const f32x4 g = acc[ai][0][m][n], up = acc[ai][1][m][n];
#pragma unroll
                    for (int e = 0; e < 4; ++e) { const float s = __builtin_amdgcn_rcpf(1.f + __builtin_amdgcn_exp2f(-g[e] * LOG2E)); o[n][e] = g[e] * s * up[e]; } }
                *(GAS v4u*)rowp = pack8(o[0], o[1]); }
    }
};
struct EpiMlaDown {
    static constexpr bool PERM = true;
    bf16_t* C; bf16_t* KPE; float* SSQ; const float* tab64;
    __device__ __forceinline__ void operator()(const f32x4 (&acc)[2][2][4][2], const Unit& u, int wr, int wc, int fr, int fq) const {
        const int row0 = u.pm * BM + wr * 64 + fr; const int pb = u.pm % 17;
        if (u.pn < 4) {
            const int col0 = u.pn * BM + wc * 32 + 8 * fq;
#pragma unroll
            for (int ai = 0; ai < 2; ++ai)
#pragma unroll
                for (int m = 0; m < 4; ++m) { const int row = row0 + ai * HALF + m * 16; GAS bf16_t* rowp = (GAS bf16_t*)C + (size_t)row * 1024 + col0; float ss = 0.f;
#pragma unroll
                    for (int bj = 0; bj < 2; ++bj) { const f32x4 v0 = acc[ai][bj][m][0], v1 = acc[ai][bj][m][1];
                        ss += (v0[0] * v0[0] + v0[1] * v0[1]) + (v0[2] * v0[2] + v0[3] * v0[3]) + (v1[0] * v1[0] + v1[1] * v1[1]) + (v1[2] * v1[2] + v1[3] * v1[3]);
                        *(GAS v4u*)(rowp + bj * HALF) = pack8(v0, v1); }
                    ss += __shfl_xor(ss, 16); ss += __shfl_xor(ss, 32);
                    if (fq == 0) ((GAS float*)SSQ)[(size_t)row * 16 + u.pn * 4 + wc] = ss; }
        } else if (wc < 2) {
            const GAS f32x4* T = (const GAS f32x4*)tab64;
#pragma unroll
            for (int ai = 0; ai < 2; ++ai)
#pragma unroll
                for (int m = 0; m < 4; ++m) { const int row = row0 + ai * HALF + m * 16; f32x4 v0 = acc[ai][0][m][0], v1 = acc[ai][0][m][1];
                    if (pb != 0) { const int pos = (wc == 0) ? (4 * (pb - 1) + 2 * ai + wr) : (16 * m + fr); rope2(v0, T[pos * 8 + 2 * fq]); rope2(v1, T[pos * 8 + 2 * fq + 1]); }
                    *(GAS v4u*)((GAS bf16_t*)KPE + (size_t)row * 64 + wc * 32 + 8 * fq) = pack8(v0, v1); }
        }
    }
};
template <bool ROPE> struct EpiMlaUp {
    static constexpr bool PERM = true;
    bf16_t* O; int ldc; const float* SSQ; int which; float scale; const float* tab64;
    __device__ __forceinline__ void operator()(const f32x4 (&acc)[2][2][4][2], const Unit& u, int wr, int wc, int fr, int fq) const {
        const int row0 = u.pm * BM + wr * 64 + fr, col0 = u.pn * BM + wc * 32 + 8 * fq; const int pb = u.pm % 17;
        const GAS f32x4* T = (const GAS f32x4*)tab64;
#pragma unroll
        for (int ai = 0; ai < 2; ++ai)
#pragma unroll
            for (int m = 0; m < 4; ++m) { const int row = row0 + ai * HALF + m * 16; GAS bf16_t* rowp = (GAS bf16_t*)O + (size_t)row * ldc + col0;
                const GAS f32x4* sp = (const GAS f32x4*)((const GAS float*)SSQ + (size_t)row * 16 + which * 8); const f32x4 s0 = sp[0], s1 = sp[1];
                const float ss = ((s0[0] + s0[1]) + (s0[2] + s0[3])) + ((s1[0] + s1[1]) + (s1[2] + s1[3]));
                const float rs = __builtin_amdgcn_rsqf(ss * (1.f / 512.f) + EPS) * scale;
#pragma unroll
                for (int bj = 0; bj < 2; ++bj) { f32x4 v0 = acc[ai][bj][m][0] * rs, v1 = acc[ai][bj][m][1] * rs;
                    if (ROPE) { const int g = (u.pn * BM + bj * HALF + wc * 32) % 192;
                        if (g >= 128 && pb != 0) { const int pos = (g == 128) ? (4 * (pb - 1) + 2 * ai + wr) : (16 * m + fr); rope2(v0, T[pos * 8 + 2 * fq]); rope2(v1, T[pos * 8 + 2 * fq + 1]); } }
                    *(GAS v4u*)(rowp + bj * HALF) = pack8(v0, v1); } }
    }
};

template <class Epi, class Sched>
__device__ __forceinline__ void gemm_phase(LAS unsigned char* lds, const Gemm g, const Sched& S, const Epi& E, unsigned char* g_probe = nullptr) {
    const int tid = threadIdx.x, wid = __builtin_amdgcn_readfirstlane(tid >> 6), lane = tid & 63, wr = wid >> 2, wc = wid & 3, fr = lane & 15, fq = lane >> 4;
    const int K = g.K, lda = g.lda;
    unsigned voffA[2], voffB[2];
#pragma unroll
    for (int i = 0; i < 2; ++i) { int R, C; stage_rc(tid * 16 + i * 8192, R, C); const int Rb = Epi::PERM ? ((R & ~31) + perm32(R & 31)) : R;
        voffA[i] = (unsigned)(R * lda + C) * 2u; voffB[i] = (unsigned)(Rb * K + C) * 2u; }
    const size_t kstep = (size_t)(BK * 2);
    const size_t hsA = (size_t)HALF * lda * 2, hsB = (size_t)HALF * K * 2;
    const size_t tsA = 2 * hsA, tsB = 2 * hsB;
    const unsigned ldsw = (unsigned)wid * 1024u;
    const int aoff = lds_byte(wr * 64 + fr, fq * 8), boff = lds_byte(wc * 32 + fr, fq * 8);
#define PG8_SA(b, h) (((b) * 2 + (h)) * HTB)
#define PG8_SB(b, h) ((4 + (b) * 2 + (h)) * HTB)
#define PG8_STAGE(bufoff, gbase, voff) do { _Pragma("unroll") for (int _i = 0; _i < 2; ++_i) \
        __builtin_amdgcn_global_load_lds((const unsigned*)((const char*)(gbase) + (voff)[_i]), (LAS unsigned*)(lds + (bufoff) + ldsw + _i * 8192), 16, 0, 0); } while (0)
#define PG8_LDA(dst, b, h) do { _Pragma("unroll") for (int m = 0; m < 4; ++m) _Pragma("unroll") for (int k = 0; k < 2; ++k) dst[m][k] = *(const LAS bf16x8*)(lds + PG8_SA(b, h) + aoff + m * 2048 + k * 1024); } while (0)
#define PG8_LDB(dst, b, h) do { _Pragma("unroll") for (int n = 0; n < 2; ++n) _Pragma("unroll") for (int k = 0; k < 2; ++k) dst[n][k] = *(const LAS bf16x8*)(lds + PG8_SB(b, h) + boff + n * 2048 + k * 1024); } while (0)
#define PG8_MMA(ai, bj, At, Bt) do { __builtin_amdgcn_s_setprio(1); _Pragma("unroll") for (int m = 0; m < 4; ++m) _Pragma("unroll") for (int n = 0; n < 2; ++n) _Pragma("unroll") for (int k = 0; k < 2; ++k) \
        acc[ai][bj][m][n] = __builtin_amdgcn_mfma_f32_16x16x32_bf16(Bt[n][k], At[m][k], acc[ai][bj][m][n], 0, 0, 0); __builtin_amdgcn_s_setprio(0); } while (0)
#define PG8_WAIT_V(n) asm volatile("s_waitcnt vmcnt(" #n ")" ::: "memory")
#define PG8_WAIT_L(n) asm volatile("s_waitcnt lgkmcnt(" #n ")" ::: "memory")
#define PG8_BAR __builtin_amdgcn_s_barrier()
#define PG8_SCHED __builtin_amdgcn_sched_barrier(0)
    Unit cur, nxt; int ui = 0;
    if (!S.next(0, cur)) return;
    f32x4 acc[2][2][4][2];
#pragma unroll
    for (int a = 0; a < 2; ++a)
#pragma unroll
        for (int b = 0; b < 2; ++b)
#pragma unroll
            for (int m = 0; m < 4; ++m)
#pragma unroll
                for (int n = 0; n < 2; ++n) acc[a][b][m][n] = (f32x4){0.f, 0.f, 0.f, 0.f};
    bf16x8 At[4][2], B0[2][2], B1[2][2];
    const char* cA = (const char*)g.A + (size_t)cur.pm * tsA + cur.koff; const char* cB = (const char*)g.Bt + (size_t)cur.pn * tsB + cur.koff;
    PG8_STAGE(PG8_SB(0, 0), cB, voffB); PG8_STAGE(PG8_SB(0, 1), cB + hsB, voffB); PG8_STAGE(PG8_SA(0, 0), cA, voffA); PG8_STAGE(PG8_SA(0, 1), cA + hsA, voffA);
    if (wr == 1) PG8_BAR;
    PG8_WAIT_V(2); PG8_BAR;
    PG8_STAGE(PG8_SB(1, 0), cB + kstep, voffB); PG8_STAGE(PG8_SA(1, 0), cA + kstep, voffA); PG8_STAGE(PG8_SB(1, 1), cB + hsB + kstep, voffB);
    PG8_WAIT_V(6); PG8_BAR;
    for (;;) {
        const bool has_next = S.next(ui + 1, nxt);
        if constexpr (Sched::TICKET) { if (ui == S.tdraw && tid == 0) *S.tkl = __hip_atomic_fetch_add(S.ctr, 1u, __ATOMIC_RELAXED, __HIP_MEMORY_SCOPE_AGENT); }
        const char* nA = has_next ? (const char*)g.A + (size_t)nxt.pm * tsA + nxt.koff : cA; const char* nB = has_next ? (const char*)g.Bt + (size_t)nxt.pn * tsB + nxt.koff : cB;
        const int nt = cur.nt;
        for (int t = 0; t < nt; t += 2) {
            const bool last = (t == nt - 2);
            const char* a1 = cA + (size_t)(t + 1) * kstep;
            const char* a2 = last ? nA : cA + (size_t)(t + 2) * kstep; const char* b2 = last ? nB : cB + (size_t)(t + 2) * kstep;
            const char* a3 = a2 + kstep; const char* b3 = b2 + kstep;
            PG8_LDB(B0, 0, 0); PG8_LDB(B1, 0, 1); PG8_SCHED; PG8_LDA(At, 0, 0); PG8_STAGE(PG8_SA(1, 1), a1 + hsA, voffA);
            PG8_WAIT_V(8); PG8_WAIT_L(0); PG8_BAR; PG8_MMA(0, 0, At, B0); PG8_MMA(0, 1, At, B1); PG8_BAR; PG8_SCHED;
            PG8_LDA(At, 0, 1); PG8_STAGE(PG8_SB(0, 0), b2, voffB); PG8_STAGE(PG8_SB(0, 1), b2 + hsB, voffB); PG8_STAGE(PG8_SA(0, 0), a2, voffA);
            PG8_WAIT_V(8); PG8_WAIT_L(0); PG8_BAR; PG8_MMA(1, 0, At, B0); PG8_MMA(1, 1, At, B1); PG8_BAR; PG8_SCHED;
            PG8_LDB(B0, 1, 0); PG8_LDB(B1, 1, 1); PG8_SCHED; PG8_LDA(At, 1, 0); PG8_STAGE(PG8_SA(0, 1), a2 + hsA, voffA);
            PG8_WAIT_V(8); PG8_WAIT_L(0); PG8_BAR; PG8_MMA(0, 0, At, B0); PG8_MMA(0, 1, At, B1); PG8_BAR; PG8_SCHED;
            PG8_LDA(At, 1, 1); PG8_STAGE(PG8_SB(1, 0), b3, voffB); PG8_STAGE(PG8_SB(1, 1), b3 + hsB, voffB); PG8_STAGE(PG8_SA(1, 0), a3, voffA);
            PG8_WAIT_V(8); PG8_WAIT_L(0); PG8_BAR; PG8_MMA(1, 0, At, B0); PG8_MMA(1, 1, At, B1); PG8_BAR; PG8_SCHED;
        }
#ifdef PROBE_EPI
        unsigned long long te0_ = __builtin_amdgcn_s_memrealtime();
#endif
        if (wr == 0) PG8_BAR;
        E(acc, cur, wr, wc, fr, fq);
#ifdef PROBE_EPI
        if (PROBE_EPI == 1) asm volatile("s_waitcnt vmcnt(0)" ::: "memory");
        if (blockIdx.x == 0 && tid == 0 && g_probe) { GAS unsigned long long* tw = (GAS unsigned long long*)g_probe; tw[5] += __builtin_amdgcn_s_memrealtime() - te0_; }
#endif
        if (!has_next) break;
#pragma unroll
        for (int a = 0; a < 2; ++a)
#pragma unroll
            for (int b = 0; b < 2; ++b)
#pragma unroll
                for (int m = 0; m < 4; ++m)
#pragma unroll
                    for (int n = 0; n < 2; ++n) acc[a][b][m][n] = (f32x4){0.f, 0.f, 0.f, 0.f};
        cur = nxt; cA = nA; cB = nB; ++ui;
        if (wr == 1) PG8_BAR;
    }
    PG8_WAIT_V(0);
    PG8_BAR;
#undef PG8_SA
#undef PG8_SB
#undef PG8_STAGE
#undef PG8_LDA
#undef PG8_LDB
#undef PG8_MMA
#undef PG8_WAIT_V
#undef PG8_WAIT_L
#undef PG8_BAR
#undef PG8_SCHED
}
}
namespace attn {
constexpr int NW = 8, QBLK = 32, KVBLK = 64;
constexpr int SHM_V = KVBLK * 128 * 2, SHM_K = KVBLK * 128 * 2, SHM_K2 = KVBLK * 64 * 2;
constexpr int L_V = 0, L_K = 2 * SHM_V, L_K2 = L_K + 2 * SHM_K, L_WS = L_K2 + 2 * SHM_K2, L_RPB = L_WS + NW * 64 * 4, L_Q2 = L_RPB + 2048, L_END = L_Q2 + NW * 4096;
constexpr float THR = 8.f;
#define KSWF(row) ((((row) & 7) | ((((row) >> 4) & 1) << 3)))
#define KSWZ(row, colB) ((row) * 256 + ((colB) ^ (KSWF(row) << 4)))
#define K2SWF(row) (((((row) >> 1) & 3) | ((((row) >> 4) & 1) << 2)))
#define K2SWZ(row, colB) ((row) * 128 + ((colB) ^ (K2SWF(row) << 4)))
#define SBAR() __builtin_amdgcn_sched_barrier(0)
__device__ __forceinline__ int crow(int r, int hi) { return (r & 3) + 8 * (r >> 2) + 4 * hi; }

struct Desc {
    const bf16* Q; const bf16* K; const bf16* V; const bf16* K2; bf16* O;
    int ldq, ldk, ldv, ldo;
    int row_ctx, row_lat;
    int NT, NTreal;
    float m0, l0;
    int a0, a1;
    const float* rpb;
    unsigned char* probe;
    const bf16* O1; float lam;
    int rot;
};

__device__ __forceinline__ void partialSM(f32x16& p0, f32x16& p1, float& m_reg, float& mn, float& alpha) {
  constexpr float C = LOG2E;
  float pmax = p0[0];
#pragma unroll
  for (int r = 1; r < 16; ++r) pmax = fmaxf(pmax, p0[r]);
#pragma unroll
  for (int r = 0; r < 16; ++r) pmax = fmaxf(pmax, p1[r]);
  { auto rr = __builtin_amdgcn_permlane32_swap(__float_as_uint(pmax), __float_as_uint(pmax), false, false);
    pmax = fmaxf(__uint_as_float(rr[0]), __uint_as_float(rr[1])); }
  if (__builtin_expect(__all(pmax - m_reg <= THR), 1)) { mn = m_reg; alpha = 1.f; }
  else { mn = fmaxf(m_reg, pmax); alpha = __builtin_amdgcn_exp2f((m_reg - mn) * C); m_reg = mn; }
  float mnC = -mn * C;
#pragma unroll
  for (int r = 0; r < 16; ++r) p0[r] = fmaf(p0[r], C, mnC);
#pragma unroll
  for (int r = 0; r < 16; ++r) p1[r] = fmaf(p1[r], C, mnC);
#pragma unroll
  for (int r = 0; r < 16; ++r) p0[r] = __builtin_amdgcn_exp2f(p0[r]);
}
__device__ __forceinline__ void finishSM(f32x16& p0, f32x16& p1, float alpha, float& l_reg, bf16x8& pa0, bf16x8& pa1, bf16x8& pa2, bf16x8& pa3) {
#pragma unroll
  for (int r = 0; r < 16; ++r) p1[r] = __builtin_amdgcn_exp2f(p1[r]);
  float ps = 0;
#pragma unroll
  for (int r = 0; r < 16; ++r) ps += p0[r];
#pragma unroll
  for (int r = 0; r < 16; ++r) ps += p1[r];
  { auto rr = __builtin_amdgcn_permlane32_swap(__float_as_uint(ps), __float_as_uint(ps), false, false);
    ps = __uint_as_float(rr[0]) + __uint_as_float(rr[1]); }
  l_reg = l_reg * alpha + ps;
#define PK4(P, BASE, OUT) do { unsigned a0 = cvt_pk_bf16(P[BASE + 0], P[BASE + 1]), a1 = cvt_pk_bf16(P[BASE + 2], P[BASE + 3]);   \
    unsigned b0 = cvt_pk_bf16(P[BASE + 4], P[BASE + 5]), b1 = cvt_pk_bf16(P[BASE + 6], P[BASE + 7]);                              \
    auto r0 = __builtin_amdgcn_permlane32_swap(a0, b0, false, false); auto r1 = __builtin_amdgcn_permlane32_swap(a1, b1, false, false); \
    v4u w = {r0[0], r1[0], r0[1], r1[1]}; OUT = __builtin_bit_cast(bf16x8, w); } while (0)
  PK4(p0, 0, pa0); PK4(p0, 8, pa1); PK4(p1, 0, pa2); PK4(p1, 8, pa3);
#undef PK4
}
template <bool K2, int NQR>
__device__ __forceinline__ void qkt(f32x16& p0, f32x16& p1, const LAS char* Ks, const LAS char* K2s, const bf16x8* qr, const LAS char* q2l, int r32, int hi) {
  p0 = f32x16{}; p1 = f32x16{};
#pragma unroll
  for (int d0 = 0; d0 < 8; ++d0) { int cb = (d0 * 16 + hi * 8) * 2;
    bf16x8 b0 = *(const LAS bf16x8*)(Ks + KSWZ(r32, cb));
    bf16x8 b1 = *(const LAS bf16x8*)(Ks + KSWZ(32 + r32, cb));
    bf16x8 q; if constexpr (true) { if (d0 < NQR) q = qr[d0 < NQR ? d0 : 0]; else q = *(const LAS bf16x8*)(q2l + (d0 - NQR) * 1024); }
    p0 = __builtin_amdgcn_mfma_f32_32x32x16_bf16(b0, q, p0, 0, 0, 0);
    p1 = __builtin_amdgcn_mfma_f32_32x32x16_bf16(b1, q, p1, 0, 0, 0); }
  if constexpr (K2) {
#pragma unroll
    for (int d0 = 0; d0 < 4; ++d0) { int cb = (d0 * 16 + hi * 8) * 2;
      bf16x8 b0 = *(const LAS bf16x8*)(K2s + K2SWZ(r32, cb));
      bf16x8 b1 = *(const LAS bf16x8*)(K2s + K2SWZ(32 + r32, cb));
      const bf16x8 q2 = *(const LAS bf16x8*)(q2l + (8 - NQR + d0) * 1024);
      p0 = __builtin_amdgcn_mfma_f32_32x32x16_bf16(b0, q2, p0, 0, 0, 0);
      p1 = __builtin_amdgcn_mfma_f32_32x32x16_bf16(b1, q2, p1, 0, 0, 0); }
  }
}
__device__ __forceinline__ int v_st(int k, int c) { const int kk = (k & ~0xC) | ((k & 4) << 1) | ((k & 8) >> 1); return ((kk >> 3) * 4 + (c >> 5)) * 512 + ((kk & 7) * 32 + (c & 31)) * 2; }
__device__ __forceinline__ int v_rd_base(int lane) { return ((lane & 3) << 3) | (((lane >> 2) & 3) << 6) | (((lane >> 4) & 1) << 5) | (((lane >> 5) & 1) << 8); }
constexpr int v_rd_off(int d0, int ks, int half) { return d0 * 512 + ks * 4096 + half * 2048; }
template <int OFF> __device__ __forceinline__ s16x4 tr_read(int vb) {
  s16x4 r; asm volatile("ds_read_b64_tr_b16 %0, %1 offset:%2" : "=&v"(r) : "v"(vb), "i"(OFF) : "memory"); return r;
}
template <int D0> __device__ __forceinline__ void pv_one(f32x16& od, int vb, bf16x8 pa0, bf16x8 pa1, bf16x8 pa2, bf16x8 pa3) {
  const s16x4 l0 = tr_read<v_rd_off(D0, 0, 0)>(vb), h0 = tr_read<v_rd_off(D0, 0, 1)>(vb), l1 = tr_read<v_rd_off(D0, 1, 0)>(vb), h1 = tr_read<v_rd_off(D0, 1, 1)>(vb);
  const s16x4 l2 = tr_read<v_rd_off(D0, 2, 0)>(vb), h2 = tr_read<v_rd_off(D0, 2, 1)>(vb), l3 = tr_read<v_rd_off(D0, 3, 0)>(vb), h3 = tr_read<v_rd_off(D0, 3, 1)>(vb);
  asm volatile("s_waitcnt lgkmcnt(0)" ::: "memory"); SBAR();
#define PK(L, H) (bf16x8){L[0], L[1], L[2], L[3], H[0], H[1], H[2], H[3]}
  od = __builtin_amdgcn_mfma_f32_32x32x16_bf16(pa0, PK(l0, h0), od, 0, 0, 0);
  od = __builtin_amdgcn_mfma_f32_32x32x16_bf16(pa1, PK(l1, h1), od, 0, 0, 0);
  od = __builtin_amdgcn_mfma_f32_32x32x16_bf16(pa2, PK(l2, h2), od, 0, 0, 0);
  od = __builtin_amdgcn_mfma_f32_32x32x16_bf16(pa3, PK(l3, h3), od, 0, 0, 0);
#undef PK
}
__device__ __forceinline__ void pv_d0(f32x16* o, int vb, bf16x8 pa0, bf16x8 pa1, bf16x8 pa2, bf16x8 pa3) {
  pv_one<0>(o[0], vb, pa0, pa1, pa2, pa3); pv_one<1>(o[1], vb, pa0, pa1, pa2, pa3); pv_one<2>(o[2], vb, pa0, pa1, pa2, pa3); pv_one<3>(o[3], vb, pa0, pa1, pa2, pa3);
}
__device__ __forceinline__ void qkt_pf(f32x16& p0, f32x16& p1, const LAS char* Ks, const bf16x8* qr, int r32, int hi) {
  bf16x8 kf[16];
#pragma unroll
  for (int d0 = 0; d0 < 8; ++d0) { const int cb = (d0 * 16 + hi * 8) * 2; kf[2 * d0] = *(const LAS bf16x8*)(Ks + KSWZ(r32, cb)); kf[2 * d0 + 1] = *(const LAS bf16x8*)(Ks + KSWZ(32 + r32, cb)); }
  SBAR();
  p0 = f32x16{}; p1 = f32x16{};
#pragma unroll
  for (int d0 = 0; d0 < 8; ++d0) { p0 = __builtin_amdgcn_mfma_f32_32x32x16_bf16(kf[2 * d0], qr[d0], p0, 0, 0, 0); p1 = __builtin_amdgcn_mfma_f32_32x32x16_bf16(kf[2 * d0 + 1], qr[d0], p1, 0, 0, 0); }
}
template <int D0> __device__ __forceinline__ void vfrag(s16x4 (&f)[8], int vb) {
  f[0] = tr_read<v_rd_off(D0, 0, 0)>(vb); f[1] = tr_read<v_rd_off(D0, 0, 1)>(vb); f[2] = tr_read<v_rd_off(D0, 1, 0)>(vb); f[3] = tr_read<v_rd_off(D0, 1, 1)>(vb);
  f[4] = tr_read<v_rd_off(D0, 2, 0)>(vb); f[5] = tr_read<v_rd_off(D0, 2, 1)>(vb); f[6] = tr_read<v_rd_off(D0, 3, 0)>(vb); f[7] = tr_read<v_rd_off(D0, 3, 1)>(vb);
}
__device__ __forceinline__ void pv4(f32x16& od, const s16x4 (&f)[8], bf16x8 pa0, bf16x8 pa1, bf16x8 pa2, bf16x8 pa3) {
#define PK(L, H) (bf16x8){L[0], L[1], L[2], L[3], H[0], H[1], H[2], H[3]}
  od = __builtin_amdgcn_mfma_f32_32x32x16_bf16(pa0, PK(f[0], f[1]), od, 0, 0, 0);
  od = __builtin_amdgcn_mfma_f32_32x32x16_bf16(pa1, PK(f[2], f[3]), od, 0, 0, 0);
  od = __builtin_amdgcn_mfma_f32_32x32x16_bf16(pa2, PK(f[4], f[5]), od, 0, 0, 0);
  od = __builtin_amdgcn_mfma_f32_32x32x16_bf16(pa3, PK(f[6], f[7]), od, 0, 0, 0);
#undef PK
}
__device__ __forceinline__ void pv_pipe(f32x16* o, int vb, bf16x8 pa0, bf16x8 pa1, bf16x8 pa2, bf16x8 pa3) {
  s16x4 fa[8], fb[8];
  vfrag<0>(fa, vb); SBAR();
  vfrag<1>(fb, vb); asm volatile("s_waitcnt lgkmcnt(8)" ::: "memory"); SBAR(); pv4(o[0], fa, pa0, pa1, pa2, pa3); SBAR();
  vfrag<2>(fa, vb); asm volatile("s_waitcnt lgkmcnt(8)" ::: "memory"); SBAR(); pv4(o[1], fb, pa0, pa1, pa2, pa3); SBAR();
  vfrag<3>(fb, vb); asm volatile("s_waitcnt lgkmcnt(8)" ::: "memory"); SBAR(); pv4(o[2], fa, pa0, pa1, pa2, pa3); SBAR();
  asm volatile("s_waitcnt lgkmcnt(0)" ::: "memory"); SBAR(); pv4(o[3], fb, pa0, pa1, pa2, pa3);
}
#define PV_PIPE_HOOKS(o_, vb_, pa0, pa1, pa2, pa3, H0, H1, H2, H3) do { s16x4 fa_[8], fb_[8]; \
  vfrag<0>(fa_, vb_); SBAR(); \
  vfrag<1>(fb_, vb_); asm volatile("s_waitcnt lgkmcnt(8)" ::: "memory"); SBAR(); pv4((o_)[0], fa_, pa0, pa1, pa2, pa3); H0; SBAR(); \
  vfrag<2>(fa_, vb_); asm volatile("s_waitcnt lgkmcnt(8)" ::: "memory"); SBAR(); pv4((o_)[1], fb_, pa0, pa1, pa2, pa3); H1; SBAR(); \
  vfrag<3>(fb_, vb_); asm volatile("s_waitcnt lgkmcnt(8)" ::: "memory"); SBAR(); pv4((o_)[2], fa_, pa0, pa1, pa2, pa3); H2; SBAR(); \
  asm volatile("s_waitcnt lgkmcnt(0)" ::: "memory"); SBAR(); pv4((o_)[3], fb_, pa0, pa1, pa2, pa3); H3; SBAR(); } while (0)
template <int MODE>
__device__ __forceinline__ void mask_tile(f32x16& p0, f32x16& p1, const Desc& d, int j, int wid, int r32, int hi, const LAS float* rpbL) {
  if constexpr (MODE == 1) {
    if (j >= 4) { const int base = d.a0 + 64 * (j - 4) - (wid * 32 + r32);
#pragma unroll
      for (int r = 0; r < 16; ++r) { const int dd = base + crow(r, hi); if (dd > 128 || dd < -128) p0[r] = -1e30f; if (dd + 32 > 128 || dd + 32 < -128) p1[r] = -1e30f; } }
  } else if constexpr (MODE == 2) {
    if (j >= 4) {
      const int kr = d.a0 + (j - 4), qr_ = d.a1 + (wid >> 1), c = 32 * (wid & 1) + r32;
      int r0 = qr_ - 4; r0 = r0 < 0 ? 0 : (r0 > 56 ? 56 : r0); int c0 = c - 8; c0 = c0 < 0 ? 0 : (c0 > 48 ? 48 : c0);
      asm volatile("" : "+v"(c0));
      const bool rv = (j < d.NTreal) && (kr >= r0) && (kr < r0 + 8);
      if (!rv) {
#pragma unroll
        for (int r = 0; r < 16; ++r) { p0[r] = -1e30f; p1[r] = -1e30f; }
      } else { const LAS float* brow = rpbL + (kr - qr_ + 7) * 31 + (15 - c);
#pragma unroll
        for (int rc = 0; rc < 16; rc += 4) {
#pragma unroll
          for (int r = rc; r < rc + 4; ++r) { const int k0 = crow(r, hi), k1 = k0 + 32; const bool ok0 = (unsigned)(k0 - c0) < 16u, ok1 = (unsigned)(k1 - c0) < 16u;
            const float b0 = brow[ok0 ? k0 : c], b1 = brow[ok1 ? k1 : c];
            p0[r] = ok0 ? p0[r] + b0 : -1e30f; p1[r] = ok1 ? p1[r] + b1 : -1e30f; }
          SBAR(); } }
    }
  }
}

template <int MODE, bool K2, int SDEPTH, int NQR>
__device__ __forceinline__ void unit(const Desc& d, LAS char* lds) {
  static_assert((K2 ? 12 : 8) - NQR <= 4, "at most four Q fragments live in LDS");
  const int tid = threadIdx.x, wid = __builtin_amdgcn_readfirstlane(tid >> 6), lane = tid & 63, r32 = lane & 31, hi = lane >> 5;
  LAS char* V_lds = lds + L_V; LAS char* K_lds = lds + L_K; LAS char* K2_lds = lds + L_K2;
  LAS float* ws = (LAS float*)(lds + L_WS) + wid * 64; LAS float* li_l = ws; LAS float* al_l = ws + 32;
  LAS float* rpbL = (LAS float*)(lds + L_RPB);
  if constexpr (MODE == 2) { if (tid < 465) rpbL[tid] = ((const GAS float*)d.rpb)[tid]; }
  float m_reg = d.m0, l_reg = d.l0; f32x16 o[4] = {}; bf16x8 qr[NQR];
  LAS char* q2l = lds + L_Q2 + wid * 4096 + lane * 16;
  { const GAS bf16* Qw = (const GAS bf16*)d.Q + (long)(wid * QBLK + r32) * d.ldq + hi * 8;
#pragma unroll
    for (int d0 = 0; d0 < NQR; ++d0) qr[d0] = *(const GAS bf16x8*)(Qw + d0 * 16);
#pragma unroll
    for (int d0 = NQR; d0 < (K2 ? 12 : 8); ++d0) *(LAS bf16x8*)(q2l + (d0 - NQR) * 1024) = *(const GAS bf16x8*)(Qw + d0 * 16); }
  const int sr = tid >> 4, sc = (tid & 15) * 8, vst0 = v_st(sr, sc), vst1 = v_st(32 + sr, sc);
  const int vb0 = (int)(unsigned)(uintptr_t)V_lds + v_rd_base(lane);
  const GAS bf16* Kp = (const GAS bf16*)d.K + (long)sr * d.ldk + sc; const GAS bf16* Vp = (const GAS bf16*)d.V + (long)sr * d.ldv + sc;
  const GAS bf16* K2p = K2 ? (const GAS bf16*)d.K2 + (long)(tid >> 3) * 64 + (tid & 7) * 8 : nullptr;
  const int k2st = K2SWZ(tid >> 3, (tid & 7) * 16);
  struct { bf16x8 vs0, vs1, ks0, ks1, k2; } sr_[SDEPTH];
  const int NT = d.NT, NTr = d.NTreal;
#define TROW(j) ((j) < 4 ? d.row_ctx + 64 * (j) : d.row_lat + 64 * (((j) < NTr ? (j) : NTr - 1) - 4))
#define SLOAD(i, j) do { const long kr_ = TROW(j); sr_[i].vs0 = *(const GAS bf16x8*)(Vp + kr_ * d.ldv); sr_[i].vs1 = *(const GAS bf16x8*)(Vp + (kr_ + 32) * d.ldv); \
    sr_[i].ks0 = *(const GAS bf16x8*)(Kp + kr_ * d.ldk); sr_[i].ks1 = *(const GAS bf16x8*)(Kp + (kr_ + 32) * d.ldk); \
    if constexpr (K2) sr_[i].k2 = *(const GAS bf16x8*)(K2p + kr_ * 64); } while (0)
#define SWRITE(b, i) do { *(LAS bf16x8*)(V_lds + (b) * SHM_V + vst0) = sr_[i].vs0; *(LAS bf16x8*)(V_lds + (b) * SHM_V + vst1) = sr_[i].vs1; const int kc = sc * 2; \
    *(LAS bf16x8*)(K_lds + (b) * SHM_K + KSWZ(sr, kc)) = sr_[i].ks0; *(LAS bf16x8*)(K_lds + (b) * SHM_K + KSWZ(32 + sr, kc)) = sr_[i].ks1; \
    if constexpr (K2) *(LAS bf16x8*)(K2_lds + (b) * SHM_K2 + k2st) = sr_[i].k2; } while (0)
#define SWAIT() do { if constexpr (SDEPTH == 2) asm volatile("s_waitcnt vmcnt(4)" ::: "memory"); else asm volatile("s_waitcnt vmcnt(0)" ::: "memory"); } while (0)
#define RESC(a) do { if (__any((a) < 1.f)) { if (hi == 0) al_l[r32] = (a); asm volatile("s_waitcnt lgkmcnt(0)" ::: "memory"); \
    _Pragma("unroll") for (int dd = 0; dd < 4; ++dd) _Pragma("unroll") for (int r = 0; r < 16; ++r) o[dd][r] *= al_l[crow(r, hi)]; } } while (0)
  f32x16 pA0, pA1, pB0, pB1; float mnA, mnB, alA, alB; bf16x8 pa0, pa1, pa2, pa3;
  constexpr int SE = 0, SO = SDEPTH - 1;
  SLOAD(SE, 0); asm volatile("s_waitcnt vmcnt(0)" ::: "memory"); SWRITE(0, SE); __syncthreads();
  qkt<K2, NQR>(pA0, pA1, K_lds, K2_lds, qr, q2l, r32, hi); partialSM(pA0, pA1, m_reg, mnA, alA);
  SLOAD(SO, 1); if constexpr (SDEPTH == 2) { if (2 < NT) SLOAD(SE, 2); }
  SWAIT(); SWRITE(1, SO); __syncthreads();
  for (int j = 1; j + 1 < NT; j += 2) {
    SBAR(); qkt<K2, NQR>(pB0, pB1, K_lds + SHM_K, K2_lds + SHM_K2, qr, q2l, r32, hi);
    finishSM(pA0, pA1, alA, l_reg, pa0, pa1, pa2, pa3); SBAR();
    SLOAD(SO, j + SDEPTH); SBAR();
    pv_d0(o, vb0, pa0, pa1, pa2, pa3); if constexpr (MODE != 0) { SBAR(); mask_tile<MODE>(pB0, pB1, d, j, wid, r32, hi, rpbL); SBAR(); } partialSM(pB0, pB1, m_reg, mnB, alB);
    __syncthreads(); SWAIT(); SWRITE(0, SE);
    RESC(alB); __syncthreads();
    SBAR(); qkt<K2, NQR>(pA0, pA1, K_lds, K2_lds, qr, q2l, r32, hi);
    finishSM(pB0, pB1, alB, l_reg, pa0, pa1, pa2, pa3); SBAR();
    if (SDEPTH == 1 || j + 3 < NT) SLOAD(SE, j + 1 + SDEPTH); SBAR();
    pv_d0(o, vb0 + SHM_V, pa0, pa1, pa2, pa3); if constexpr (MODE != 0) { SBAR(); mask_tile<MODE>(pA0, pA1, d, j + 1, wid, r32, hi, rpbL); SBAR(); } partialSM(pA0, pA1, m_reg, mnA, alA);
    __syncthreads(); SWAIT(); SWRITE(1, SO);
    RESC(alA); __syncthreads();
  }
  SBAR(); qkt<K2, NQR>(pB0, pB1, K_lds + SHM_K, K2_lds + SHM_K2, qr, q2l, r32, hi);
  finishSM(pA0, pA1, alA, l_reg, pa0, pa1, pa2, pa3); SBAR();
  pv_d0(o, vb0, pa0, pa1, pa2, pa3); if constexpr (MODE != 0) { SBAR(); mask_tile<MODE>(pB0, pB1, d, NT - 1, wid, r32, hi, rpbL); SBAR(); } partialSM(pB0, pB1, m_reg, mnB, alB);
  __syncthreads(); RESC(alB);
  finishSM(pB0, pB1, alB, l_reg, pa0, pa1, pa2, pa3); SBAR();
  pv_d0(o, vb0 + SHM_V, pa0, pa1, pa2, pa3);
  if (hi == 0) li_l[r32] = l_reg; asm volatile("s_waitcnt lgkmcnt(0)" ::: "memory");
  float rli[16];
#pragma unroll
  for (int r = 0; r < 16; ++r) rli[r] = __builtin_amdgcn_rcpf(li_l[crow(r, hi)]);
#pragma unroll
  for (int d0 = 0; d0 < 4; ++d0)
#pragma unroll
    for (int r = 0; r < 16; ++r) o[d0][r] *= rli[r];
  SBAR();
  GAS bf16* Ow = (GAS bf16*)d.O + (long)(wid * QBLK) * d.ldo;
  { int lo_ = lane; asm volatile("" : "+v"(lo_));
    LAS bf16* stg = (LAS bf16*)(K_lds + wid * 4096);
#pragma unroll
    for (int g = 0; g < 2; ++g) { SBAR();
#pragma unroll
      for (int r = 0; r < 16; ++r) { const int orow = crow(r, hi); const float x0 = o[2 * g][r], x1 = o[2 * g + 1][r];
        stg[orow * 64 + r32] = (bf16)(cvt_pk_bf16(x0, x0) & 0xffffu); stg[orow * 64 + 32 + r32] = (bf16)(cvt_pk_bf16(x1, x1) & 0xffffu); }
      asm volatile("s_waitcnt lgkmcnt(0)" ::: "memory");
#pragma unroll
      for (int q = 0; q < 4; ++q) { const int idx = q * 64 + lo_, row = idx >> 3, ch = idx & 7; const v4u v = *(const LAS v4u*)(stg + row * 64 + ch * 8);
        *(GAS v4u*)(Ow + (long)row * d.ldo + g * 64 + ch * 8) = v; }
      asm volatile("s_waitcnt lgkmcnt(0)" ::: "memory"); } }
  __syncthreads();
#undef TROW
#undef SLOAD
#undef SWRITE
#undef SWAIT
#undef RESC
}
constexpr int X_V = 0, X_K = 4 * SHM_V, X_P = X_K + 3 * SHM_K, X_WS = X_P + 4 * 4096, X_END = X_WS + NW * 64 * 4;
template <bool COMB>
__device__ __forceinline__ void unit_split(const Desc& d, LAS char* lds) {
  const int tid = threadIdx.x, wid = __builtin_amdgcn_readfirstlane(tid >> 6), lane = tid & 63, r32 = lane & 31, hi = lane >> 5;
  const bool isS = wid < 4; const int w4 = wid & 3;
  LAS char* V_lds = lds + X_V; LAS char* K_lds = lds + X_K; LAS char* P_l = lds + X_P + w4 * 4096 + lane * 16;
  LAS float* wsS = (LAS float*)(lds + X_WS) + w4 * 64; LAS float* al_l = wsS; LAS float* li_l = wsS + 32;
  volatile LAS unsigned* flag = (volatile LAS unsigned*)((LAS float*)(lds + X_WS) + (w4 + 4) * 64);
  const int NT = d.NT;
#define KOFF(i, L) ((4 * (w4 + 4 * (i)) + ((L) >> 4)) * d.ldk + ((((L) & 15) ^ KSWF(4 * (w4 + 4 * (i)) + ((L) >> 4))) * 8))
#define VKK(i, L) (((w4 + 4 * (i)) >> 1) * 8 + (((L) & 31) >> 2))
#define VOFF(i, L) (((VKK(i, L) & ~0xC) | ((VKK(i, L) & 4) << 1) | ((VKK(i, L) & 8) >> 1)) * d.ldv + ((w4 + 4 * (i)) & 1) * 64 + ((L) >> 5) * 32 + ((L) & 3) * 8)
#define TROT(j) (((j) + d.rot) >= NT ? ((j) + d.rot) - NT : ((j) + d.rot))
#define TROW(j) (TROT(j) < 4 ? d.row_ctx + 64 * TROT(j) : d.row_lat + 64 * (TROT(j) - 4))
#define GLDS(src, dst) __builtin_amdgcn_global_load_lds((const unsigned*)(src), (LAS unsigned*)(dst), 16, 0, 0)
#define KDMA(j) do { int L_ = lane; asm volatile("" : "+v"(L_)); const GAS bf16* kp_ = (const GAS bf16*)d.K + (long)TROW(j) * d.ldk; LAS char* kb_ = K_lds + ((j) % 3) * SHM_K + w4 * 1024; \
    GLDS(kp_ + KOFF(0, L_), kb_); GLDS(kp_ + KOFF(1, L_), kb_ + 4096); GLDS(kp_ + KOFF(2, L_), kb_ + 8192); GLDS(kp_ + KOFF(3, L_), kb_ + 12288); } while (0)
#define VDMA(j) do { int L_ = lane; asm volatile("" : "+v"(L_)); const GAS bf16* vp_ = (const GAS bf16*)d.V + (long)TROW(j) * d.ldv; LAS char* vb_ = V_lds + ((j) & 1) * 2 * SHM_V + w4 * 1024; \
    _Pragma("unroll") for (int i_ = 0; i_ < 4; ++i_) { const int v_ = VOFF(i_, L_); GLDS(vp_ + v_, vb_ + i_ * 4096); GLDS(vp_ + 128 + v_, vb_ + SHM_V + i_ * 4096); } } while (0)
#define VPIECE(j, i) do { int L_ = lane; asm volatile("" : "+v"(L_)); const GAS bf16* vp_ = (const GAS bf16*)d.V + (long)TROW(j) * d.ldv + ((i) & 1) * 128; \
    GLDS(vp_ + VOFF((i) >> 1, L_), V_lds + ((j) & 1) * 2 * SHM_V + ((i) & 1) * SHM_V + w4 * 1024 + ((i) >> 1) * 4096); } while (0)
#define WAITV(n) asm volatile("s_waitcnt vmcnt(" #n ")" ::: "memory")
#define BAR() asm volatile("s_waitcnt lgkmcnt(0)\n\ts_barrier" ::: "memory")
#define KBUF(j) (K_lds + ((j) % 3) * SHM_K)
#define VOFS(j) (((j) & 1) * 2 * SHM_V)
  if (isS) {
    float m_reg = d.m0, l_reg = d.l0; bf16x8 qr[8];
    { const GAS bf16* Qw = (const GAS bf16*)d.Q + (long)(w4 * QBLK + r32) * d.ldq + hi * 8;
#pragma unroll
      for (int d0 = 0; d0 < 8; ++d0) qr[d0] = *(const GAS bf16x8*)(Qw + d0 * 16); }
    asm volatile("" ::: "memory");
    KDMA(0); KDMA(1); if (2 < NT) KDMA(2);
    f32x16 pA0, pA1, pB0, pB1; float mnA, mnB, alA, alB; bf16x8 pa0, pa1, pa2, pa3;
    if (2 < NT) WAITV(8); else WAITV(4);
    BAR();
    qkt_pf(pA0, pA1, KBUF(0), qr, r32, hi);
    if (2 < NT) WAITV(4); else WAITV(0);
    BAR();
#define PUBP() do { *(LAS bf16x8*)(P_l) = pa0; *(LAS bf16x8*)(P_l + 1024) = pa1; *(LAS bf16x8*)(P_l + 2048) = pa2; *(LAS bf16x8*)(P_l + 3072) = pa3; } while (0)
#define SSTEP(J, PC0, PC1, MNC, ALC, PN0, PN1) do { \
      partialSM(PC0, PC1, m_reg, MNC, ALC); PROBE_SVALU(); { const bool rs_ = __any((ALC) < 1.f); if (rs_ && hi == 0) al_l[r32] = (ALC); if (lane == 0) *flag = rs_ ? 1u : 0u; } \
      if ((J) + 1 < NT) { SBAR(); qkt_pf(PN0, PN1, KBUF((J) + 1), qr, r32, hi); SBAR(); } \
      BAR();                                                                             \
      finishSM(PC0, PC1, ALC, l_reg, pa0, pa1, pa2, pa3); PUBP(); \
      if ((J) + 1 == NT && hi == 0) li_l[r32] = l_reg; \
      if ((J) + 3 < NT) KDMA((J) + 3); \
      if ((J) + 3 < NT) WAITV(4); else WAITV(0); \
      BAR();                                                                             \
    } while (0)
#ifdef PROBE_S
#define PROBE_SVALU() do { float dm_ = 1.0f; _Pragma("unroll") for (int q_ = 0; q_ < 32; ++q_) asm volatile("v_exp_f32 %0, %0" : "+v"(dm_)); asm volatile("" :: "v"(dm_)); } while (0)
#else
#define PROBE_SVALU() do { } while (0)
#endif
    for (int j = 0; j < NT; j += 2) {
      SSTEP(j, pA0, pA1, mnA, alA, pB0, pB1);
      SSTEP(j + 1, pB0, pB1, mnB, alB, pA0, pA1);
    }
    BAR();
#undef PUBP
#undef SSTEP
  } else {
    f32x16 o[8] = {}; bf16x8 pa0, pa1, pa2, pa3;
    const int vb0 = (int)(unsigned)(uintptr_t)V_lds + v_rd_base(lane);
    BAR();
    BAR();
#define GETP() do { pa0 = *(const LAS bf16x8*)(P_l); pa1 = *(const LAS bf16x8*)(P_l + 1024); pa2 = *(const LAS bf16x8*)(P_l + 2048); pa3 = *(const LAS bf16x8*)(P_l + 3072); } while (0)
#ifdef PROBE_W
    unsigned long long wacc = 0, wprev = __builtin_amdgcn_s_memrealtime();
#define WST(k) do { const unsigned long long t_ = __builtin_amdgcn_s_memrealtime(); if ((k) == PROBE_W) wacc += t_ - wprev; wprev = t_; } while (0)
#else
#define WST(k) do { } while (0)
#endif
    VDMA(0);
    BAR();
    WAITV(0); BAR();
    for (int J = 1; J < NT; ++J) {
      WST(3);
      VDMA(J);
      GETP(); asm volatile("s_waitcnt lgkmcnt(0)" ::: "memory"); pv_pipe(o, vb0 + VOFS(J - 1), pa0, pa1, pa2, pa3);
      WST(0); BAR();
      WST(1);
      pv_pipe(o + 4, vb0 + VOFS(J - 1) + SHM_V, pa0, pa1, pa2, pa3);
      if (__builtin_amdgcn_readfirstlane(*flag)) {
#pragma unroll
        for (int dd = 0; dd < 8; ++dd)
#pragma unroll
          for (int r = 0; r < 16; ++r) o[dd][r] *= al_l[crow(r, hi)]; }
      WST(2); WAITV(0); BAR();
    }
    GETP(); asm volatile("s_waitcnt lgkmcnt(0)" ::: "memory"); pv_pipe(o, vb0 + VOFS(NT - 1), pa0, pa1, pa2, pa3); pv_pipe(o + 4, vb0 + VOFS(NT - 1) + SHM_V, pa0, pa1, pa2, pa3);
    float rli[16];
#pragma unroll
    for (int r = 0; r < 16; ++r) rli[r] = __builtin_amdgcn_rcpf(li_l[crow(r, hi)]);
    GAS bf16* Ow = (GAS bf16*)d.O + (long)(w4 * QBLK) * d.ldo;
    if constexpr (!COMB) {
    { LAS bf16* stg = (LAS bf16*)(lds + X_P + w4 * 4096);
#pragma unroll
      for (int g = 0; g < 4; ++g) {
#pragma unroll
        for (int r = 0; r < 16; ++r) { const int orow = crow(r, hi); const float x0 = o[2 * g][r] * rli[r], x1 = o[2 * g + 1][r] * rli[r];
          stg[orow * 64 + r32] = (bf16)(cvt_pk_bf16(x0, x0) & 0xffffu); stg[orow * 64 + 32 + r32] = (bf16)(cvt_pk_bf16(x1, x1) & 0xffffu); }
        asm volatile("s_waitcnt lgkmcnt(0)" ::: "memory");
#pragma unroll
        for (int q = 0; q < 4; ++q) { const int idx = q * 64 + lane, row = idx >> 3, ch = idx & 7; const v4u v = *(const LAS v4u*)(stg + row * 64 + ch * 8);
          *(GAS v4u*)(Ow + (long)row * d.ldo + g * 64 + ch * 8) = v; }
        asm volatile("s_waitcnt lgkmcnt(0)" ::: "memory"); } }
    } else {
      const GAS bf16* O1w = (const GAS bf16*)d.O1 + (long)(w4 * QBLK) * 4096; const float lam = d.lam;
      asm volatile("s_waitcnt vmcnt(0)" ::: "memory");
      LAS bf16* stg = (LAS bf16*)(lds + X_P + w4 * 4096);
      float dv[4][4][8]; float ssq[4] = {0.f, 0.f, 0.f, 0.f};
#pragma unroll
      for (int g = 0; g < 4; ++g) {
#pragma unroll
        for (int r = 0; r < 16; ++r) { const int orow = crow(r, hi); const float x0 = o[2 * g][r] * rli[r], x1 = o[2 * g + 1][r] * rli[r];
          stg[orow * 64 + r32] = (bf16)(cvt_pk_bf16(x0, x0) & 0xffffu); stg[orow * 64 + 32 + r32] = (bf16)(cvt_pk_bf16(x1, x1) & 0xffffu); }
        asm volatile("s_waitcnt lgkmcnt(0)" ::: "memory");
#pragma unroll
        for (int q = 0; q < 4; ++q) { const int idx = q * 64 + lane, row = idx >> 3, ch = idx & 7; const v4u v2 = *(const LAS v4u*)(stg + row * 64 + ch * 8);
          const v4u v1 = *(const GAS v4u*)(O1w + (long)row * 4096 + g * 64 + ch * 8);
#pragma unroll
          for (int j = 0; j < 4; ++j) { const unsigned w1 = v1[j], w2 = v2[j];
            const float xl = __builtin_bit_cast(float, w1 << 16) - lam * __builtin_bit_cast(float, w2 << 16), xh = __builtin_bit_cast(float, w1 & 0xffff0000u) - lam * __builtin_bit_cast(float, w2 & 0xffff0000u);
            dv[g][q][2 * j] = xl; dv[g][q][2 * j + 1] = xh; ssq[q] += xl * xl + xh * xh; } }
        asm volatile("s_waitcnt lgkmcnt(0)" ::: "memory"); }
#pragma unroll
      for (int q = 0; q < 4; ++q) { float t = ssq[q]; t += __shfl_xor(t, 1); t += __shfl_xor(t, 2); t += __shfl_xor(t, 4); ssq[q] = __builtin_amdgcn_rsqf(t * (1.f / 256.f) + 1e-6f); }
#pragma unroll
      for (int g = 0; g < 4; ++g)
#pragma unroll
        for (int q = 0; q < 4; ++q) { const int idx = q * 64 + lane, row = idx >> 3, ch = idx & 7; const float rs = ssq[q]; v4u w;
          w.x = cvt_pk_bf16(dv[g][q][0] * rs, dv[g][q][1] * rs); w.y = cvt_pk_bf16(dv[g][q][2] * rs, dv[g][q][3] * rs); w.z = cvt_pk_bf16(dv[g][q][4] * rs, dv[g][q][5] * rs); w.w = cvt_pk_bf16(dv[g][q][6] * rs, dv[g][q][7] * rs);
          *(GAS v4u*)(Ow + (long)row * d.ldo + g * 64 + ch * 8) = w; }
    }
    BAR();
#ifdef PROBE_W
    if (blockIdx.x == 0 && wid == 4 && lane == 0) { GAS unsigned long long* tw = (GAS unsigned long long*)d.probe; tw[4] += wacc; }
#endif
#undef GETP
  }
#undef KOFF
#undef VKK
#undef VOFF
#undef TROW
#undef TROT
#undef GLDS
#undef KDMA
#undef VDMA
#undef VPIECE
#undef WAITV
#undef BAR
#undef KBUF
#undef VOFS
}
}
constexpr int NWAVES = 8;
constexpr size_t MiB = 1u << 20;
constexpr size_t WS_CTL = 0, CTL_ZERO_BYTES = 1 * MiB;
constexpr size_t WS_MODP = 1 * MiB;
constexpr size_t WS_MODS = 9 * MiB;
constexpr size_t WS_TAB = 10 * MiB;
constexpr size_t WS_SSQ = 11 * MiB;
constexpr size_t WS_W = 13 * MiB;
constexpr size_t W_SWA_QKV = WS_W, W_SWA_O = W_SWA_QKV + 12 * MiB, W_DIFF_QKV = W_SWA_O + 8 * MiB, W_DIFF_O = W_DIFF_QKV + 24 * MiB;
constexpr size_t W_MLA_DOWN = W_DIFF_O + 8 * MiB, W_MLA_UQ = W_MLA_DOWN + 5 * MiB, W_MLA_UKV = W_MLA_UQ + 3 * MiB, W_MLA_O = W_MLA_UKV + 4 * MiB;
constexpr size_t W_NA_QKV = W_MLA_O + 8 * MiB, W_NA_O = W_NA_QKV + 24 * MiB, W_GU = W_NA_O + 8 * MiB, W_DOWN = W_GU + 4 * 44 * MiB, W_END = W_DOWN + 4 * 22 * MiB;
constexpr size_t WS_H = W_END;
constexpr size_t WS_U = WS_H + 136 * MiB;
constexpr size_t WS_Y = WS_U + 68 * MiB;
constexpr size_t WS_O = WS_Y + 136 * MiB;
constexpr size_t WS_O12 = WS_O + 68 * MiB;
constexpr size_t WS_R1 = WS_O12 + 136 * MiB;
constexpr size_t R1_MLA_Q = WS_R1, R1_MLA_KV = WS_R1 + 102 * MiB, R1_MLA_C = R1_MLA_KV + 136 * MiB, R1_MLA_KPE = R1_MLA_C + 34 * MiB;
constexpr size_t R1_KH = WS_R1 + 68 * MiB, R1_VH = WS_R1 + 136 * MiB;
constexpr size_t WS_YP = WS_R1 + 276 * MiB;
constexpr size_t WS_END = WS_YP + 64 * MiB;
static_assert(W_END == (13 + 368) * MiB && (size_t)MROWS * 6144 * 2 <= 276 * MiB && (size_t)MROWS * FF * 2 <= 276 * MiB && R1_MLA_KPE + (size_t)MROWS * 64 * 2 <= WS_END, "ws map");
constexpr int CW_BAR = 4096;
constexpr int RING_BYTES = 133120, MISC_OFF = 135168, LDS_BYTES = 147456;
static_assert(attn::L_END <= RING_BYTES && attn::X_END <= RING_BYTES && pg8::STAGE_BYTES <= RING_BYTES && 8 * 16640 <= RING_BYTES && MISC_OFF + 128 <= LDS_BYTES, "LDS map");

#define RLX_AGENT __ATOMIC_RELAXED, __HIP_MEMORY_SCOPE_AGENT
#define LDS_WAIT() asm volatile("s_waitcnt lgkmcnt(0)" ::: "memory")

#define XB_TMO      128
#define XB_XCNT(j)  (256  + 64 * (j))
#define XB_XSUB(j)  (1280 + 64 * (j))
#define XB_XGEN(j)  (2304 + 64 * (j))
#define XB_TOP      3328
#define XB_TOPGEN   3392
#define XCD_BAR_WORDS 3456
#define XB_SPIN_CAP (1u << 18)
__device__ __forceinline__ unsigned xb_ld(unsigned* p)              { return __hip_atomic_load(p, __ATOMIC_RELAXED, __HIP_MEMORY_SCOPE_AGENT); }
__device__ __forceinline__ unsigned xb_add(unsigned* p, unsigned v) { return __hip_atomic_fetch_add(p, v, __ATOMIC_RELAXED, __HIP_MEMORY_SCOPE_AGENT); }
__device__ __forceinline__ unsigned xb_xcc_id() { return (unsigned)__builtin_amdgcn_s_getreg((3 << 11) | 20) & 0xFu; }
#define XB_SPIN(cond, bar) do { unsigned _sp = 0; while (cond) { __builtin_amdgcn_s_sleep(1); \
    if ((++_sp & 255u) == 0u) { if (xb_ld(&(bar)[XB_TMO])) break; if (_sp > XB_SPIN_CAP) { atomicAdd(&(bar)[XB_TMO], 1u); break; } } } } while (0)
struct XcdBarrier { unsigned* bar; unsigned x; volatile LAS unsigned* st; };
__device__ __forceinline__ XcdBarrier xcd_barrier_post(unsigned* bar, volatile LAS unsigned* st) {
    XcdBarrier b; b.bar = bar; b.x = xb_xcc_id(); b.st = st;
    if (threadIdx.x == 0) (void)xb_add(&bar[XB_XCNT(b.x)], 1u);
    return b;
}
__device__ __forceinline__ void xcd_barrier_complete(unsigned* bar, unsigned x, unsigned& nloc, unsigned& nx) {
    const unsigned G = gridDim.x * gridDim.y * gridDim.z;
    unsigned sum, cnt, mine, sp = 0u;
    for (;;) {
        sum = 0u; cnt = 0u; mine = 0u;
#pragma unroll
        for (unsigned j = 0; j < 16; ++j) { const unsigned c = xb_ld(&bar[XB_XCNT(j)]); sum += c; cnt += (c > 0u) ? 1u : 0u; mine = (j == x) ? c : mine; }
        if (sum == G) break;
        __builtin_amdgcn_s_sleep(1);
        if ((++sp & 255u) == 0u) { if (xb_ld(&bar[XB_TMO])) break; if (sp > XB_SPIN_CAP) { atomicAdd(&bar[XB_TMO], 1u); break; } }
    }
    nloc = mine > 0u ? mine : 1u; nx = cnt > 0u ? cnt : 1u;
}
__device__ __forceinline__ void xcd_barrier(const XcdBarrier& b) {
    asm volatile("s_waitcnt vmcnt(0)" ::: "memory");
    __syncthreads();
    if (threadIdx.x == 0) {
        unsigned* bar = b.bar;
        __builtin_amdgcn_s_waitcnt(0);
        unsigned nloc = b.st[0], nx = b.st[1];
        if (nloc == 0u) { xcd_barrier_complete(bar, b.x, nloc, nx); b.st[0] = nloc; b.st[1] = nx; }
        const unsigned old = xb_add(&bar[XB_XSUB(b.x)], 1u);
        const unsigned gen = old / nloc;
        if (old + 1u == (gen + 1u) * nloc) {
            __builtin_amdgcn_fence(__ATOMIC_RELEASE, "agent");
            asm volatile("s_waitcnt vmcnt(0)" ::: "memory");
            const unsigned og = xb_add(&bar[XB_TOP], 1u);
            const unsigned tg = og / nx;
            if (og + 1u == (tg + 1u) * nx) xb_add(&bar[XB_TOPGEN], 1u);
            else XB_SPIN(xb_ld(&bar[XB_TOPGEN]) == tg, bar);
            __builtin_amdgcn_fence(__ATOMIC_ACQUIRE, "agent");
            xb_add(&bar[XB_XGEN(b.x)], 1u);
            asm volatile("s_waitcnt vmcnt(0)" ::: "memory");
        } else {
            XB_SPIN(xb_ld(&bar[XB_XGEN(b.x)]) == gen, bar);
            __builtin_amdgcn_fence(__ATOMIC_ACQUIRE, "agent");
            asm volatile("s_waitcnt vmcnt(0)" ::: "memory");
        }
    }
    __syncthreads();
}

enum { I_X = 0, I_C, I_CTX, I_CCTX, I_MODW, I_MODB, I_NORMG, I_WGU, I_WDOWN, I_SWA_QKV, I_SWA_O, I_SWA_SINK, I_DIFF_QKV, I_DIFF_O, I_DIFF_LAM, I_DIFF_SUBLN,
       I_MLA_DOWN, I_MLA_QN, I_MLA_KVN, I_MLA_UQ, I_MLA_UKV, I_MLA_O, I_NA_QKV, I_NA_O, I_NA_RPB, N_IN };
struct Args { const float* in[N_IN]; float* out; unsigned char* ws; int ph_lo, ph_hi, li, pad; };

struct Frame {
    LAS unsigned char* lds;
    int tid, lane, wave, vcu, G;
    unsigned char* ws;
};
__device__ __forceinline__ float wave_sum(float v) {
#pragma unroll
    for (int o = 1; o < 64; o <<= 1) v += __shfl_xor(v, o);
    return v;
}
__device__ __forceinline__ float ssq4(const f32x4 v) { return (v[0] * v[0] + v[1] * v[1]) + (v[2] * v[2] + v[3] * v[3]); }

constexpr float DIFF_LAM_INIT = 0.35550906759096926f;
struct CJob { const float* W; bf16* WT; int K, Nsrc, Ng, gu, rmod, rlo, rmax, pt; const float* kg; int kmask; float ks; };
constexpr int CJ_ITEMS[18] = {1536, 1024, 3072, 1024, 640, 384, 512, 1024, 3072, 1024, 5632, 5632, 5632, 5632, 2816, 2816, 2816, 2816};
constexpr int CJ_TOTAL = 47104;
#define CJ_IN(I_) cj_opaque(a.in[I_])
__device__ __forceinline__ const float* cj_opaque(const float* p) { unsigned long long v = (unsigned long long)p; asm volatile("" : "+s"(v)); return (const float*)v; }
__device__ __forceinline__ CJob cjob(const Args& a, int j) {
    unsigned char* ws = a.ws; CJob c; c.gu = 0; c.rmod = 1 << 30; c.rlo = 0; c.rmax = 0; c.pt = 0; c.kg = nullptr; c.kmask = -1; c.ks = 1.f;
    switch (j) {
    case 0: c.W = CJ_IN(I_SWA_QKV); c.WT = (bf16*)(ws + W_SWA_QKV); c.K = 2048; c.Nsrc = 3072; c.Ng = 3072; c.rmax = 2560; c.pt = 1; break;
    case 1: c.W = CJ_IN(I_SWA_O); c.WT = (bf16*)(ws + W_SWA_O); c.K = 2048; c.Nsrc = 2048; c.Ng = 2048; break;
    case 2: c.W = CJ_IN(I_DIFF_QKV); c.WT = (bf16*)(ws + W_DIFF_QKV); c.K = 2048; c.Nsrc = 6144; c.Ng = 6144; c.rmax = 4096; c.pt = 1; break;
    case 3: c.W = CJ_IN(I_DIFF_O); c.WT = (bf16*)(ws + W_DIFF_O); c.K = 2048; c.Nsrc = 2048; c.Ng = 2048; c.kg = CJ_IN(I_DIFF_SUBLN); c.kmask = 255; c.ks = 1.f - DIFF_LAM_INIT; break;
    case 4: c.W = CJ_IN(I_MLA_DOWN); c.WT = (bf16*)(ws + W_MLA_DOWN); c.K = 2048; c.Nsrc = 1088; c.Ng = 1280; c.rlo = 1024; c.rmax = 1088; c.pt = 2; break;
    case 5: c.W = CJ_IN(I_MLA_UQ); c.WT = (bf16*)(ws + W_MLA_UQ); c.K = 512; c.Nsrc = 3072; c.Ng = 3072; c.rmod = 192; c.rlo = 128; c.rmax = 3072; c.pt = 2; c.kg = CJ_IN(I_MLA_QN); break;
    case 6: c.W = CJ_IN(I_MLA_UKV); c.WT = (bf16*)(ws + W_MLA_UKV); c.K = 512; c.Nsrc = 4096; c.Ng = 4096; c.kg = CJ_IN(I_MLA_KVN); break;
    case 7: c.W = CJ_IN(I_MLA_O); c.WT = (bf16*)(ws + W_MLA_O); c.K = 2048; c.Nsrc = 2048; c.Ng = 2048; break;
    case 8: c.W = CJ_IN(I_NA_QKV); c.WT = (bf16*)(ws + W_NA_QKV); c.K = 2048; c.Nsrc = 6144; c.Ng = 6144; break;
    case 9: c.W = CJ_IN(I_NA_O); c.WT = (bf16*)(ws + W_NA_O); c.K = 2048; c.Nsrc = 2048; c.Ng = 2048; break;
    case 10: case 11: case 12: case 13: c.W = CJ_IN(I_WGU) + (size_t)(j - 10) * DM * 2 * FF; c.WT = (bf16*)(ws + W_GU + (size_t)(j - 10) * 44 * MiB); c.K = 2048; c.Nsrc = 2 * FF; c.Ng = 2 * FF; c.gu = 1; break;
    default: c.W = CJ_IN(I_WDOWN) + (size_t)(j - 14) * FF * DM; c.WT = (bf16*)(ws + W_DOWN + (size_t)(j - 14) * 22 * MiB); c.K = FF; c.Nsrc = 2048; c.Ng = 2048; break;
    }
    return c;
}
__device__ __forceinline__ void convert_item(const CJob& c, int it, LAS float* scr, int lane) {
    const int ngr = c.Ng >> 6, kb = it / ngr, gi = it - kb * ngr, k0 = kb * 64, n0 = gi * 64;
    int sb = n0; if (c.gu) { const int pn = n0 >> 8, bj = (n0 >> 7) & 1, j = n0 & 127; sb = bj * FF + pn * 128 + j; }
    const bool zero = sb >= c.Nsrc, rope = ((n0 % c.rmod) >= c.rlo) && (n0 < c.rmax);
    if (!zero) {
        const GAS f32x4* wp = (const GAS f32x4*)(c.W + (size_t)(k0 + (lane >> 4)) * c.Nsrc + sb + (lane & 15) * 4);
        f32x4 v[16];
#pragma unroll
        for (int i = 0; i < 16; ++i) v[i] = wp[(size_t)i * c.Nsrc];
#pragma unroll
        for (int i = 0; i < 16; ++i) { LAS float* s = scr + (4 * i + (lane >> 4)) * 65 + (lane & 15) * 4; s[0] = v[i][0]; s[1] = v[i][1]; s[2] = v[i][2]; s[3] = v[i][3]; }
    }
    LDS_WAIT(); asm volatile("" ::: "memory");
    const int cch = lane & 7;
    float g[8];
#pragma unroll
    for (int t = 0; t < 8; ++t) g[t] = c.kg ? ((const GAS float*)c.kg)[(k0 + 8 * cch + t) & c.kmask] * c.ks : 1.f;
#pragma unroll
    for (int j8 = 0; j8 < 8; ++j8) { const int nn = (lane >> 3) + 8 * j8;
        int src = nn; if (rope) src = (c.pt == 1) ? ((nn & 1) * 32 + (nn >> 1)) : ((nn >> 5) * 32 + (nn & 1) * 16 + ((nn & 31) >> 1));
        const LAS float* s = scr + (8 * cch) * 65 + src; v4u o;
        if (zero) o = (v4u){0u, 0u, 0u, 0u};
        else { o.x = cvt_pk_bf16(s[0 * 65] * g[0], s[1 * 65] * g[1]); o.y = cvt_pk_bf16(s[2 * 65] * g[2], s[3 * 65] * g[3]); o.z = cvt_pk_bf16(s[4 * 65] * g[4], s[5 * 65] * g[5]); o.w = cvt_pk_bf16(s[6 * 65] * g[6], s[7 * 65] * g[7]); }
        *(GAS v4u*)(c.WT + (size_t)(n0 + nn) * c.K + k0 + 8 * cch) = o; }
    LDS_WAIT(); asm volatile("" ::: "memory");
}
constexpr int cj_total(unsigned mask) { int t = 0; for (int q = 0; q < 18; ++q) if ((mask >> q) & 1u) t += CJ_ITEMS[q]; return t; }
template <unsigned MASK>
__device__ __forceinline__ void convert_jobs(Frame& F, const Args& a, int ic, int nidle) {
    if (ic < 0) return;
    constexpr int TOTAL = cj_total(MASK);
    LAS float* scr = (LAS float*)(F.lds + F.wave * 16640);
    for (int gidx = ic * NWAVES + F.wave; gidx < TOTAL; gidx += nidle * NWAVES) {
        int j = 0, it = gidx; bool found = false;
#pragma unroll
        for (int q = 0; q < 18; ++q) { if (((MASK >> q) & 1u) && !found) { if (it < CJ_ITEMS[q]) { j = q; found = true; } else it -= CJ_ITEMS[q]; } }
        const CJob c = cjob(a, j);
        convert_item(c, it, scr, F.lane);
    }
}
constexpr unsigned CJM_L0 = (1u << 0) | (1u << 1);
constexpr unsigned cvm_ffn1(int l) { return l == 0 ? (1u << 2) : 0u; }
constexpr unsigned cvm_ffn2(int l) { return l == 0 ? ((1u << 3) | (1u << 15)) : l == 1 ? ((1u << 7) | (1u << 16)) : (1u << 8); }
constexpr int MOD_KS = 16;
template <int L0, int LN, int KS = MOD_KS, bool REV = false>
__device__ __forceinline__ void mod_partials(Frame& F, const Args& a, int ic, int nidle) {
    if (ic < 0 || LN <= 0) return;
    constexpr int RPT = DM / KS;
    LAS float* scr = (LAS float*)(F.lds + F.wave * 16640);
    const int lane = F.lane;
    const int w0 = ic * NWAVES + F.wave, nw = nidle * NWAVES;
    for (int t = REV ? nw - 1 - w0 : w0; t < LN * 48 * KS; t += nw) {
        const int li = t / (48 * KS), l = L0 + li, rem = t - li * (48 * KS), cg = rem / KS, ks = rem - cg * KS;
#pragma unroll
        for (int r = 0; r < 5; ++r)
#pragma unroll
            for (int q = 0; q < RPT / 64; ++q) { const int k = ks * RPT + lane + 64 * q; const float v = (r < 4) ? ((const GAS float*)a.in[I_C])[r * DM + k] : ((const GAS float*)a.in[I_CCTX])[k];
                scr[r * RPT + lane + 64 * q] = v / (1.f + __expf(-v)); }
        LDS_WAIT(); asm volatile("" ::: "memory");
        f32x4 acc[5];
#pragma unroll
        for (int r = 0; r < 5; ++r) acc[r] = (f32x4){0.f, 0.f, 0.f, 0.f};
        const GAS f32x4* wp = (const GAS f32x4*)(a.in[I_MODW] + ((size_t)l * DM + ks * RPT) * MODW + cg * 256 + lane * 4);
        for (int kk = 0; kk < RPT; kk += 16) { f32x4 w[16];
#pragma unroll
            for (int i = 0; i < 16; ++i) w[i] = wp[(size_t)(kk + i) * (MODW / 4)];
#pragma unroll
            for (int i = 0; i < 16; ++i)
#pragma unroll
                for (int r = 0; r < 5; ++r) acc[r] += w[i] * scr[r * RPT + kk + i]; }
#pragma unroll
        for (int r = 0; r < 5; ++r) *(GAS f32x4*)((float*)(F.ws + WS_MODP) + ((size_t)((l & 1) * MOD_KS + ks) * 5 + r) * MODW + cg * 256 + lane * 4) = acc[r];
        LDS_WAIT(); asm volatile("" ::: "memory");
    }
}
template <int L0, int LN, int KS = MOD_KS>
__device__ __forceinline__ void mod_reduce(Frame& F, const Args& a, int ic, int nidle) {
    if (ic < 0 || LN <= 0) return;
    for (int gid = ic * 512 + F.tid; gid < LN * 5 * (MODW / 4); gid += nidle * 512) {
        const int li = gid / (5 * (MODW / 4)), l = L0 + li, rem = gid - li * (5 * (MODW / 4)), r = rem / (MODW / 4), j4 = rem - r * (MODW / 4);
        f32x4 s = *(const GAS f32x4*)(a.in[I_MODB] + (size_t)l * MODW + 4 * j4);
#pragma unroll
        for (int ks = 0; ks < KS; ++ks) s += *(const GAS f32x4*)((const float*)(F.ws + WS_MODP) + ((size_t)((l & 1) * MOD_KS + ks) * 5 + r) * MODW + 4 * j4);
        *(GAS f32x4*)((float*)(F.ws + WS_MODS) + ((size_t)l * 5 + r) * MODW + 4 * j4) = s;
    }
}
__device__ __forceinline__ void p0a(Frame& F, const Args& a) {
    LAS float* scr = (LAS float*)(F.lds + F.wave * 16640);
    const int gw = F.vcu * NWAVES + F.wave, NGW = F.G * NWAVES, lane = F.lane;
    mod_partials<0, 1, 32, true>(F, a, F.vcu, F.G);
    convert_jobs<CJM_L0>(F, a, F.vcu, F.G);
    if (blockIdx.x == 0) {
        const float L2T = 13.287712379549449f;
        GAS f32x4* T128 = (GAS f32x4*)(F.ws + WS_TAB); GAS f32x4* T64 = (GAS f32x4*)(F.ws + WS_TAB + 16384);
        for (int e = F.tid; e < 1024 + 512; e += 512) {
            int pos, k, n; if (e < 1024) { pos = e >> 4; k = e & 15; n = 32; } else { pos = (e - 1024) >> 3; k = (e - 1024) & 7; n = 16; }
            f32x4 o;
#pragma unroll
            for (int q = 0; q < 2; ++q) { const float inv = exp2f(-(float)(2 * k + q) / (float)n * L2T); const float ang = (float)pos * inv; float rev = ang * 0.15915494309189535f; rev -= floorf(rev);
                o[2 * q] = __builtin_amdgcn_cosf(rev); o[2 * q + 1] = __builtin_amdgcn_sinf(rev); }
            if (e < 1024) T128[e] = o; else T64[e - 1024] = o;
        }
    }
    if (blockIdx.x == 1 && F.wave == 0) {
        const GAS float* lv = (const GAS float*)a.in[I_DIFF_LAM];
        const float s1 = wave_sum(lv[lane] * lv[128 + lane] + lv[64 + lane] * lv[192 + lane]), s2 = wave_sum(lv[256 + lane] * lv[384 + lane] + lv[320 + lane] * lv[448 + lane]);
        if (lane == 0) *(GAS float*)(F.ws + WS_TAB + 32768) = expf(s1) - expf(s2) + DIFF_LAM_INIT;
    }
}
__device__ __forceinline__ void p0b(Frame& F, const Args& a) { mod_reduce<0, 1, 32>(F, a, (int)blockIdx.x, F.G); }
template <int KIND>
__device__ __forceinline__ void thin_phase(Frame& F, const Args& a, int lg, int sub, bool latent_only, int ysplit, bool dry = false) {
    const int gw = F.vcu * NWAVES + F.wave, NGW = F.G * NWAVES, lane = F.lane;
    const int lu = (KIND == 0) ? 0 : (sub == 0 ? lg : lg + 1), subu = (KIND == 0) ? 0 : 1 - sub;
    const GAS float* MODS = (const GAS float*)(F.ws + WS_MODS); const GAS float* NG = (const GAS float*)a.in[I_NORMG];
    LAS f32x4* PT = (LAS f32x4*)F.lds;
    { const int t = F.tid;
#pragma unroll
      for (int r = 0; r < 5; ++r) {
        if (KIND != 0) { const f32x4 g = ((const GAS f32x4*)(MODS + ((size_t)lg * 5 + r) * MODW + (sub ? 5 : 2) * DM))[t], p = ((const GAS f32x4*)(NG + ((size_t)lg * 4 + (sub ? 3 : 1)) * DM))[t]; PT[(r * 3 + 0) * 512 + t] = g * p; }
        if (KIND != 2) { const GAS float* mv = MODS + ((size_t)lu * 5 + r) * MODW;
          const f32x4 sc = ((const GAS f32x4*)(mv + (subu ? 4 : 1) * DM))[t], sh = ((const GAS f32x4*)(mv + (subu ? 3 : 0) * DM))[t], p = ((const GAS f32x4*)(NG + ((size_t)lu * 4 + (subu ? 2 : 0)) * DM))[t];
          PT[(r * 3 + 1) * 512 + t] = p * (sc + 1.f); PT[(r * 3 + 2) * 512 + t] = sh; } }
      __syncthreads(); }
    for (int m = gw; m < MROWS; m += NGW) {
        const int b = m / TPB, rr = m - b * TPB; const bool isctx = rr < CTXL; const int mr = isctx ? 4 : b;
        if ((latent_only || KIND == 2) && isctx) continue;
        f32x4 h[8];
        if (KIND == 0) { const GAS f32x4* hp = (const GAS f32x4*)(isctx ? a.in[I_CTX] + ((size_t)b * CTXL + rr) * DM : a.in[I_X] + ((size_t)b * SEQ + (rr - CTXL)) * DM);
#pragma unroll
          for (int j = 0; j < 8; ++j) h[j] = hp[64 * j + lane]; }
        else { const GAS unsigned long long* hp = (const GAS unsigned long long*)((const bf16*)(F.ws + WS_H) + (size_t)m * DM);
#pragma unroll
          for (int j = 0; j < 8; ++j) { const unsigned long long w = hp[64 * j + lane]; const unsigned lo = (unsigned)w, hi = (unsigned)(w >> 32);
            h[j] = (f32x4){__builtin_bit_cast(float, lo << 16), __builtin_bit_cast(float, lo & 0xffff0000u), __builtin_bit_cast(float, hi << 16), __builtin_bit_cast(float, hi & 0xffff0000u)}; } }
        if (KIND != 0) {
            f32x4 y[8]; float ss = 0.f;
            if (!(isctx && ysplit)) { const GAS unsigned long long* yp = (const GAS unsigned long long*)((const bf16*)(F.ws + WS_Y) + (size_t)m * DM);
#pragma unroll
                for (int j = 0; j < 8; ++j) { const unsigned long long w = yp[64 * j + lane]; const unsigned lo = (unsigned)w, hi = (unsigned)(w >> 32);
                    y[j] = (f32x4){__builtin_bit_cast(float, lo << 16), __builtin_bit_cast(float, lo & 0xffff0000u), __builtin_bit_cast(float, hi << 16), __builtin_bit_cast(float, hi & 0xffff0000u)}; }
            } else {
                const GAS f32x4* sp = (const GAS f32x4*)((const float*)(F.ws + WS_YP) + ((size_t)b * CTXL + rr) * DM);
#pragma unroll
                for (int j = 0; j < 8; ++j) y[j] = sp[64 * j + lane];
#pragma unroll 1
                for (int ks = 1; ks < ysplit; ++ks) { sp += (size_t)1024 * DM / 4;
#pragma unroll
                    for (int j = 0; j < 8; ++j) y[j] += sp[64 * j + lane]; } }
#pragma unroll
            for (int j = 0; j < 8; ++j) ss += ssq4(y[j]);
            const float rstd = __builtin_amdgcn_rsqf(wave_sum(ss) * (1.f / DM) + EPS);
            const LAS f32x4* pa = PT + (mr * 3 + 0) * 512;
#pragma unroll
            for (int j = 0; j < 8; ++j) h[j] += pa[64 * j + lane] * (y[j] * rstd);
        }
        if (KIND == 2) { GAS f32x4* op = (GAS f32x4*)(a.out + ((size_t)b * SEQ + (rr - CTXL)) * DM);
#pragma unroll
            for (int j = 0; j < 8; ++j) op[64 * j + lane] = h[j];
        } else {
            GAS unsigned long long* hp = (GAS unsigned long long*)((bf16*)(F.ws + (dry ? WS_O12 : WS_H)) + (size_t)m * DM); float ss = 0.f;
#pragma unroll
            for (int j = 0; j < 8; ++j) { hp[64 * j + lane] = (unsigned long long)cvt_pk_bf16(h[j][0], h[j][1]) | ((unsigned long long)cvt_pk_bf16(h[j][2], h[j][3]) << 32); ss += ssq4(h[j]); }
            const float rstd = __builtin_amdgcn_rsqf(wave_sum(ss) * (1.f / DM) + EPS);
            const LAS f32x4* pc = PT + (mr * 3 + 1) * 512; const LAS f32x4* ps = PT + (mr * 3 + 2) * 512;
            GAS unsigned long long* up = (GAS unsigned long long*)((bf16*)(F.ws + (dry ? WS_O : WS_U)) + (size_t)m * DM);
#pragma unroll
            for (int j = 0; j < 8; ++j) { const f32x4 u = (h[j] * rstd) * pc[64 * j + lane] + ps[64 * j + lane];
                up[64 * j + lane] = (unsigned long long)cvt_pk_bf16(u[0], u[1]) | ((unsigned long long)cvt_pk_bf16(u[2], u[3]) << 32); }
        }
    }
    __syncthreads();
}
__device__ __forceinline__ void diff_combine(Frame& F) {
    const int gw = F.vcu * NWAVES + F.wave, NGW = F.G * NWAVES, lane = F.lane;
    const float lam = *(const GAS float*)(F.ws + WS_TAB + 32768);
    for (int m = gw; m < MROWS; m += NGW) {
        const GAS v4u* p1 = (const GAS v4u*)((const bf16*)(F.ws + WS_O12) + (size_t)m * 4096); GAS v4u* po = (GAS v4u*)((bf16*)(F.ws + WS_O) + (size_t)m * DM);
#pragma unroll
        for (int s = 0; s < 4; ++s) { const v4u a1 = p1[64 * s + lane], a2 = p1[256 + 64 * s + lane]; float x[8]; float ss = 0.f;
#pragma unroll
            for (int q = 0; q < 4; ++q) { const unsigned w1 = a1[q], w2 = a2[q];
                x[2 * q] = __builtin_bit_cast(float, w1 << 16) - lam * __builtin_bit_cast(float, w2 << 16); x[2 * q + 1] = __builtin_bit_cast(float, w1 & 0xffff0000u) - lam * __builtin_bit_cast(float, w2 & 0xffff0000u);
                ss += x[2 * q] * x[2 * q] + x[2 * q + 1] * x[2 * q + 1]; }
#pragma unroll
            for (int o = 1; o < 32; o <<= 1) ss += __shfl_xor(ss, o);
            const float rstd = __builtin_amdgcn_rsqf(ss * (1.f / 256.f) + EPS);
            v4u w; w.x = cvt_pk_bf16(x[0] * rstd, x[1] * rstd); w.y = cvt_pk_bf16(x[2] * rstd, x[3] * rstd); w.z = cvt_pk_bf16(x[4] * rstd, x[5] * rstd); w.w = cvt_pk_bf16(x[6] * rstd, x[7] * rstd);
            po[64 * s + lane] = w; }
    }
}
#define CTX_TICKET_HEAD(CTRW) \
    unsigned* tkc_ = (unsigned*)(F.ws + WS_CTL) + (CTRW); volatile LAS unsigned* tkl_ = (volatile LAS unsigned*)(F.lds + MISC_OFF) + 4; \
    const bool dyn_ = F.G >= 64; bool fin_ = false; \
    for (int un_ = F.vcu;;) { int u; \
        if (un_ < (dyn_ ? 1024 : 1024 + 64)) { u = un_; un_ += F.G; } \
        else { if (!dyn_ || fin_) break; fin_ = true; \
               if (F.tid == 0) *tkl_ = __hip_atomic_fetch_add(tkc_, 1u, __ATOMIC_RELAXED, __HIP_MEMORY_SCOPE_AGENT); \
               __syncthreads(); const unsigned t_ = (unsigned)__builtin_amdgcn_readfirstlane((int)*tkl_); __syncthreads(); if (t_ >= 64u) break; u = 1024 + (int)t_; }
__device__ __forceinline__ void attn_swa_phase(Frame& F, const Args& a) {
    const bf16* QKV = (const bf16*)(F.ws + WS_R1); bf16* O = (bf16*)(F.ws + WS_O);
    for (int it = 0; ; ++it) {
        int u = F.vcu + it * F.G;
        if (u >= 1024) {
            if (F.G == 256) { const int q = F.vcu & 15, e = it - 4; if ((q != 0 && q != 15) || e < 0 || e > 1) break; u = 1024 + ((F.vcu >> 4) * 2 + (q == 15 ? 1 : 0)) * 2 + e; }
            else if (u >= 1024 + 64) break;
        }
        attn::Desc d; int b, hq; long qrow;
        if (u < 1024) { const int bh = u >> 4, qb = u & 15; b = bh >> 4; hq = bh & 15; qrow = (long)b * TPB + CTXL + 256 * qb;
            const int t0 = 256 * qb, tlo = t0 - 128 < 0 ? 0 : t0 - 128, thi = t0 + 384 > SEQ ? SEQ : t0 + 384;
            d.NT = 4 + (thi - tlo) / 64; d.row_lat = b * TPB + CTXL + tlo; d.a0 = tlo - t0;
        } else { const int bh = u - 1024; b = bh >> 4; hq = bh & 15; qrow = (long)b * TPB; d.NT = 4; d.row_lat = b * TPB + CTXL; d.a0 = 0; }
        const int hk = hq >> 2;
        d.NTreal = d.NT; d.row_ctx = b * TPB; d.a1 = 0; d.rpb = nullptr; d.K2 = nullptr; d.rot = 0;
        d.Q = QKV + qrow * 3072 + 128 * hq; d.K = QKV + 2048 + 128 * hk; d.V = QKV + 2560 + 128 * hk; d.O = O + qrow * DM + 128 * hq;
        d.ldq = 3072; d.ldk = 3072; d.ldv = 3072; d.ldo = DM;
        d.m0 = ((const GAS float*)a.in[I_SWA_SINK])[hq]; d.l0 = 1.f;
        attn::unit<1, false, 2, 8>(d, (LAS char*)F.lds);
    }
}
__device__ __forceinline__ void attn_diff_phase(Frame& F) {
    const bf16* Q = (const bf16*)(F.ws + WS_R1); const bf16* KH = (const bf16*)(F.ws + R1_KH); const bf16* VH = (const bf16*)(F.ws + R1_VH); bf16* O12 = (bf16*)(F.ws + WS_O12); bf16* O = (bf16*)(F.ws + WS_O);
    const float lam = *(const GAS float*)(F.ws + WS_TAB + 32768);
    CTX_TICKET_HEAD(64)
        attn::Desc d; int bh; long qrow;
        if (u < 1024) { bh = u >> 5; qrow = (long)(bh >> 3) * TPB + CTXL + 128 * (u & 31); d.NT = 68; }
        else { bh = (u - 1024) >> 1; qrow = (long)(bh >> 3) * TPB + 128 * (u & 1); d.NT = 4; }
        const int b = bh >> 3, h = bh & 7;
        d.NTreal = d.NT; d.row_ctx = b * TPB; d.row_lat = b * TPB + CTXL; d.a0 = 0; d.a1 = 0; d.rpb = nullptr; d.K2 = nullptr; d.m0 = -1e30f; d.l0 = 0.f; d.rot = 0; d.probe = F.ws + 65536;
        d.V = VH + (size_t)h * MROWS * 256; d.ldq = 2048; d.ldk = 128; d.ldv = 256; d.O1 = O12 + qrow * 4096 + 256 * h; d.lam = lam;
        d.Q = Q + qrow * 2048 + 256 * h; d.K = KH + (size_t)(2 * h) * MROWS * 128; d.O = O12 + qrow * 4096 + 256 * h; d.ldo = 4096;
        attn::unit_split<false>(d, (LAS char*)F.lds);
        d.Q = Q + qrow * 2048 + 256 * h + 128; d.K = KH + (size_t)(2 * h + 1) * MROWS * 128; d.O = O + qrow * DM + 256 * h; d.ldo = DM;
        attn::unit_split<true>(d, (LAS char*)F.lds);
    }
}
__device__ __forceinline__ void attn_mla_phase(Frame& F) {
    const bf16* Qp = (const bf16*)(F.ws + R1_MLA_Q); const bf16* KV = (const bf16*)(F.ws + R1_MLA_KV); const bf16* KPE = (const bf16*)(F.ws + R1_MLA_KPE); bf16* O = (bf16*)(F.ws + WS_O);
    CTX_TICKET_HEAD(128)
        attn::Desc d; int bh; long qrow;
        if (u < 1024) { bh = u >> 4; const int qb = u & 15; qrow = (long)(bh >> 4) * TPB + CTXL + 256 * qb; d.NT = 68; }
        else { bh = u - 1024; qrow = (long)(bh >> 4) * TPB; d.NT = 4; }
        const int b = bh >> 4, h = bh & 15;
        d.NTreal = d.NT; d.row_ctx = b * TPB; d.row_lat = b * TPB + CTXL; d.a0 = 0; d.a1 = 0; d.rpb = nullptr; d.m0 = -1e30f; d.l0 = 0.f; d.rot = 0;
        d.Q = Qp + qrow * 3072 + 192 * h; d.K = KV + 256 * h; d.V = KV + 256 * h + 128; d.K2 = KPE; d.O = O + qrow * DM + 128 * h;
        d.ldq = 3072; d.ldk = 4096; d.ldv = 4096; d.ldo = DM;
        attn::unit<0, true, 1, 8>(d, (LAS char*)F.lds);
    }
}
__device__ __forceinline__ void attn_na_phase(Frame& F, const Args& a) {
    const bf16* QKV = (const bf16*)(F.ws + WS_R1); bf16* O = (bf16*)(F.ws + WS_O);
    for (int u = F.vcu; u < 1024; u += F.G) {
        attn::Desc d; const int bh = u >> 4, R = u & 15, b = bh >> 4, h = bh & 15; const long qrow = (long)b * TPB + CTXL + 256 * R;
        const int krlo = 4 * R - 4 < 0 ? 0 : 4 * R - 4; int krhi = 4 * R - 1; krhi = (krhi < 0 ? 0 : (krhi > 56 ? 56 : krhi)) + 8;
        d.NTreal = 4 + (krhi - krlo); d.NT = (d.NTreal + 1) & ~1; d.row_ctx = b * TPB; d.row_lat = b * TPB + CTXL + 64 * krlo; d.a0 = krlo; d.a1 = 4 * R;
        d.rpb = a.in[I_NA_RPB] + h * 465; d.K2 = nullptr; d.m0 = -1e30f; d.l0 = 0.f; d.rot = 0;
        d.Q = QKV + qrow * 6144 + 128 * h; d.K = QKV + 2048 + 128 * h; d.V = QKV + 4096 + 128 * h; d.O = O + qrow * DM + 128 * h;
        d.ldq = 6144; d.ldk = 6144; d.ldv = 6144; d.ldo = DM;
        attn::unit<2, false, 1, 4>(d, (LAS char*)F.lds);
    }
}

constexpr int NPH = 33;
#ifdef PROBE_EPI
#define GPROBE (args.ws + 65536)
#else
#define GPROBE nullptr
#endif
#ifndef TS_BLOCK
#define TS_BLOCK 0
#endif
#ifndef TS_BASE
#define TS_BASE 0.f
#endif
#ifndef TS_KIND
#define TS_KIND 0
#endif
#ifndef PROBE_TSMASK
#define PROBE_TSMASK 0ull
#endif
#ifndef TS_SCALE
#define TS_SCALE 1.f
#endif
#ifndef PROBE_DUP
#define PROBE_DUP (-1)
#endif
constexpr int WO_SPLIT = 8, DN_SPLIT = 4;
__global__ void __launch_bounds__(NWAVES * 64, 2) fwd_kernel(Args args) {
    extern __shared__ __attribute__((aligned(16))) unsigned char lds_raw[];
    Frame F; F.lds = (LAS unsigned char*)lds_raw; F.tid = threadIdx.x; F.lane = F.tid & 63; F.wave = __builtin_amdgcn_readfirstlane(F.tid >> 6);
    F.G = gridDim.x; { const int bx = blockIdx.x; F.vcu = (F.G % 8 == 0) ? (bx % 8) * (F.G / 8) + bx / 8 : bx; }
    F.ws = args.ws;
    volatile LAS unsigned* MISC = (volatile LAS unsigned*)(F.lds + MISC_OFF);
    if (F.tid < 32) MISC[F.tid] = 0u;
    __syncthreads();
    XcdBarrier bar = xcd_barrier_post((unsigned*)(args.ws + WS_CTL) + CW_BAR + args.li * XCD_BAR_WORDS, MISC + 8);
    const int lo = args.ph_lo, hi = args.ph_hi;

#define IN(k) (lo <= (k) && (k) < hi)
#ifdef PROBE_BW
#define SEAM(k) do { if ((k) + 1 < hi) { unsigned long long t0_ = 0; const bool hit_ = ((((PROBE_BW) >> (k)) & 1ull) != 0ull) && blockIdx.x == TS_BLOCK && F.tid == 0; if (hit_) t0_ = __builtin_amdgcn_s_memrealtime(); \
    xcd_barrier(bar); if (hit_) { GAS unsigned long long* tw = (GAS unsigned long long*)(args.ws + 65536); tw[5] += __builtin_amdgcn_s_memrealtime() - t0_; } } } while (0)
#else
#define SEAM(k) do { if ((k) + 1 < hi) xcd_barrier(bar); } while (0)
#endif
    unsigned char* ws = args.ws;
    const float* T128 = (const float*)(ws + WS_TAB); const float* T64 = (const float*)(ws + WS_TAB + 16384);
    bf16* U = (bf16*)(ws + WS_U); bf16* Y = (bf16*)(ws + WS_Y); float* YP = (float*)(ws + WS_YP); bf16* O = (bf16*)(ws + WS_O); bf16* R1 = (bf16*)(ws + WS_R1);
    const int bx = (int)blockIdx.x; int tbx = bx;
#define GEMM_ALL(Abuf, lda_, Wt, N_, K_, EpiT, ...) do { pg8::Gemm g{(const bf16*)(Abuf), (const bf16*)(Wt), MROWS, (N_), (K_), (lda_)}; pg8::StaticOrder S; S.init(MROWS, (N_), (K_), F.G, bx); \
        EpiT E{__VA_ARGS__}; pg8::gemm_phase<EpiT, pg8::StaticOrder>(F.lds, g, S, E, GPROBE); } while (0)
#define GEMM_TKT(CTRW, Abuf, lda_, Wt, N_, K_, EpiT, ...) do { pg8::Gemm g{(const bf16*)(Abuf), (const bf16*)(Wt), MROWS, (N_), (K_), (lda_)}; pg8::TicketOrder S; S.init(MROWS, (N_), (K_), F.G, bx); \
        const int nf_ = S.nwg / F.G, rm_ = S.nwg % F.G; const bool tk_ = nf_ >= 2 && rm_ > 0; \
        S.ctr = (unsigned*)(ws + WS_CTL) + (CTRW); S.tkl = (volatile LAS unsigned*)(F.lds + MISC_OFF) + 5; S.nfull = tk_ ? nf_ : (1 << 28); S.rem = rm_; S.tdraw = tk_ ? nf_ - 2 : -1; \
        EpiT E{__VA_ARGS__}; pg8::gemm_phase<EpiT, pg8::TicketOrder>(F.lds, g, S, E, GPROBE); \
        if (tk_) tbx = __builtin_amdgcn_readfirstlane((int)*S.tkl); } while (0)
#define GEMM_REV(Abuf, lda_, Wt, N_, K_, EpiT, ...) do { pg8::Gemm g{(const bf16*)(Abuf), (const bf16*)(Wt), MROWS, (N_), (K_), (lda_)}; pg8::StaticOrder S; S.init(MROWS, (N_), (K_), F.G, F.G - 1 - bx); \
        EpiT E{__VA_ARGS__}; pg8::gemm_phase<EpiT, pg8::StaticOrder>(F.lds, g, S, E, GPROBE); } while (0)
#define GEMM_LAT(Abuf, lda_, Wt, N_, K_, EpiT, ...) do { pg8::Gemm g{(const bf16*)(Abuf), (const bf16*)(Wt), MROWS, (N_), (K_), (lda_)}; pg8::LatentOrder S; S.init(NBATCH * SEQ, (N_), (K_), F.G, bx); \
        EpiT E{__VA_ARGS__}; pg8::gemm_phase<EpiT, pg8::LatentOrder>(F.lds, g, S, E); } while (0)
#define GEMM_CSP(Abuf, lda_, Wt, N_, K_, S_, EpiT, ...) do { pg8::Gemm g{(const bf16*)(Abuf), (const bf16*)(Wt), MROWS, (N_), (K_), (lda_)}; pg8::CtxSplitOrder S; S.init(NBATCH * SEQ, (N_), (K_), F.G, bx); S.S = (S_); S.ntA = ((K_) / 64 / ((S_) / 2) / 2 + 1) & ~1; S.ntB = (K_) / 64 / ((S_) / 2) - S.ntA; \
        EpiT E{__VA_ARGS__}; pg8::gemm_phase<EpiT, pg8::CtxSplitOrder>(F.lds, g, S, E); } while (0)
#define TAILCVT(MASK_, nunits_) do { const int rem_ = (nunits_) % F.G; convert_jobs<(MASK_)>(F, args, rem_ ? tbx - rem_ : tbx, rem_ ? F.G - rem_ : F.G); } while (0)
#define TAIL3() do { const int rem_ = (68 * 12) % F.G, ic_ = rem_ ? tbx - rem_ : tbx, ni_ = rem_ ? F.G - rem_ : F.G, nA_ = (ni_ * 109 + 104) / 208; \
        if (ni_ < 2 || nA_ < 1 || nA_ >= ni_) { convert_jobs<(1u << 10) | (1u << 14)>(F, args, ic_, ni_); mod_partials<1, 1>(F, args, ic_, ni_); } \
        else { convert_jobs<(1u << 10)>(F, args, (ic_ >= 0 && ic_ < nA_) ? ic_ : -1, nA_); \
               convert_jobs<(1u << 14)>(F, args, ic_ >= nA_ ? ic_ - nA_ : -1, ni_ - nA_); mod_partials<1, 1>(F, args, ic_ >= nA_ ? ic_ - nA_ : -1, ni_ - nA_); } } while (0)
#define TAILMODP(L_, nunits_) do { const int rem_ = (nunits_) % F.G; mod_partials<((L_) < 0 ? 0 : (L_)), ((L_) < 0 ? 0 : 1)>(F, args, rem_ ? tbx - rem_ : tbx, rem_ ? F.G - rem_ : F.G); } while (0)
#define TAILMODR(L_, nunits_) do { const int rem_ = (nunits_) % F.G; mod_reduce<((L_) < 0 ? 0 : (L_)), ((L_) < 0 ? 0 : 1)>(F, args, rem_ ? tbx - rem_ : tbx, rem_ ? F.G - rem_ : F.G); } while (0)
#ifdef PROBE_THIN
#define THIN_DRY(x) do { x; xcd_barrier(bar); } while (0)
#else
#define THIN_DRY(x) do { } while (0)
#endif
#ifdef PROBE_COLD
#define COLD_DUP(l, x) do { if ((l) == PROBE_COLD) { x; xcd_barrier(bar); } } while (0)
#else
#define COLD_DUP(l, x) do { } while (0)
#endif
#ifdef PROBE_TS
#define TS_HIT(k) ((PROBE_TS >= 0) ? ((k) == PROBE_TS) : (((PROBE_TSMASK) >> (k)) & 1ull) != 0ull)
#define TS_A(k) do { if (TS_HIT(k) && blockIdx.x == TS_BLOCK && F.tid == 0) { GAS unsigned long long* tw = (GAS unsigned long long*)(args.ws + 65536); tw[0] = __builtin_amdgcn_s_memrealtime(); tw[1] = __builtin_readcyclecounter(); } } while (0)
#define TS_B(k) do { if (TS_HIT(k) && blockIdx.x == TS_BLOCK && F.tid == 0) { GAS unsigned long long* tw = (GAS unsigned long long*)(args.ws + 65536); const unsigned long long r_ = __builtin_amdgcn_s_memrealtime(), c_ = __builtin_readcyclecounter(); \
    tw[2] = r_; tw[3] = c_; tw[5] += r_ - tw[0]; tw[6] += c_ - tw[1]; } } while (0)
#else
#define TS_A(k) do { } while (0)
#define TS_B(k) do { } while (0)
#endif
#define PHASE(k, ...) do { if (IN(k)) { TS_A(k); __VA_ARGS__; TS_B(k); if (PROBE_DUP == (k)) { xcd_barrier(bar); __VA_ARGS__; } SEAM(k); } } while (0)
#define FFN_PART(l, p0) do { \
        PHASE((p0) + 0, THIN_DRY(thin_phase<1>(F, args, (l), 0, false, WO_SPLIT, true)); thin_phase<1>(F, args, (l), 0, false, WO_SPLIT)); \
        PHASE((p0) + 1, COLD_DUP(l, GEMM_ALL(U, DM, ws + W_GU + (size_t)(((l) + 1) & 3) * 44 * MiB, 2 * FF, DM, pg8::EpiSwiGLU, R1, FF)); GEMM_TKT(256 + 64 * (l), U, DM, ws + W_GU + (size_t)(l) * 44 * MiB, 2 * FF, DM, pg8::EpiSwiGLU, R1, FF); TAILCVT(cvm_ffn1(l), 68 * 44); TAILMODP(((l) >= 1) ? (l) + 1 : -1, 68 * 44); TAILMODR(((l) == 0) ? 1 : -1, 68 * 44); tbx = bx); \
        PHASE((p0) + 2, GEMM_CSP(R1, FF, ws + W_DOWN + (size_t)(l) * 22 * MiB, DM, FF, DN_SPLIT, pg8::EpiF32, Y, DM, YP); TAILCVT(cvm_ffn2(l), 64 * 8 + 4 * 8 * DN_SPLIT); TAILMODR(((l) >= 1) ? (l) + 1 : -1, 64 * 8 + 4 * 8 * DN_SPLIT)); \
        PHASE((p0) + 3, THIN_DRY(thin_phase<1>(F, args, (l), 1, false, DN_SPLIT, true)); thin_phase<1>(F, args, (l), 1, false, DN_SPLIT)); } while (0)

    PHASE(0, p0a(F, args));
    PHASE(1, p0b(F, args));
    PHASE(2, thin_phase<0>(F, args, 0, 0, false, 0));
#ifdef PROBE_XBAR
#define XB4 xcd_barrier(bar); xcd_barrier(bar); xcd_barrier(bar); xcd_barrier(bar);
    XB4 XB4 XB4 XB4 XB4 XB4 XB4 XB4 XB4 XB4
#endif
    PHASE(3, GEMM_TKT(192, U, DM, ws + W_SWA_QKV, 3072, DM, pg8::EpiQKV, R1, 3072, 8, 10, 0.08838834764831845f, T128, nullptr, nullptr, 0, 1);
             TAIL3(); tbx = bx);
    PHASE(4, attn_swa_phase(F, args));
    PHASE(5, GEMM_CSP(O, DM, ws + W_SWA_O, DM, DM, WO_SPLIT, pg8::EpiF32, Y, DM, YP));
    FFN_PART(0, 6);
    PHASE(10, GEMM_TKT(1024, U, DM, ws + W_DIFF_QKV, 6144, DM, pg8::EpiQKV, R1, 2048, 8, 16, 0.08838834764831845f, T128, (bf16*)(ws + R1_KH), (bf16*)(ws + R1_VH), 16, 2);
              TAILCVT((1u << 11) | (1u << 4) | (1u << 5) | (1u << 6), 68 * 24); tbx = bx);
    PHASE(11, attn_diff_phase(F));
    PHASE(13, GEMM_CSP(O, DM, ws + W_DIFF_O, DM, DM, WO_SPLIT, pg8::EpiF32, Y, DM, YP));
    FFN_PART(1, 14);
    PHASE(18, GEMM_ALL(U, DM, ws + W_MLA_DOWN, 1280, DM, pg8::EpiMlaDown, (bf16*)(ws + R1_MLA_C), (bf16*)(ws + R1_MLA_KPE), (float*)(ws + WS_SSQ), T64);
              TAILCVT((1u << 12) | (1u << 17), 68 * 5));
    PHASE(19, GEMM_ALL(ws + R1_MLA_C, 1024, ws + W_MLA_UQ, 3072, 512, pg8::EpiMlaUp<true>, (bf16*)(ws + R1_MLA_Q), 3072, (const float*)(ws + WS_SSQ), 0, 0.07216878364870323f, T64);
              GEMM_REV(ws + R1_MLA_C + 1024, 1024, ws + W_MLA_UKV, 4096, 512, pg8::EpiMlaUp<false>, (bf16*)(ws + R1_MLA_KV), 4096, (const float*)(ws + WS_SSQ), 1, 1.f, T64));
    PHASE(20, attn_mla_phase(F));
    PHASE(21, GEMM_CSP(O, DM, ws + W_MLA_O, DM, DM, WO_SPLIT, pg8::EpiF32, Y, DM, YP));
    FFN_PART(2, 22);
    PHASE(26, GEMM_TKT(1088, U, DM, ws + W_NA_QKV, 6144, DM, pg8::EpiQKV, R1, 6144, 8, 0, 0.08838834764831845f, T128, nullptr, nullptr, 0, 1);
              TAILCVT((1u << 13) | (1u << 9), 68 * 24); tbx = bx);
    PHASE(27, attn_na_phase(F, args));
    PHASE(28, GEMM_LAT(O, DM, ws + W_NA_O, DM, DM, pg8::EpiF32, Y, DM, YP));
    PHASE(29, thin_phase<1>(F, args, 3, 0, true, 0));
    PHASE(30, GEMM_LAT(U, DM, ws + W_GU + (size_t)3 * 44 * MiB, 2 * FF, DM, pg8::EpiSwiGLU, R1, FF));
    PHASE(31, GEMM_LAT(R1, FF, ws + W_DOWN + (size_t)3 * 22 * MiB, DM, FF, pg8::EpiF32, Y, DM, YP));
    PHASE(32, thin_phase<2>(F, args, 3, 1, true, 0));
#ifdef PROBE_TS
    xcd_barrier(bar);
    if (blockIdx.x == TS_BLOCK && F.tid == 0) { const GAS unsigned long long* tw = (const GAS unsigned long long*)(args.ws + 65536); const float dr = (float)tw[5], dc = (float)tw[6];
        float v = 0.f;
        if (TS_KIND == 0) v = dr * 0.01f;
        if (TS_KIND == 1) v = dc / dr * 100.f;
        if (TS_KIND == 3) v = (float)tw[4] * 0.01f;
        const unsigned long long t0 = __builtin_amdgcn_s_memrealtime(), dt = (unsigned long long)(v * TS_SCALE * 100.f);
        while (__builtin_amdgcn_s_memrealtime() - t0 < dt && dt < 2000000ull) __builtin_amdgcn_s_sleep(8); }
#endif
#undef IN
#undef SEAM
}

#ifndef MK_PER_PHASE
#define MK_PER_PHASE 0
#endif
extern "C" void kernel_launch(void* const* d_in, const int* in_sizes, int n_in, void* d_out, int out_size, void* d_ws, size_t ws_size, hipStream_t stream) {
    static int grid = 0;
    if (grid == 0) {
        if (n_in != N_IN || in_sizes[0] != NBATCH * SEQ * DM || out_size != NBATCH * SEQ * DM || ws_size < WS_END) {
            fprintf(stderr, "kernel_launch: shape mismatch (n_in %d, in0 %d, out %d, ws %zu, need %zu)\n", n_in, n_in > 0 ? in_sizes[0] : -1, out_size, ws_size, (size_t)WS_END); grid = -1; return; }
        int dev = 0, cus = 0, per_cu = 0;
        if (hipGetDevice(&dev) != hipSuccess || hipDeviceGetAttribute(&cus, hipDeviceAttributeMultiprocessorCount, dev) != hipSuccess) { grid = -1; return; }
        if (hipFuncSetAttribute((const void*)fwd_kernel, hipFuncAttributeMaxDynamicSharedMemorySize, LDS_BYTES) != hipSuccess) { fprintf(stderr, "kernel_launch: hipFuncSetAttribute failed\n"); grid = -1; return; }
        if (hipOccupancyMaxActiveBlocksPerMultiprocessor(&per_cu, (const void*)fwd_kernel, NWAVES * 64, LDS_BYTES) != hipSuccess || per_cu < 1) { fprintf(stderr, "kernel_launch: occupancy query says %d\n", per_cu); }
        (void)hipGetLastError();
        grid = cus;
    }
    if (grid < 0) return;
    if (hipMemsetAsync((char*)d_ws + WS_CTL, 0, CTL_ZERO_BYTES, stream) != hipSuccess) return;
    Args a{};
    for (int i = 0; i < N_IN; ++i) a.in[i] = (const float*)d_in[i];
    a.out = (float*)d_out; a.ws = (unsigned char*)d_ws;
#if MK_PER_PHASE
    for (int p = 0; p < NPH; ++p) { a.ph_lo = p; a.ph_hi = p + 1; a.li = 0; hipLaunchKernelGGL(fwd_kernel, dim3(grid), dim3(NWAVES * 64), LDS_BYTES, stream, a); }
#else
    a.ph_lo = 0; a.ph_hi = NPH; a.li = 0;
    hipLaunchKernelGGL(fwd_kernel, dim3(grid), dim3(NWAVES * 64), LDS_BYTES, stream, a);
#endif
    const hipError_t le = hipPeekAtLastError();
    if (le != hipSuccess) fprintf(stderr, "kernel_launch: launch failed: %s\n", hipGetErrorName(le));
}
```
